# Optimizing an MI355X kernel written in HIP

```python
import jax, jax.numpy as jnp
from jax import lax
import numpy as np

D_MODEL = 4096
BATCH = 2
SEQ = 8192
DEPTH = 1

MLA_HEADS = 32
MLA_Q_RANK = 1024
MLA_KV_RANK = 512
MLA_NOPE_DIM = 128
MLA_ROPE_DIM = 64
MLA_V_DIM = D_MODEL // MLA_HEADS
ROPE_THETA = 10000.0
SWA_HEADS = 64
SWA_KV_HEADS = 8
SWA_HEAD_DIM = D_MODEL // SWA_HEADS
SWA_GROUP = SWA_HEADS // SWA_KV_HEADS
WINDOW = 128
Q_BLOCK = 128
PEER_HEADS = 8
PEER_N_KEYS = 128
PEER_N_EXPERTS = PEER_N_KEYS * PEER_N_KEYS
PEER_QUERY_DIM = 256
PEER_HALF = PEER_QUERY_DIM // 2
PEER_TOPK = 16
PEER_CHUNK = 64

NORM_EPS = 1e-6
NEG_INF = -1e30
N_ADA = 6

W_MLA_Q = MLA_Q_RANK
W_MLA_KV = MLA_KV_RANK + MLA_ROPE_DIM
W_SWA_Q = SWA_HEADS * SWA_HEAD_DIM
W_SWA_KV = SWA_KV_HEADS * SWA_HEAD_DIM
OFF_MLA_KV = W_MLA_Q
OFF_SWA_Q = OFF_MLA_KV + W_MLA_KV
OFF_SWA_K = OFF_SWA_Q + W_SWA_Q
OFF_SWA_V = OFF_SWA_K + W_SWA_KV
OFF_GATE_A = OFF_SWA_V + W_SWA_KV
OFF_GATE_B = OFF_GATE_A + D_MODEL
IN_WIDTH = OFF_GATE_B + D_MODEL

kernel_name = "hybrid_mla_swa_sink_peer_block"


def rms_norm(x, g):
    x32 = x.astype(jnp.float32)
    y = x32 * lax.rsqrt(jnp.mean(x32 * x32, axis=-1, keepdims=True) + NORM_EPS)
    return (y * g.astype(jnp.float32)).astype(x.dtype)


def rotate_half_split(x, cos, sin):
    half = x.shape[-1] // 2
    x1, x2 = x[..., :half], x[..., half:]
    return jnp.concatenate([x1 * cos - x2 * sin, x2 * cos + x1 * sin], axis=-1)


def alibi_slopes(n):
    return jnp.exp2(-8.0 * jnp.arange(1, n + 1, dtype=jnp.float32) / n)


def mla_attention(zq, zkv, g_q_lat, w_q_b, g_kv_lat, w_kv_b):
    B, S, _ = zq.shape
    H, DN, DR, DV = MLA_HEADS, MLA_NOPE_DIM, MLA_ROPE_DIM, MLA_V_DIM
    q = (rms_norm(zq, g_q_lat) @ w_q_b).reshape(B, S, H, DN + DR)
    q_nope, q_pe = q[..., :DN], q[..., DN:]
    c_kv = rms_norm(zkv[..., :MLA_KV_RANK], g_kv_lat)
    k_pe = zkv[..., MLA_KV_RANK:]
    kv = (c_kv @ w_kv_b).reshape(B, S, H, DN + DV)
    k_nope, v = kv[..., :DN], kv[..., DN:]
    pos = jnp.arange(S, dtype=jnp.float32)
    inv_freq = ROPE_THETA ** (-jnp.arange(0, DR, 2, dtype=jnp.float32) / DR)
    ang = pos[:, None] * inv_freq[None, :]
    cos, sin = jnp.cos(ang).astype(zq.dtype), jnp.sin(ang).astype(zq.dtype)
    q_pe = rotate_half_split(q_pe, cos[None, :, None, :], sin[None, :, None, :])
    k_pe = rotate_half_split(k_pe, cos[None], sin[None])
    scale = (DN + DR) ** -0.5
    nb = S // Q_BLOCK
    qn_b = q_nope.reshape(B, nb, Q_BLOCK, H, DN).transpose(1, 0, 2, 3, 4)
    qp_b = q_pe.reshape(B, nb, Q_BLOCK, H, DR).transpose(1, 0, 2, 3, 4)
    kpos = jnp.arange(S)

    def block(args):
        qn, qp, i = args
        qpos = i * Q_BLOCK + jnp.arange(Q_BLOCK)
        s = (jnp.einsum('bqhd,bkhd->bhqk', qn, k_nope, preferred_element_type=jnp.float32)
             + jnp.einsum('bqhr,bkr->bhqk', qp, k_pe, preferred_element_type=jnp.float32)) * scale
        s = jnp.where(kpos[None, :] <= qpos[:, None], s, NEG_INF)
        p = jax.nn.softmax(s, axis=-1).astype(v.dtype)
        return jnp.einsum('bhqk,bkhd->bqhd', p, v)

    o = lax.map(block, (qn_b, qp_b, jnp.arange(nb)))
    return o.transpose(1, 0, 2, 3, 4).reshape(B, S, H * DV)


def swa_sink_attention(zq, zk, zv, sinks):
    B, S, _ = zq.shape
    NKV, G, HD = SWA_KV_HEADS, SWA_GROUP, SWA_HEAD_DIM
    nb = S // Q_BLOCK
    span = Q_BLOCK + WINDOW
    q = zq.reshape(B, nb, Q_BLOCK, NKV, G, HD).transpose(1, 0, 2, 3, 4, 5)
    pad = ((0, 0), (WINDOW, 0), (0, 0), (0, 0))
    k = jnp.pad(zk.reshape(B, S, NKV, HD), pad)
    v = jnp.pad(zv.reshape(B, S, NKV, HD), pad)
    slopes = alibi_slopes(SWA_HEADS).reshape(NKV, G)[None, :, :, None, None]
    sink = sinks.astype(jnp.float32).reshape(NKV, G)[None, :, :, None, None]
    scale = HD ** -0.5

    def block(args):
        qb, i = args
        start = i * Q_BLOCK
        kb = lax.dynamic_slice_in_dim(k, start, span, axis=1)
        vb = lax.dynamic_slice_in_dim(v, start, span, axis=1)
        qpos = start + jnp.arange(Q_BLOCK)
        kpos = start - WINDOW + jnp.arange(span)
        dist = qpos[:, None] - kpos[None, :]
        valid = (kpos[None, :] >= 0) & (dist >= 0) & (dist < WINDOW)
        s = (jnp.einsum('bqngd,bknd->bngqk', qb, kb, preferred_element_type=jnp.float32) * scale
             - slopes * dist.astype(jnp.float32))
        s = jnp.where(valid, s, NEG_INF)
        logits = jnp.concatenate([s, jnp.broadcast_to(sink, s.shape[:-1] + (1,))], axis=-1)
        p = jax.nn.softmax(logits, axis=-1)[..., :span].astype(vb.dtype)
        return jnp.einsum('bngqk,bknd->bqngd', p, vb)

    o = lax.map(block, (q, jnp.arange(nb)))
    return o.transpose(1, 0, 2, 3, 4, 5).reshape(B, S, SWA_HEADS * HD)


def peer_ffn(h, w_peer_q, sub_keys, u, v):
    B, S, D = h.shape
    T = B * S
    H, K = PEER_HEADS, PEER_TOPK
    xt = h.reshape(T, D)
    q = (xt @ w_peer_q).reshape(T, H, 2, PEER_HALF)
    s = jnp.einsum('thpd,hpnd->thpn', q, sub_keys, preferred_element_type=jnp.float32)
    top_s, top_i = lax.top_k(s, K)
    cand = top_s[:, :, 0, :, None] + top_s[:, :, 1, None, :]
    best_s, best_c = lax.top_k(cand.reshape(T, H, K * K), K)
    i1 = jnp.take_along_axis(top_i[:, :, 0], best_c // K, axis=-1)
    i2 = jnp.take_along_axis(top_i[:, :, 1], best_c % K, axis=-1)
    expert = i1 * PEER_N_KEYS + i2
    gate = jax.nn.softmax(best_s, axis=-1).astype(h.dtype)
    nc = T // PEER_CHUNK

    def chunk(args):
        xc, ec, gc = args
        u_sel = u[ec]
        v_sel = v[ec]
        a = jax.nn.gelu(jnp.einsum('cd,chkd->chk', xc, u_sel), approximate=False) * gc
        return jnp.einsum('chk,chkd->cd', a, v_sel)

    out = lax.map(chunk, (xt.reshape(nc, PEER_CHUNK, D),
                          expert.reshape(nc, PEER_CHUNK, H, K),
                          gate.reshape(nc, PEER_CHUNK, H, K)))
    return out.reshape(B, S, D)


def setup_inputs(seed: int = 0) -> dict:
    key = jax.random.key(seed)
    ks = jax.random.split(key, 20)
    D = D_MODEL
    f32 = jnp.float32

    def nrm(k, shape, std):
        return jax.random.normal(k, shape, f32) * std

    def gain(k, n):
        return 1.0 + 0.1 * jax.random.normal(k, (DEPTH, n), f32)

    return {
        "x": jax.random.normal(ks[0], (BATCH, SEQ, D), f32),
        "c": jax.random.normal(ks[1], (BATCH, D), f32),
        "w_ada": nrm(ks[2], (DEPTH, D, N_ADA * D), 0.5 * D ** -0.5),
        "b_ada": nrm(ks[3], (DEPTH, N_ADA * D), 0.02),
        "g_attn_pre": gain(ks[4], D),
        "g_attn_post": gain(ks[5], D),
        "w_in": nrm(ks[6], (DEPTH, D, IN_WIDTH), D ** -0.5),
        "g_q_lat": gain(ks[7], MLA_Q_RANK),
        "w_q_b": nrm(ks[8], (DEPTH, MLA_Q_RANK, MLA_HEADS * (MLA_NOPE_DIM + MLA_ROPE_DIM)), MLA_Q_RANK ** -0.5),
        "g_kv_lat": gain(ks[9], MLA_KV_RANK),
        "w_kv_b": nrm(ks[10], (DEPTH, MLA_KV_RANK, MLA_HEADS * (MLA_NOPE_DIM + MLA_V_DIM)), MLA_KV_RANK ** -0.5),
        "sinks": nrm(ks[11], (DEPTH, SWA_HEADS), 0.5),
        "w_out": nrm(ks[12], (DEPTH, D, D), D ** -0.5),
        "g_ffn_pre": gain(ks[13], D),
        "g_ffn_post": gain(ks[14], D),
        "w_peer_q": nrm(ks[15], (DEPTH, D, PEER_HEADS * PEER_QUERY_DIM), D ** -0.5),
        "peer_sub_keys": nrm(ks[16], (DEPTH, PEER_HEADS, 2, PEER_N_KEYS, PEER_HALF), PEER_HALF ** -0.5),
        "peer_u": nrm(ks[17], (DEPTH, PEER_N_EXPERTS, D), D ** -0.5),
        "peer_v": nrm(ks[18], (DEPTH, PEER_N_EXPERTS, D), (PEER_HEADS * PEER_TOPK) ** -0.5),
    }


def reference(x, c, w_ada, b_ada, g_attn_pre, g_attn_post, w_in, g_q_lat, w_q_b, g_kv_lat,
              w_kv_b, sinks, w_out, g_ffn_pre, g_ffn_post, w_peer_q, peer_sub_keys, peer_u, peer_v):
    B, S, D = x.shape
    cond = jax.nn.silu(c)
    for l in range(DEPTH):
        ada = (cond @ w_ada[l] + b_ada[l]).reshape(B, N_ADA, 1, D)
        shift_a, scale_a, gate_a = ada[:, 0], ada[:, 1], ada[:, 2]
        shift_f, scale_f, gate_f = ada[:, 3], ada[:, 4], ada[:, 5]

        h = rms_norm(x, g_attn_pre[l]) * (1 + scale_a) + shift_a
        z = h @ w_in[l]
        zq, zkv, zsq, zsk, zsv, za, zb = jnp.split(
            z, [OFF_MLA_KV, OFF_SWA_Q, OFF_SWA_K, OFF_SWA_V, OFF_GATE_A, OFF_GATE_B], axis=-1)
        o_a = mla_attention(zq, zkv, g_q_lat[l], w_q_b[l], g_kv_lat[l], w_kv_b[l])
        o_b = swa_sink_attention(zsq, zsk, zsv, sinks[l])
        mix = jax.nn.sigmoid(za) * o_a + jax.nn.sigmoid(zb) * o_b
        x = x + gate_a * rms_norm(mix @ w_out[l], g_attn_post[l])

        h = rms_norm(x, g_ffn_pre[l]) * (1 + scale_f) + shift_f
        y = peer_ffn(h, w_peer_q[l], peer_sub_keys[l], peer_u[l], peer_v[l])
        x = x + gate_f * rms_norm(y, g_ffn_post[l])
    return x
```

```cpp
#include <hip/hip_runtime.h>
#include <cstdio>
#include <cstdint>
#include <cmath>
namespace pg8 {
#define PG8_LAS __attribute__((address_space(3)))
typedef unsigned short bf16_t;
typedef short bf16x8 __attribute__((ext_vector_type(8)));
typedef float f32x4 __attribute__((ext_vector_type(4)));
typedef unsigned u32x4 __attribute__((ext_vector_type(4)));
constexpr int BM = 256, BK = 64, HALF = 128, HTB = HALF * BK * 2  , STAGE_BYTES = 8 * HTB, NXCD = 8, WGM = 8;

__host__ __device__ __forceinline__ int lds_byte(int r, int c) { const int st = (r >> 4) * 2 + (c >> 5), rr = r & 15, cc = c & 31, ob = rr * 64 + cc * 2; return st * 1024 + (ob ^ (((ob >> 9) & 1) << 5)); }
__host__ __device__ __forceinline__ void stage_rc(int b, int& R, int& C) { const int st = b / 1024, sb = b % 1024, swz = sb ^ (((sb >> 9) & 1) << 5); R = (st >> 1) * 16 + swz / 64; C = (st & 1) * 32 + (swz % 64) / 2; }
__host__ __device__ __forceinline__ int perm32(int rho) { const int n = rho >> 4, i = rho & 15; return 8 * (i >> 2) + 4 * n + (i & 3); }

struct Unit { int pm, pn; };
struct Gemm { const bf16_t* A; const bf16_t* Bt; int M, N, K; };

struct StaticOrder {
    int nM, nN, nwg, G, c;
    __host__ __device__ void init(int M, int N, int G_, int c_) { nM = M / BM; nN = N / BM; nwg = nM * nN; G = G_; c = c_; }
    __host__ __device__ bool next(int i, Unit& u) const {
        const long L = (long)i * G + c; if (L >= nwg) return false;
        int wgid = (int)L; { const int q = nwg / NXCD, r = nwg % NXCD, xcd = wgid % NXCD, off = wgid / NXCD; wgid = (xcd < r ? xcd * (q + 1) : r * (q + 1) + (xcd - r) * q) + off; }
        const int nig = WGM * nN, gid = wgid / nig, fm = gid * WGM, gsz = (nM - fm) < WGM ? (nM - fm) : WGM;
        u.pm = fm + ((wgid % nig) % gsz); u.pn = (wgid % nig) / gsz; return true;
    }
    __device__ __forceinline__ void a_ready(const Unit&) const {}
    __device__ __forceinline__ void done(const Unit&) const {}
};

__device__ __forceinline__ unsigned cvt_pk_bf16(float lo, float hi) { unsigned r; asm volatile("v_cvt_pk_bf16_f32 %0, %1, %2" : "=v"(r) : "v"(lo), "v"(hi)); return r; }
typedef float f32x2 __attribute__((ext_vector_type(2)));
__device__ __forceinline__ f32x2 gelu_pk(f32x2 v) {
    const f32x2 av = __builtin_elementwise_abs(v), d = av * 0.2316418882f + 1.0f;
    f32x2 t; t.x = __builtin_amdgcn_rcpf(d.x); t.y = __builtin_amdgcn_rcpf(d.y);
    f32x2 q = t * 0.5307027145f + (-0.7265760135f); q = q * t + 0.7107068705f; q = q * t + (-0.142248368f); q = q * t + 0.127414796f; q = q * t;
    const f32x2 s = (v * v) * (-0.72134752044f);
    f32x2 e; e.x = __builtin_amdgcn_exp2f(s.x); e.y = __builtin_amdgcn_exp2f(s.y);
    const f32x2 m = v * (q * e), r = v - m;
    f32x2 o; o.x = v.x < 0.f ? m.x : r.x; o.y = v.y < 0.f ? m.y : r.y; return o;
}

template <int ACT  > struct EpiBf16 {
    static constexpr bool PERM = true, AFTER_DRAIN = false; static_assert(ACT == 0 || ACT == 1, "EpiBf16: ACT is 0 (none) or 1 (gelu_pk)");
    bf16_t* O; int ldc; const float* bias; int split_cols; size_t split_stride; float scale0;
    __device__ __forceinline__ void operator()(const f32x4 (&acc)[2][2][4][2], const Unit& u, int wr, int wc, int fr, int fq) const {
        const int row0 = u.pm * BM + wr * 64 + fr; int colt = u.pn * BM; bf16_t* base = O;
        float sc = 1.f; if (split_cols) { const int t = colt / split_cols; base += (size_t)t * split_stride; colt -= t * split_cols; if (t == 0) sc = scale0; }
        const int col0 = colt + wc * 32 + 8 * fq, bcol0 = u.pn * BM + wc * 32 + 8 * fq;
        f32x4 bv[2][2];
#pragma unroll
        for (int bj = 0; bj < 2; ++bj)
#pragma unroll
            for (int n = 0; n < 2; ++n) bv[bj][n] = bias ? *(const f32x4*)(bias + bcol0 + bj * HALF + 4 * n) : (f32x4){0.f, 0.f, 0.f, 0.f};
#pragma unroll
        for (int ai = 0; ai < 2; ++ai)
#pragma unroll
            for (int m = 0; m < 4; ++m) { bf16_t* rowp = base + (size_t)(row0 + ai * HALF + m * 16) * ldc + col0;
#pragma unroll
                for (int bj = 0; bj < 2; ++bj) { f32x4 v0 = acc[ai][bj][m][0] + bv[bj][0], v1 = acc[ai][bj][m][1] + bv[bj][1];
                    if (ACT == 1) { f32x2 a = gelu_pk((f32x2){v0[0], v0[1]}), b = gelu_pk((f32x2){v0[2], v0[3]}), c = gelu_pk((f32x2){v1[0], v1[1]}), d = gelu_pk((f32x2){v1[2], v1[3]});
                        v0 = (f32x4){a.x, a.y, b.x, b.y}; v1 = (f32x4){c.x, c.y, d.x, d.y}; }
                    v0 = v0 * sc; v1 = v1 * sc; u32x4 w; w.x = cvt_pk_bf16(v0[0], v0[1]); w.y = cvt_pk_bf16(v0[2], v0[3]); w.z = cvt_pk_bf16(v1[0], v1[1]); w.w = cvt_pk_bf16(v1[2], v1[3]);
                    *(u32x4*)(rowp + bj * HALF) = w; } }
    }
};
struct EpiZ {
    static constexpr bool PERM = true, AFTER_DRAIN = false;
    bf16_t *zq, *zsq, *za, *zb, *zsk, *zsv, *zkv; float sq_scale;
    __device__ __forceinline__ void operator()(const f32x4 (&acc)[2][2][4][2], const Unit& u, int wr, int wc, int fr, int fq) const {
        const int pn = u.pn; bf16_t* base; int ld, ct; float sc = 1.f;
        if (pn < 4) { base = zq; ld = 1024; ct = pn; }
        else if (pn < 20) { base = zsq; ld = 4096; ct = pn - 4; sc = sq_scale; }
        else if (pn < 36) { base = za; ld = 4096; ct = pn - 20; }
        else if (pn < 52) { base = zb; ld = 4096; ct = pn - 36; }
        else if (pn < 54) { base = zsk; ld = 512; ct = pn - 52; }
        else if (pn < 56) { base = zsv; ld = 512; ct = pn - 54; }
        else { base = zkv; ld = 768; ct = pn - 56; }
        const int row0 = u.pm * BM + wr * 64 + fr, col0 = ct * BM + wc * 32 + 8 * fq;
#pragma unroll
        for (int ai = 0; ai < 2; ++ai)
#pragma unroll
            for (int m = 0; m < 4; ++m) { bf16_t* rowp = base + (size_t)(row0 + ai * HALF + m * 16) * ld + col0;
#pragma unroll
                for (int bj = 0; bj < 2; ++bj) { const f32x4 v0 = acc[ai][bj][m][0] * sc, v1 = acc[ai][bj][m][1] * sc;
                    u32x4 w; w.x = cvt_pk_bf16(v0[0], v0[1]); w.y = cvt_pk_bf16(v0[2], v0[3]); w.z = cvt_pk_bf16(v1[0], v1[1]); w.w = cvt_pk_bf16(v1[2], v1[3]);
                    *(u32x4*)(rowp + bj * HALF) = w; } }
    }
};
struct EpiQ {
    static constexpr bool PERM = true, AFTER_DRAIN = false;
    bf16_t *qn, *qp; const float* rc; const float* rs;
    __device__ __forceinline__ void operator()(const f32x4 (&acc)[2][2][4][2], const Unit& u, int wr, int wc, int fr, int fq) const {
        const int pn = u.pn; const bool rope = pn >= 16;
        bf16_t* base = rope ? qp : qn; const int ld = rope ? 2048 : 4096, ct = rope ? pn - 16 : pn;
        const int row0 = u.pm * BM + wr * 64 + fr, col0 = ct * BM + wc * 32 + 8 * fq;
#pragma unroll
        for (int ai = 0; ai < 2; ++ai)
#pragma unroll
            for (int m = 0; m < 4; ++m) { const int row = row0 + ai * HALF + m * 16; bf16_t* rowp = base + (size_t)row * ld + col0;
#pragma unroll
                for (int bj = 0; bj < 2; ++bj) { f32x4 v0 = acc[ai][bj][m][0], v1 = acc[ai][bj][m][1];
                    if (rope) { const int i0 = ((col0 + bj * HALF) & 63) >> 1; const int pos = row & 8191;
                        const f32x4 c = *(const f32x4*)(rc + pos * 32 + i0), s = *(const f32x4*)(rs + pos * 32 + i0);
                        const f32x4 a = v0, b = v1;
                        v0[0] = a[0] * c[0] - a[1] * s[0]; v0[1] = a[1] * c[0] + a[0] * s[0]; v0[2] = a[2] * c[1] - a[3] * s[1]; v0[3] = a[3] * c[1] + a[2] * s[1];
                        v1[0] = b[0] * c[2] - b[1] * s[2]; v1[1] = b[1] * c[2] + b[0] * s[2]; v1[2] = b[2] * c[3] - b[3] * s[3]; v1[3] = b[3] * c[3] + b[2] * s[3]; }
                    u32x4 w; w.x = cvt_pk_bf16(v0[0], v0[1]); w.y = cvt_pk_bf16(v0[2], v0[3]); w.z = cvt_pk_bf16(v1[0], v1[1]); w.w = cvt_pk_bf16(v1[2], v1[3]);
                    *(u32x4*)(rowp + bj * HALF) = w; } }
    }
};
struct EpiT {
    static constexpr bool PERM = true, AFTER_DRAIN = false;
    bf16_t* T; float* rsq;
    __device__ __forceinline__ void operator()(const f32x4 (&acc)[2][2][4][2], const Unit& u, int wr, int wc, int fr, int fq) const {
        const int row0 = u.pm * BM + wr * 64 + fr, col0 = u.pn * BM + wc * 32 + 8 * fq;
#pragma unroll
        for (int ai = 0; ai < 2; ++ai)
#pragma unroll
            for (int m = 0; m < 4; ++m) { const int row = row0 + ai * HALF + m * 16; bf16_t* rowp = T + (size_t)row * 4096 + col0; float s = 0.f;
#pragma unroll
                for (int bj = 0; bj < 2; ++bj) { const f32x4 v0 = acc[ai][bj][m][0], v1 = acc[ai][bj][m][1];
                    s += (v0[0] * v0[0] + v0[1] * v0[1]) + (v0[2] * v0[2] + v0[3] * v0[3]) + (v1[0] * v1[0] + v1[1] * v1[1]) + (v1[2] * v1[2] + v1[3] * v1[3]);
                    u32x4 w; w.x = cvt_pk_bf16(v0[0], v0[1]); w.y = cvt_pk_bf16(v0[2], v0[3]); w.z = cvt_pk_bf16(v1[0], v1[1]); w.w = cvt_pk_bf16(v1[2], v1[3]);
                    *(u32x4*)(rowp + bj * HALF) = w; }
                s += __shfl_xor(s, 16); s += __shfl_xor(s, 32);
                if (fq == 0) rsq[(size_t)row * 64 + u.pn * 4 + wc] = s; }
    }
};

template <class Epi, class Sched, bool ALIGN_EPI = false, bool SP2 = false>
__device__ __forceinline__ void gemm_phase(PG8_LAS unsigned char* lds, const Gemm g, const Sched& S, const Epi& E) {
    const int tid = threadIdx.x, wid = __builtin_amdgcn_readfirstlane(tid >> 6), lane = tid & 63, wr = wid >> 2, wc = wid & 3, fr = lane & 15, fq = lane >> 4;
    const int K = g.K, nt = K / BK;
    unsigned voffA[2], voffB[2];
#pragma unroll
    for (int i = 0; i < 2; ++i) { int R, C; stage_rc(tid * 16 + i * 8192, R, C); const int Rb = Epi::PERM ? ((R & ~31) + perm32(R & 31)) : R;
        voffA[i] = (unsigned)(R * K + C) * 2u; voffB[i] = (unsigned)(Rb * K + C) * 2u; }
    const size_t kstep = (size_t)(BK * 2);
    const size_t hstep = (size_t)HALF * K * 2;
    const size_t tstep = 2 * hstep;
    const unsigned ldsw = (unsigned)wid * 1024u;
    const int aoff = lds_byte(wr * 64 + fr, fq * 8), boff = lds_byte(wc * 32 + fr, fq * 8);
#define PG8_SA(b, h) (((b) * 2 + (h)) * HTB)
#define PG8_SB(b, h) ((4 + (b) * 2 + (h)) * HTB)
#define PG8_STAGE(bufoff, gbase, voff) do { _Pragma("unroll") for (int _i = 0; _i < 2; ++_i) \
        __builtin_amdgcn_global_load_lds((const unsigned*)((const char*)(gbase) + (voff)[_i]), (PG8_LAS unsigned*)(lds + (bufoff) + ldsw + _i * 8192), 16, 0, 0); } while (0)
#define PG8_LDA(dst, b, h) do { _Pragma("unroll") for (int m = 0; m < 4; ++m) _Pragma("unroll") for (int k = 0; k < 2; ++k) dst[m][k] = *(const PG8_LAS bf16x8*)(lds + PG8_SA(b, h) + aoff + m * 2048 + k * 1024); } while (0)
#define PG8_LDB(dst, b, h) do { _Pragma("unroll") for (int n = 0; n < 2; ++n) _Pragma("unroll") for (int k = 0; k < 2; ++k) dst[n][k] = *(const PG8_LAS bf16x8*)(lds + PG8_SB(b, h) + boff + n * 2048 + k * 1024); } while (0)
#define PG8_MMA(ai, bj, At, Bt) do { __builtin_amdgcn_s_setprio(1); _Pragma("unroll") for (int m = 0; m < 4; ++m) _Pragma("unroll") for (int n = 0; n < 2; ++n) _Pragma("unroll") for (int k = 0; k < 2; ++k) \
        acc[ai][bj][m][n] = __builtin_amdgcn_mfma_f32_16x16x32_bf16(Bt[n][k], At[m][k], acc[ai][bj][m][n], 0, 0, 0); __builtin_amdgcn_s_setprio(0); } while (0)
#define PG8_WAIT_V(n) asm volatile("s_waitcnt vmcnt(" #n ")" ::: "memory")
#define PG8_WAIT_L(n) asm volatile("s_waitcnt lgkmcnt(" #n ")" ::: "memory")
#define PG8_BAR __builtin_amdgcn_s_barrier()
#define PG8_SCHED __builtin_amdgcn_sched_barrier(0)
    Unit cur, nxt; int ui = 0;
    if (!S.next(0, cur)) return;
    f32x4 acc[2][2][4][2];
#pragma unroll
    for (int a = 0; a < 2; ++a)
#pragma unroll
        for (int b = 0; b < 2; ++b)
#pragma unroll
            for (int m = 0; m < 4; ++m)
#pragma unroll
                for (int n = 0; n < 2; ++n) acc[a][b][m][n] = (f32x4){0.f, 0.f, 0.f, 0.f};
    bf16x8 At[4][2], B0[2][2], B1[2][2];
    const char* cA = (const char*)g.A + (size_t)cur.pm * tstep; const char* cB = (const char*)g.Bt + (size_t)cur.pn * tstep;
    S.a_ready(cur);
    if constexpr (SP2) {
        PG8_STAGE(PG8_SB(0, 0), cB, voffB); PG8_STAGE(PG8_SB(0, 1), cB + hstep, voffB); PG8_STAGE(PG8_SA(0, 0), cA, voffA); PG8_STAGE(PG8_SA(0, 1), cA + hstep, voffA);
        if (wr == 1) PG8_BAR;
        PG8_WAIT_V(2); PG8_BAR;
        PG8_STAGE(PG8_SB(1, 0), cB + kstep, voffB); PG8_STAGE(PG8_SA(1, 0), cA + kstep, voffA); PG8_STAGE(PG8_SB(1, 1), cB + hstep + kstep, voffB);
        PG8_WAIT_V(6); PG8_BAR;
    } else {
        PG8_STAGE(PG8_SB(0, 0), cB, voffB); PG8_STAGE(PG8_SA(0, 0), cA, voffA); PG8_STAGE(PG8_SB(0, 1), cB + hstep, voffB); PG8_STAGE(PG8_SA(0, 1), cA + hstep, voffA);
        if (wr == 1) PG8_BAR;
        PG8_WAIT_V(4); PG8_BAR;
        PG8_STAGE(PG8_SB(1, 0), cB + kstep, voffB); PG8_STAGE(PG8_SA(1, 0), cA + kstep, voffA); PG8_STAGE(PG8_SB(1, 1), cB + hstep + kstep, voffB);
        PG8_WAIT_V(6); PG8_BAR;
    }
    for (;;) {
        const bool has_next = S.next(ui + 1, nxt);
        const char* nA = has_next ? (const char*)g.A + (size_t)nxt.pm * tstep : cA; const char* nB = has_next ? (const char*)g.Bt + (size_t)nxt.pn * tstep : cB;
        for (int t = 0; t < nt; t += 2) {
            const bool last = (t == nt - 2);
            const char* a1 = cA + (size_t)(t + 1) * kstep;
            const char* a2 = last ? nA : cA + (size_t)(t + 2) * kstep; const char* b2 = last ? nB : cB + (size_t)(t + 2) * kstep;
            const char* a3 = a2 + kstep; const char* b3 = b2 + kstep;
            if (last && has_next) S.a_ready(nxt);
            if constexpr (SP2) {
            PG8_LDB(B0, 0, 0); PG8_LDB(B1, 0, 1); PG8_SCHED; PG8_LDA(At, 0, 0); PG8_STAGE(PG8_SA(1, 1), a1 + hstep, voffA);
            PG8_WAIT_V(8); PG8_WAIT_L(0); PG8_BAR; PG8_MMA(0, 0, At, B0); PG8_MMA(0, 1, At, B1); PG8_BAR; PG8_SCHED;
            PG8_LDA(At, 0, 1); PG8_STAGE(PG8_SB(0, 0), b2, voffB); PG8_STAGE(PG8_SB(0, 1), b2 + hstep, voffB); PG8_STAGE(PG8_SA(0, 0), a2, voffA);
            PG8_WAIT_V(8); PG8_WAIT_L(0); PG8_BAR; PG8_MMA(1, 0, At, B0); PG8_MMA(1, 1, At, B1); PG8_BAR; PG8_SCHED;
            PG8_LDB(B0, 1, 0); PG8_LDB(B1, 1, 1); PG8_SCHED; PG8_LDA(At, 1, 0); PG8_STAGE(PG8_SA(0, 1), a2 + hstep, voffA);
            PG8_WAIT_V(8); PG8_WAIT_L(0); PG8_BAR; PG8_MMA(0, 0, At, B0); PG8_MMA(0, 1, At, B1); PG8_BAR; PG8_SCHED;
            PG8_LDA(At, 1, 1); PG8_STAGE(PG8_SB(1, 0), b3, voffB); PG8_STAGE(PG8_SB(1, 1), b3 + hstep, voffB); PG8_STAGE(PG8_SA(1, 0), a3, voffA);
            PG8_WAIT_V(8); PG8_WAIT_L(0); PG8_BAR; PG8_MMA(1, 0, At, B0); PG8_MMA(1, 1, At, B1); PG8_BAR; PG8_SCHED;
            } else {
            PG8_LDB(B0, 0, 0); PG8_SCHED; PG8_LDA(At, 0, 0); PG8_STAGE(PG8_SA(1, 1), a1 + hstep, voffA);
            PG8_WAIT_L(8); PG8_BAR; PG8_WAIT_L(0); PG8_MMA(0, 0, At, B0); PG8_BAR; PG8_SCHED;
            PG8_LDB(B1, 0, 1); PG8_STAGE(PG8_SB(0, 0), b2, voffB);
            PG8_BAR; PG8_WAIT_L(0); PG8_MMA(0, 1, At, B1); PG8_BAR;
            PG8_LDA(At, 0, 1); PG8_STAGE(PG8_SA(0, 0), a2, voffA);
            PG8_BAR; PG8_WAIT_L(0); PG8_MMA(1, 0, At, B0); PG8_BAR; PG8_SCHED;
            PG8_STAGE(PG8_SB(0, 1), b2 + hstep, voffB);
            PG8_WAIT_V(6); PG8_BAR; PG8_MMA(1, 1, At, B1); PG8_BAR;
            PG8_LDB(B0, 1, 0); PG8_SCHED; PG8_LDA(At, 1, 0); PG8_STAGE(PG8_SA(0, 1), a2 + hstep, voffA);
            PG8_WAIT_L(8); PG8_BAR; PG8_WAIT_L(0); PG8_MMA(0, 0, At, B0); PG8_BAR; PG8_SCHED;
            PG8_LDB(B1, 1, 1); PG8_STAGE(PG8_SB(1, 0), b3, voffB);
            PG8_BAR; PG8_WAIT_L(0); PG8_MMA(0, 1, At, B1); PG8_BAR;
            PG8_LDA(At, 1, 1); PG8_STAGE(PG8_SA(1, 0), a3, voffA);
            PG8_BAR; PG8_WAIT_L(0); PG8_MMA(1, 0, At, B0); PG8_BAR; PG8_SCHED;
            PG8_STAGE(PG8_SB(1, 1), b3 + hstep, voffB);
            PG8_WAIT_V(6); PG8_BAR; PG8_MMA(1, 1, At, B1); PG8_BAR;
            }
        }
        if constexpr (ALIGN_EPI) { if (wr == 0) PG8_BAR; }
        if constexpr (!Epi::AFTER_DRAIN) { E(acc, cur, wr, wc, fr, fq); S.done(cur); }
        if (!has_next) break;
#pragma unroll
        for (int a = 0; a < 2; ++a)
#pragma unroll
            for (int b = 0; b < 2; ++b)
#pragma unroll
                for (int m = 0; m < 4; ++m)
#pragma unroll
                    for (int n = 0; n < 2; ++n) acc[a][b][m][n] = (f32x4){0.f, 0.f, 0.f, 0.f};
        cur = nxt; cA = nA; cB = nB; ++ui;
        if constexpr (ALIGN_EPI) { if (wr == 1) PG8_BAR; }
    }
    PG8_WAIT_V(0);
    if constexpr (!ALIGN_EPI) { if (wr == 0) PG8_BAR; }
    PG8_BAR;
    if constexpr (Epi::AFTER_DRAIN) { E.fused(acc, cur, wr, wc, fr, fq, lds, wid, lane); S.done(cur); }
#undef PG8_SA
#undef PG8_SB
#undef PG8_STAGE
#undef PG8_LDA
#undef PG8_LDB
#undef PG8_MMA
#undef PG8_WAIT_V
#undef PG8_WAIT_L
#undef PG8_BAR
#undef PG8_SCHED
}
}
#define GAS __attribute__((address_space(1)))
#define LAS __attribute__((address_space(3)))
typedef unsigned short bf16;
typedef unsigned v4u __attribute__((ext_vector_type(4)));
typedef float f32x4 __attribute__((ext_vector_type(4)));
typedef short bf16x8 __attribute__((ext_vector_type(8)));
typedef GAS unsigned gu32;
typedef GAS unsigned long long gu64;
#define RLX_AGENT __ATOMIC_RELAXED, __HIP_MEMORY_SCOPE_AGENT
#define LDS_WAIT() asm volatile("s_waitcnt lgkmcnt(0)" ::: "memory")
#define VM_WAIT() asm volatile("s_waitcnt vmcnt(0)" ::: "memory")
__device__ __forceinline__ unsigned long long rt() { return __builtin_amdgcn_s_memrealtime(); }
__device__ __forceinline__ unsigned f2bf(float f) { unsigned u = __builtin_bit_cast(unsigned, f); return (u + 0x7fffu + ((u >> 16) & 1u)) >> 16; }
__device__ __forceinline__ unsigned pk2(float lo, float hi) { return f2bf(lo) | (f2bf(hi) << 16); }

#define XB_TMO      128
#define XB_XCNT(j)  (256  + 64 * (j))
#define XB_XSUB(j)  (1280 + 64 * (j))
#define XB_XGEN(j)  (2304 + 64 * (j))
#define XB_TOP      3328
#define XB_TOPGEN   3392
#define XCD_BAR_WORDS 3456
#define XB_SPIN_CAP (1u << 18)

__device__ __forceinline__ unsigned xb_ld(unsigned* p)              { return __hip_atomic_load(p, __ATOMIC_RELAXED, __HIP_MEMORY_SCOPE_AGENT); }
__device__ __forceinline__ unsigned xb_add(unsigned* p, unsigned v) { return __hip_atomic_fetch_add(p, v, __ATOMIC_RELAXED, __HIP_MEMORY_SCOPE_AGENT); }
__device__ __forceinline__ unsigned xb_xcc_id() { return (unsigned)__builtin_amdgcn_s_getreg((3 << 11) | 20) & 0xFu; }
#define XB_SPIN(cond, bar) do { unsigned _sp = 0; while (cond) { __builtin_amdgcn_s_sleep(1); \
    if ((++_sp & 255u) == 0u) { if (xb_ld(&(bar)[XB_TMO])) break; if (_sp > XB_SPIN_CAP) { atomicAdd(&(bar)[XB_TMO], 1u); break; } } } } while (0)

struct XcdBarrier {
    unsigned* bar; unsigned x;
    volatile LAS unsigned* st;
};

__device__ __forceinline__ XcdBarrier xcd_barrier_post(unsigned* bar, volatile LAS unsigned* st) {
    XcdBarrier b; b.bar = bar; b.x = xb_xcc_id(); b.st = st;
    if (threadIdx.x == 0) (void)xb_add(&bar[XB_XCNT(b.x)], 1u);
    return b;
}
__device__ __forceinline__ void xcd_barrier_complete(unsigned* bar, unsigned x, unsigned& nloc, unsigned& nx) {
    const unsigned G = gridDim.x * gridDim.y * gridDim.z;
    unsigned sum, cnt, mine, sp = 0u;
    for (;;) {
        sum = 0u; cnt = 0u; mine = 0u;
#pragma unroll
        for (unsigned j = 0; j < 16; ++j) { const unsigned c = xb_ld(&bar[XB_XCNT(j)]); sum += c; cnt += (c > 0u) ? 1u : 0u; mine = (j == x) ? c : mine; }
        if (sum == G) break;
        __builtin_amdgcn_s_sleep(1);
        if ((++sp & 255u) == 0u) { if (xb_ld(&bar[XB_TMO])) break; if (sp > XB_SPIN_CAP) { atomicAdd(&bar[XB_TMO], 1u); break; } }
    }
    nloc = mine > 0u ? mine : 1u; nx = cnt > 0u ? cnt : 1u;
}

__device__ __forceinline__ void xcd_barrier(const XcdBarrier& b) {
    asm volatile("s_waitcnt vmcnt(0)" ::: "memory");
    __syncthreads();
    if (threadIdx.x == 0) {
        unsigned* bar = b.bar;
        __builtin_amdgcn_s_waitcnt(0);
        unsigned nloc = b.st[0], nx = b.st[1];
        if (nloc == 0u) { xcd_barrier_complete(bar, b.x, nloc, nx); b.st[0] = nloc; b.st[1] = nx; }
        const unsigned old = xb_add(&bar[XB_XSUB(b.x)], 1u);
        const unsigned gen = old / nloc;
        if (old + 1u == (gen + 1u) * nloc) {
            __builtin_amdgcn_fence(__ATOMIC_RELEASE, "agent");
            asm volatile("s_waitcnt vmcnt(0)" ::: "memory");
            const unsigned og = xb_add(&bar[XB_TOP], 1u);
            const unsigned tg = og / nx;
            if (og + 1u == (tg + 1u) * nx) xb_add(&bar[XB_TOPGEN], 1u);
            else XB_SPIN(xb_ld(&bar[XB_TOPGEN]) == tg, bar);
            __builtin_amdgcn_fence(__ATOMIC_ACQUIRE, "agent");
            xb_add(&bar[XB_XGEN(b.x)], 1u);
            asm volatile("s_waitcnt vmcnt(0)" ::: "memory");
        } else {
            XB_SPIN(xb_ld(&bar[XB_XGEN(b.x)]) == gen, bar);
            __builtin_amdgcn_fence(__ATOMIC_ACQUIRE, "agent");
            asm volatile("s_waitcnt vmcnt(0)" ::: "memory");
        }
    }
    __syncthreads();
}

constexpr int NWAVES = 8;
constexpr int BATCH = 2, SEQ = 8192, DM = 4096, M = BATCH * SEQ;
constexpr int NZ = 15104;
constexpr int NADA = 6 * DM;
constexpr int IN_W = 14912;
constexpr float NORM_EPS = 1e-6f;
constexpr float LOG2E = 1.4426950408889634f;

constexpr size_t MiB = 1u << 20;
constexpr size_t WS_CTL = 0, CTL_ZERO_BYTES = 1 * MiB;
constexpr size_t WS_ADA = 1 * MiB;
constexpr size_t WS_ROPE = 2 * MiB;
constexpr size_t WS_SUBK = 4 * MiB;
constexpr size_t WS_RSQ = 5 * MiB;
constexpr size_t WS_ADAP = 9 * MiB;
constexpr size_t WS_WIN = 22 * MiB;
constexpr size_t WS_WQB = 140 * MiB;
constexpr size_t WS_WKVB = 152 * MiB;
constexpr size_t WS_WOUT = 160 * MiB;
constexpr size_t WS_WPQ = 192 * MiB;
constexpr size_t WS_H = 208 * MiB;
constexpr size_t WS_ZQ = 336 * MiB;
constexpr size_t WS_ZSQ = 368 * MiB;
constexpr size_t WS_ZA = 496 * MiB;
constexpr size_t WS_ZB = 624 * MiB;
constexpr size_t WS_ZSK = 752 * MiB;
constexpr size_t WS_ZSV = 768 * MiB;
constexpr size_t WS_ZKV = 784 * MiB;
constexpr size_t WS_ZQN = 808 * MiB;
constexpr size_t WS_CKV = 840 * MiB;
constexpr size_t WS_KPE = 856 * MiB;
constexpr size_t WS_QN = 860 * MiB;
constexpr size_t WS_QP = 988 * MiB;
constexpr size_t WS_KN = 1052 * MiB;
constexpr size_t WS_VM = 1180 * MiB;
constexpr size_t WS_OA = 1308 * MiB;
constexpr size_t WS_END = 1436 * MiB;
constexpr size_t WS_T = WS_ZSQ;
constexpr size_t WS_PQ = WS_ZA;
constexpr size_t WS_EXP = WS_ZA + 64 * MiB;
constexpr size_t WS_GATE = WS_ZA + 72 * MiB;
constexpr size_t WS_UB = WS_QN;
constexpr size_t WS_VB = WS_KN;
constexpr int CW_TMO = 0, CW_CODE = 1;
constexpr int CW_BAR = 4096;

constexpr int RING_OFF = 0, RING_BYTES = 131072;
constexpr int LDSCTL_OFF = RING_BYTES, MISC_OFF = LDSCTL_OFF + 320;
constexpr int LDS_BYTES = 147456;


typedef __bf16 bf16x2_t __attribute__((ext_vector_type(2)));
struct Frame {
    LAS unsigned char* lds;
    volatile LAS unsigned* MISC;
    gu32* ctl;
    int tid, lane, wave;
    int vcu, G;
};
__device__ __forceinline__ float wave_sum(float v) {
#pragma unroll
    for (int o = 1; o < 64; o <<= 1) v += __shfl_xor(v, o);
    return v;
}
__device__ __forceinline__ float bflo(unsigned w) { return __uint_as_float(w << 16); }
__device__ __forceinline__ float bfhi(unsigned w) { return __uint_as_float(w & 0xffff0000u); }
__device__ __forceinline__ unsigned cvtpk(float lo, float hi) { unsigned r; asm volatile("v_cvt_pk_bf16_f32 %0, %1, %2" : "=v"(r) : "v"(lo), "v"(hi)); return r; }
__device__ __forceinline__ float dot2bf(unsigned a, unsigned b, float acc) { return __builtin_amdgcn_fdot2_f32_bf16(__builtin_bit_cast(bf16x2_t, a), __builtin_bit_cast(bf16x2_t, b), acc, false); }

struct MapId { __device__ __forceinline__ int operator()(int n) const { return n; } };
struct MapWin { __device__ __forceinline__ int operator()(int n) const {
    if (n < 1024) return n;
    if (n < 5120) return 1600 + (n - 1024);
    if (n < 9216) return 6720 + (n - 5120);
    if (n < 13312) return 10816 + (n - 9216);
    if (n < 13824) return 5696 + (n - 13312);
    if (n < 14336) return 6208 + (n - 13824);
    if (n < 14912) return 1024 + (n - 14336);
    return -1; } };
struct MapWqb { __device__ __forceinline__ int operator()(int n) const {
    if (n < 4096) return (n >> 7) * 192 + (n & 127);
    const int m = n - 4096, h = m >> 6, p = m & 63, dim = (p >> 1) + ((p & 1) << 5);
    return h * 192 + 128 + dim; } };
struct MapWkvb { __device__ __forceinline__ int operator()(int n) const {
    if (n < 4096) return (n >> 7) * 256 + (n & 127);
    const int m = n - 4096; return (m >> 7) * 256 + 128 + (m & 127); } };
template <class Map>
__device__ __forceinline__ void transpose_item(const float* W, int K, int N, bf16* WT, LAS float* scr, int item, int nblk, int lane, const Map& map) {
    const int kb = item / nblk, nb = item % nblk, k0 = 64 * kb, n0 = 32 * nb;
    const int sc = map(n0 + (lane & 31));
#pragma unroll 8
    for (int i = 0; i < 32; ++i) { const int kk = 2 * i + (lane >> 5); scr[kk * 33 + (lane & 31)] = sc >= 0 ? W[(size_t)(k0 + kk) * N + sc] : 0.f; }
    LDS_WAIT(); asm volatile("" ::: "memory");
    const int c = lane & 7;
#pragma unroll
    for (int j = 0; j < 4; ++j) { const int n = (lane >> 3) + 8 * j; const LAS float* s = scr + (8 * c) * 33 + n;
        v4u o; o.x = pk2(s[0 * 33], s[1 * 33]); o.y = pk2(s[2 * 33], s[3 * 33]); o.z = pk2(s[4 * 33], s[5 * 33]); o.w = pk2(s[6 * 33], s[7 * 33]);
        *(GAS v4u*)(WT + (size_t)(n0 + n) * K + k0 + 8 * c) = o; }
    LDS_WAIT(); asm volatile("" ::: "memory");
}
__device__ __forceinline__ void convert_bf16(Frame& F, const float* src, bf16* dst, size_t n8) {
    const size_t nthr = (size_t)F.G * 512, t0 = (size_t)blockIdx.x * 512 + F.tid;
    for (size_t i = t0; i < n8; i += nthr) { const f32x4 a = *(const GAS f32x4*)(src + i * 8), b = *(const GAS f32x4*)(src + i * 8 + 4);
        v4u o; o.x = cvtpk(a.x, a.y); o.y = cvtpk(a.z, a.w); o.z = cvtpk(b.x, b.y); o.w = cvtpk(b.z, b.w); *(GAS v4u*)(dst + i * 8) = o; }
}

__device__ __forceinline__ void p0_prologue(Frame& F, const float* c, const float* w_ada, const float* w_in, const float* w_q_b, const float* w_kv_b, const float* w_out,
                                            const float* w_peer_q, const float* sub_keys, unsigned char* ws) {
    { LAS float* sl = (LAS float*)(F.lds);
      float* adap = (float*)(ws + WS_ADAP);
      for (int w = blockIdx.x; w < 256; w += F.G) {
          const int kc = w >> 2, cq = w & 3;
          __syncthreads();
          if (F.tid < 128) { const int b = F.tid >> 6, kk = F.tid & 63; const float v = c[b * DM + kc * 64 + kk]; sl[F.tid] = v / (1.f + __expf(-v)); }
          __syncthreads();
          for (int cg = F.tid; cg < 1536; cg += 512) {
              const int col = cq * 6144 + 4 * cg; f32x4 a0 = {0.f, 0.f, 0.f, 0.f}, a1 = {0.f, 0.f, 0.f, 0.f};
              const float* wp = w_ada + (size_t)(kc * 64) * NADA + col;
#pragma unroll 8
              for (int kk = 0; kk < 64; ++kk) { const f32x4 w4 = *(const GAS f32x4*)(wp + (size_t)kk * NADA); a0 += w4 * sl[kk]; a1 += w4 * sl[64 + kk]; }
              *(GAS f32x4*)(adap + (size_t)(kc * 2 + 0) * NADA + col) = a0;
              *(GAS f32x4*)(adap + (size_t)(kc * 2 + 1) * NADA + col) = a1;
          }
      }
      __syncthreads(); }
    { float* rc = (float*)(ws + WS_ROPE); float* rs = rc + SEQ * 32;
      for (int e = blockIdx.x * 512 + F.tid; e < SEQ * 32; e += F.G * 512) { const int pos = e >> 5, i = e & 31;
          const float invf = exp2f(-(float)(2 * i) * (13.287712379549449f / 64.f));
          const float ang = (float)pos * invf;
          double t = (double)ang * 0.15915494309189535; t -= floor(t);
          const float r = (float)(t * 6.283185307179586);
          rc[e] = cosf(r); rs[e] = sinf(r); } }
    convert_bf16(F, sub_keys, (bf16*)(ws + WS_SUBK), (size_t)16 * 128 * 128 / 8);
    { LAS float* scr = (LAS float*)(F.lds + RING_OFF + F.wave * 16384);
      const int gw = F.vcu * NWAVES + F.wave, NGW = F.G * NWAVES;
      constexpr int I_IN = 64 * (NZ / 32), I_QB = 16 * (6144 / 32), I_KVB = 8 * (8192 / 32), I_OUT = 64 * (4096 / 32), I_PQ = 64 * (2048 / 32);
      constexpr int NITEMS = I_IN + I_QB + I_KVB + I_OUT + I_PQ;
      for (int it = gw; it < NITEMS; it += NGW) {
          int r = it;
          if (r < I_IN) { transpose_item(w_in, DM, IN_W, (bf16*)(ws + WS_WIN), scr, r, NZ / 32, F.lane, MapWin()); continue; } r -= I_IN;
          if (r < I_QB) { transpose_item(w_q_b, 1024, 6144, (bf16*)(ws + WS_WQB), scr, r, 6144 / 32, F.lane, MapWqb()); continue; } r -= I_QB;
          if (r < I_KVB) { transpose_item(w_kv_b, 512, 8192, (bf16*)(ws + WS_WKVB), scr, r, 8192 / 32, F.lane, MapWkvb()); continue; } r -= I_KVB;
          if (r < I_OUT) { transpose_item(w_out, DM, DM, (bf16*)(ws + WS_WOUT), scr, r, 4096 / 32, F.lane, MapId()); continue; } r -= I_OUT;
          transpose_item(w_peer_q, DM, 2048, (bf16*)(ws + WS_WPQ), scr, r, 2048 / 32, F.lane, MapId());
      } }
}
__device__ __forceinline__ void p1_ada_reduce(Frame& F, const float* b_ada, unsigned char* ws) {
    const float* adap = (const float*)(ws + WS_ADAP); float* ada = (float*)(ws + WS_ADA);
    for (int o = blockIdx.x * 512 + F.tid; o < 2 * NADA; o += F.G * 512) { const int b = o / NADA, j = o - b * NADA; float s = b_ada[j];
#pragma unroll 8
        for (int kc = 0; kc < 64; ++kc) s += adap[(size_t)(kc * 2 + b) * NADA + j];
        ada[o] = s; }
}
__device__ __forceinline__ void p2_modnorm(Frame& F, const float* x, const float* g, unsigned char* ws) {
    const int gw = F.vcu * NWAVES + F.wave, NGW = F.G * NWAVES; const float* ada = (const float*)(ws + WS_ADA); bf16* H = (bf16*)(ws + WS_H);
    for (int m = gw; m < M; m += NGW) { const int b = m >> 13;
        const GAS f32x4* xr = (const GAS f32x4*)(x + (size_t)m * DM) + F.lane; f32x4 v[16]; float s = 0.f;
#pragma unroll
        for (int j = 0; j < 16; ++j) { v[j] = xr[64 * j]; s += (v[j].x * v[j].x + v[j].y * v[j].y) + (v[j].z * v[j].z + v[j].w * v[j].w); }
        const float rstd = 1.0f / sqrtf(wave_sum(s) * (1.f / DM) + NORM_EPS);
        const float* sh = ada + b * NADA, * sc = ada + b * NADA + DM;
        GAS unsigned long long* o8 = (GAS unsigned long long*)(H + (size_t)m * DM) + F.lane;
#pragma unroll
        for (int j = 0; j < 16; ++j) { const int col = 4 * F.lane + 256 * j;
            const f32x4 g4 = *(const f32x4*)(g + col), s4 = *(const f32x4*)(sc + col), h4 = *(const f32x4*)(sh + col);
            const f32x4 o = v[j] * rstd * g4 * (s4 + 1.0f) + h4;
            o8[64 * j] = (unsigned long long)cvtpk(o.x, o.y) | ((unsigned long long)cvtpk(o.z, o.w) << 32); }
    }
}
__device__ __forceinline__ void p4_latent(Frame& F, const float* g_q, const float* g_kv, unsigned char* ws) {
    const int gw = F.vcu * NWAVES + F.wave, NGW = F.G * NWAVES;
    const bf16* ZQ = (const bf16*)(ws + WS_ZQ); const bf16* ZKV = (const bf16*)(ws + WS_ZKV);
    bf16* ZQN = (bf16*)(ws + WS_ZQN); bf16* CKV = (bf16*)(ws + WS_CKV); bf16* KPE = (bf16*)(ws + WS_KPE);
    const float* rc = (const float*)(ws + WS_ROPE); const float* rs = rc + SEQ * 32;
    for (int m = gw; m < M; m += NGW) {
        { v4u a[2]; float f[16]; float s = 0.f;
#pragma unroll
          for (int j = 0; j < 2; ++j) { a[j] = *(const GAS v4u*)(ZQ + (size_t)m * 1024 + 512 * j + 8 * F.lane);
              f[8 * j + 0] = bflo(a[j].x); f[8 * j + 1] = bfhi(a[j].x); f[8 * j + 2] = bflo(a[j].y); f[8 * j + 3] = bfhi(a[j].y);
              f[8 * j + 4] = bflo(a[j].z); f[8 * j + 5] = bfhi(a[j].z); f[8 * j + 6] = bflo(a[j].w); f[8 * j + 7] = bfhi(a[j].w); }
#pragma unroll
          for (int e = 0; e < 16; ++e) s += f[e] * f[e];
          const float rstd = 1.0f / sqrtf(wave_sum(s) * (1.f / 1024.f) + NORM_EPS);
#pragma unroll
          for (int j = 0; j < 2; ++j) { const int col = 512 * j + 8 * F.lane; const f32x4 g0 = *(const f32x4*)(g_q + col), g1 = *(const f32x4*)(g_q + col + 4);
              v4u o; o.x = cvtpk(f[8 * j + 0] * rstd * g0.x, f[8 * j + 1] * rstd * g0.y); o.y = cvtpk(f[8 * j + 2] * rstd * g0.z, f[8 * j + 3] * rstd * g0.w);
              o.z = cvtpk(f[8 * j + 4] * rstd * g1.x, f[8 * j + 5] * rstd * g1.y); o.w = cvtpk(f[8 * j + 6] * rstd * g1.z, f[8 * j + 7] * rstd * g1.w);
              *(GAS v4u*)(ZQN + (size_t)m * 1024 + col) = o; } }
        { const v4u a = *(const GAS v4u*)(ZKV + (size_t)m * 768 + 8 * F.lane); float f[8];
          f[0] = bflo(a.x); f[1] = bfhi(a.x); f[2] = bflo(a.y); f[3] = bfhi(a.y); f[4] = bflo(a.z); f[5] = bfhi(a.z); f[6] = bflo(a.w); f[7] = bfhi(a.w);
          float s = 0.f;
#pragma unroll
          for (int e = 0; e < 8; ++e) s += f[e] * f[e];
          const float rstd = 1.0f / sqrtf(wave_sum(s) * (1.f / 512.f) + NORM_EPS);
          const int col = 8 * F.lane; const f32x4 g0 = *(const f32x4*)(g_kv + col), g1 = *(const f32x4*)(g_kv + col + 4);
          v4u o; o.x = cvtpk(f[0] * rstd * g0.x, f[1] * rstd * g0.y); o.y = cvtpk(f[2] * rstd * g0.z, f[3] * rstd * g0.w);
          o.z = cvtpk(f[4] * rstd * g1.x, f[5] * rstd * g1.y); o.w = cvtpk(f[6] * rstd * g1.z, f[7] * rstd * g1.w);
          *(GAS v4u*)(CKV + (size_t)m * 512 + col) = o; }
        if (F.lane < 32) { const int pos = m & (SEQ - 1);
          const float x1 = __uint_as_float((unsigned)ZKV[(size_t)m * 768 + 512 + F.lane] << 16), x2 = __uint_as_float((unsigned)ZKV[(size_t)m * 768 + 544 + F.lane] << 16);
          const float cc = rc[pos * 32 + F.lane], ss = rs[pos * 32 + F.lane];
          *(GAS unsigned*)(KPE + (size_t)m * 64 + 2 * F.lane) = cvtpk(x1 * cc - x2 * ss, x2 * cc + x1 * ss); }
    }
}
__device__ __forceinline__ void p9_post_attn(Frame& F, const float* x, const float* g_post, const float* g_ffn_pre, float* out, unsigned char* ws) {
    const int gw = F.vcu * NWAVES + F.wave, NGW = F.G * NWAVES; const float* ada = (const float*)(ws + WS_ADA);
    const bf16* T = (const bf16*)(ws + WS_T); const float* rsq = (const float*)(ws + WS_RSQ); bf16* H2 = (bf16*)(ws + WS_H);
    for (int m = gw; m < M; m += NGW) { const int b = m >> 13;
        const float rstd = 1.0f / sqrtf(wave_sum(rsq[(size_t)m * 64 + F.lane]) * (1.f / DM) + NORM_EPS);
        const float* ga = ada + b * NADA + 2 * DM, * shf = ada + b * NADA + 3 * DM, * scf = ada + b * NADA + 4 * DM;
        float x1[64]; float s2 = 0.f;
#pragma unroll
        for (int j = 0; j < 8; ++j) { const int col = 8 * F.lane + 512 * j;
            const v4u t = *(const GAS v4u*)(T + (size_t)m * DM + col);
            const f32x4 xa = *(const GAS f32x4*)(x + (size_t)m * DM + col), xb = *(const GAS f32x4*)(x + (size_t)m * DM + col + 4);
            const f32x4 g0 = *(const f32x4*)(g_post + col), g1 = *(const f32x4*)(g_post + col + 4), a0 = *(const f32x4*)(ga + col), a1 = *(const f32x4*)(ga + col + 4);
            float* o = x1 + 8 * j;
            o[0] = xa.x + a0.x * (bflo(t.x) * rstd * g0.x); o[1] = xa.y + a0.y * (bfhi(t.x) * rstd * g0.y); o[2] = xa.z + a0.z * (bflo(t.y) * rstd * g0.z); o[3] = xa.w + a0.w * (bfhi(t.y) * rstd * g0.w);
            o[4] = xb.x + a1.x * (bflo(t.z) * rstd * g1.x); o[5] = xb.y + a1.y * (bfhi(t.z) * rstd * g1.y); o[6] = xb.z + a1.z * (bflo(t.w) * rstd * g1.z); o[7] = xb.w + a1.w * (bfhi(t.w) * rstd * g1.w);
            *(GAS f32x4*)(out + (size_t)m * DM + col) = (f32x4){o[0], o[1], o[2], o[3]}; *(GAS f32x4*)(out + (size_t)m * DM + col + 4) = (f32x4){o[4], o[5], o[6], o[7]};
#pragma unroll
            for (int e = 0; e < 8; ++e) s2 += o[e] * o[e]; }
        const float rstd2 = 1.0f / sqrtf(wave_sum(s2) * (1.f / DM) + NORM_EPS);
#pragma unroll
        for (int j = 0; j < 8; ++j) { const int col = 8 * F.lane + 512 * j; const float* o = x1 + 8 * j;
            const f32x4 g0 = *(const f32x4*)(g_ffn_pre + col), g1 = *(const f32x4*)(g_ffn_pre + col + 4), c0 = *(const f32x4*)(scf + col), c1 = *(const f32x4*)(scf + col + 4),
                        h0 = *(const f32x4*)(shf + col), h1 = *(const f32x4*)(shf + col + 4);
            v4u w; w.x = cvtpk(o[0] * rstd2 * g0.x * (1.f + c0.x) + h0.x, o[1] * rstd2 * g0.y * (1.f + c0.y) + h0.y);
            w.y = cvtpk(o[2] * rstd2 * g0.z * (1.f + c0.z) + h0.z, o[3] * rstd2 * g0.w * (1.f + c0.w) + h0.w);
            w.z = cvtpk(o[4] * rstd2 * g1.x * (1.f + c1.x) + h1.x, o[5] * rstd2 * g1.y * (1.f + c1.y) + h1.y);
            w.w = cvtpk(o[6] * rstd2 * g1.z * (1.f + c1.z) + h1.z, o[7] * rstd2 * g1.w * (1.f + c1.w) + h1.w);
            *(GAS v4u*)(H2 + (size_t)m * DM + col) = w; }
    }
}

namespace mla {
typedef short bf16x8 __attribute__((ext_vector_type(8)));
typedef short s16x4 __attribute__((ext_vector_type(4)));
typedef float f32x16 __attribute__((ext_vector_type(16)));
typedef unsigned u32x4 __attribute__((ext_vector_type(4)));
typedef unsigned short bf16;
#ifndef MLA_QP_LDS
#define MLA_QP_LDS 0
#endif
constexpr int NW = 8, QBLK = 32, KVBLK = 64, QB = NW * QBLK;
constexpr int PQN = 4096, PQP = 2048, PKN = 4096, PKP = 64, PVV = 4096, PO = 4096;
constexpr int SLOT_K = 16384, SLOT_V = 16384, SLOT_P = 8192;
constexpr int OFF_K = 0, OFF_V = 3 * SLOT_K, OFF_KP = OFF_V + 3 * SLOT_V, OFF_QP = OFF_KP + 3 * SLOT_P, OFF_WS = OFF_QP + (MLA_QP_LDS ? NW * 4096 : 0), LDS_BYTES = OFF_WS + NW * 64 * 4;
constexpr float SCALE = 0.07216878364870322f;
constexpr float THR = 8.f;
#define SBAR() __builtin_amdgcn_sched_barrier(0)
__device__ __forceinline__ int crow(int r, int hi) { return (r & 3) + 8 * (r >> 2) + 4 * hi; }
__device__ __forceinline__ unsigned cvtpk(float lo, float hi) { unsigned r; asm volatile("v_cvt_pk_bf16_f32 %0, %1, %2" : "=v"(r) : "v"(lo), "v"(hi)); return r; }
__device__ __forceinline__ bf16x8 load8(const bf16* p) { return *reinterpret_cast<const bf16x8*>(p); }
__device__ __forceinline__ void mask_tile(f32x16& p0, f32x16& p1, int dq) {
    const float NEG = -__builtin_inff();
#pragma unroll
    for (int r = 0; r < 16; ++r) { const int c = (r & 3) + 8 * (r >> 2);
        if (dq - c < 0) p0[r] = NEG;
        if (dq - c - 32 < 0) p1[r] = NEG; }
}
__device__ __forceinline__ void partialSM(f32x16& p0, f32x16& p1, float& m_reg, float& mn, float& alpha) {
    float pmax = p0[0];
#pragma unroll
    for (int r = 1; r < 16; ++r) pmax = fmaxf(pmax, p0[r]);
#pragma unroll
    for (int r = 0; r < 16; ++r) pmax = fmaxf(pmax, p1[r]);
    { auto rr = __builtin_amdgcn_permlane32_swap(__float_as_uint(pmax), __float_as_uint(pmax), false, false);
      pmax = fmaxf(__uint_as_float(rr[0]), __uint_as_float(rr[1])); }
    constexpr float C2 = 1.4426950408889634f * SCALE;
    if (__builtin_expect(__all((pmax - m_reg) * SCALE <= THR), 1)) { mn = m_reg; alpha = 1.f; }
    else { mn = fmaxf(m_reg, pmax); alpha = __builtin_amdgcn_exp2f((m_reg - mn) * C2); m_reg = mn; }
    const float mnL = -mn * C2;
#pragma unroll
    for (int r = 0; r < 16; ++r) p0[r] = fmaf(p0[r], C2, mnL);
#pragma unroll
    for (int r = 0; r < 16; ++r) p1[r] = fmaf(p1[r], C2, mnL);
#pragma unroll
    for (int r = 0; r < 16; ++r) p0[r] = __builtin_amdgcn_exp2f(p0[r]);
}
#define MLA_PK4(P, B_, OUT) do { unsigned a0 = cvtpk(P[B_+0], P[B_+1]), a1 = cvtpk(P[B_+2], P[B_+3]);                          \
        unsigned b0 = cvtpk(P[B_+4], P[B_+5]), b1 = cvtpk(P[B_+6], P[B_+7]);                                             \
        auto r0 = __builtin_amdgcn_permlane32_swap(a0, b0, false, false); auto r1 = __builtin_amdgcn_permlane32_swap(a1, b1, false, false); \
        u32x4 w = {r0[0], r1[0], r0[1], r1[1]}; OUT = *reinterpret_cast<bf16x8*>(&w); } while (0)
__device__ __forceinline__ void finishSM(f32x16& p0, f32x16& p1, float alpha, float& l_reg, bf16x8& pa0, bf16x8& pa1, bf16x8& pa2, bf16x8& pa3) {
#pragma unroll
    for (int r = 0; r < 16; ++r) p1[r] = __builtin_amdgcn_exp2f(p1[r]);
    float ps = 0;
#pragma unroll
    for (int r = 0; r < 16; ++r) ps += p0[r];
#pragma unroll
    for (int r = 0; r < 16; ++r) ps += p1[r];
    { auto rr = __builtin_amdgcn_permlane32_swap(__float_as_uint(ps), __float_as_uint(ps), false, false);
      ps = __uint_as_float(rr[0]) + __uint_as_float(rr[1]); }
    l_reg = l_reg * alpha + ps;
    MLA_PK4(p0, 0, pa0); MLA_PK4(p0, 8, pa1); MLA_PK4(p1, 0, pa2); MLA_PK4(p1, 8, pa3);
}
#define MLA_GLDS(gp, ldsoff) __builtin_amdgcn_global_load_lds((const unsigned*)(gp), (__attribute__((address_space(3))) unsigned*)(lds3 + (ldsoff)), 16, 0, 0)
#define MLA_WAITBAR(N) asm volatile("s_waitcnt vmcnt(" #N ") lgkmcnt(0)\n\ts_barrier" ::: "memory")
__device__ __forceinline__ void mla_block(const unsigned char* wsb, int b, int h, int qb, char* lds) {
    typedef __attribute__((address_space(3))) unsigned char* lds3_t;
    const lds3_t lds3 = (lds3_t)lds;
    const int tid = threadIdx.x, wid = __builtin_amdgcn_readfirstlane(tid >> 6), lane = tid & 63, r32 = lane & 31, hi = lane >> 5;
    const int P0 = qb * QB; const int NT = (P0 + QB) / KVBLK;
    const int qlo = P0 + wid * QBLK, qm = qlo + r32 - 4 * hi;
    float* ws = (float*)(lds + OFF_WS) + wid * 64; float* li_l = ws, * al_l = ws + 32;
    unsigned offK, offV, offP;
    { const int row = 4 * wid + (lane >> 4), sl = lane & 15, ch = sl ^ (row & 7); offK = (unsigned)(row * PKN + ch * 8); }
    { const int st = 2 * wid + (lane >> 5), kg = st >> 2, cblk = st & 3, kk = kg * 8 + ((lane & 31) >> 2), k = (kk & ~0xC) | ((kk & 4) << 1) | ((kk & 8) >> 1), c = cblk * 32 + (lane & 3) * 8;
      offV = (unsigned)(k * PVV + c); }
    { const int row = 8 * wid + (lane >> 3), sl = lane & 7, ch = sl ^ ((row >> 1) & 7); offP = (unsigned)(row * PKP + ch * 8); }
    const bf16* kn = (const bf16*)(wsb + WS_KN) + (size_t)b * 8192 * PKN + h * 128; const bf16* kp = (const bf16*)(wsb + WS_KPE) + (size_t)b * 8192 * PKP; const bf16* vv = (const bf16*)(wsb + WS_VM) + (size_t)b * 8192 * PVV + h * 128;
    const size_t row0 = (size_t)b * 8192 + (size_t)P0 + wid * QBLK;
#define DMA_K(t, slot) do { const bf16* b_ = kn + (size_t)(t) * (KVBLK * PKN); const int d_ = __builtin_amdgcn_readfirstlane(OFF_K + (slot) * SLOT_K + wid * 1024);   \
        unsigned ok_ = offK, op_ = offP; asm volatile("" : "+v"(ok_), "+v"(op_));   \
        MLA_GLDS(b_ + ok_, d_); MLA_GLDS(b_ + 32 * PKN + ok_, d_ + 8192);                                                                                      \
        const bf16* bp_ = kp + (size_t)(t) * (KVBLK * PKP); MLA_GLDS(bp_ + op_, __builtin_amdgcn_readfirstlane(OFF_KP + (slot) * SLOT_P + wid * 1024)); } while (0)
#define DMA_V(t, slot) do { const bf16* b_ = vv + (size_t)(t) * (KVBLK * PVV); const int d_ = __builtin_amdgcn_readfirstlane(OFF_V + (slot) * SLOT_V + wid * 1024);   \
        unsigned ov_ = offV; asm volatile("" : "+v"(ov_));   \
        MLA_GLDS(b_ + ov_, d_); MLA_GLDS(b_ + 32 * PVV + ov_, d_ + 8192); } while (0)
    int kbo[4];
#pragma unroll
    for (int dd = 0; dd < 4; ++dd) kbo[dd] = OFF_K + r32 * 256 + (((dd * 16 + hi * 8) * 2) ^ ((r32 & 7) << 4));
    int kpo[4];
#pragma unroll
    for (int e = 0; e < 4; ++e) kpo[e] = OFF_KP + r32 * 128 + (((2 * e + hi) ^ ((r32 >> 1) & 7)) << 4);
    const int vb0 = (int)(uintptr_t)lds + OFF_V + (((lane & 3) << 3) | (((lane >> 2) & 3) << 6) | (((lane >> 4) & 1) << 5) | (((lane >> 5) & 1) << 8));
    DMA_K(0, 0); DMA_V(0, 0); DMA_K(1, 1);
    bf16x8 qr[8];
    unsigned qon = (unsigned)(r32 * PQN + hi * 8), qop = (unsigned)(r32 * PQP + hi * 8); asm volatile("" : "+v"(qon), "+v"(qop));
#pragma unroll
    for (int d0 = 0; d0 < 8; ++d0) qr[d0] = load8((const bf16*)(wsb + WS_QN) + row0 * PQN + h * 128 + d0 * 16 + qon);
#if MLA_QP_LDS
    { char* qpl = lds + OFF_QP + wid * 4096 + lane * 16;
#pragma unroll
      for (int e = 0; e < 4; ++e) *(bf16x8*)(qpl + e * 1024) = load8((const bf16*)(wsb + WS_QP) + row0 * PQP + h * 64 + e * 16 + qop); }
    const char* qpl_r = lds + OFF_QP + wid * 4096 + lane * 16;
#define QPF(e) (*(const bf16x8*)(qpl_r + (e) * 1024))
#else
    bf16x8 qp[4];
#pragma unroll
    for (int e = 0; e < 4; ++e) qp[e] = load8((const bf16*)(wsb + WS_QP) + row0 * PQP + h * 64 + e * 16 + qop);
#define QPF(e) qp[e]
#endif
    float m_reg = -1e30f, l_reg = 0; f32x16 o[4] = {};
#define QKT(P0_, P1_, slot) do { P0_ = f32x16{}; P1_ = f32x16{}; const char* kb_ = lds + (slot) * SLOT_K; const char* kq_ = lds + (slot) * SLOT_P;   \
        _Pragma("unroll") for (int d0 = 0; d0 < 8; ++d0) { const char* a_ = kb_ + kbo[d0 & 3] + (d0 >> 2) * 128;                                         \
            const bf16x8 b0 = *reinterpret_cast<const bf16x8*>(a_); const bf16x8 b1 = *reinterpret_cast<const bf16x8*>(a_ + 32 * 256);                    \
            P0_ = __builtin_amdgcn_mfma_f32_32x32x16_bf16(b0, qr[d0], P0_, 0, 0, 0); P1_ = __builtin_amdgcn_mfma_f32_32x32x16_bf16(b1, qr[d0], P1_, 0, 0, 0); }  \
        _Pragma("unroll") for (int e = 0; e < 4; ++e) { const char* a_ = kq_ + kpo[e];                                                                  \
            const bf16x8 b0 = *reinterpret_cast<const bf16x8*>(a_); const bf16x8 b1 = *reinterpret_cast<const bf16x8*>(a_ + 32 * 128); const bf16x8 q_ = QPF(e);   \
            P0_ = __builtin_amdgcn_mfma_f32_32x32x16_bf16(b0, q_, P0_, 0, 0, 0); P1_ = __builtin_amdgcn_mfma_f32_32x32x16_bf16(b1, q_, P1_, 0, 0, 0); } } while (0)
#define TRRD(dst, off) asm volatile("ds_read_b64_tr_b16 %0, %1 offset:%2" : "=&v"(dst) : "v"(vbs_), "i"(off) : "memory")
#define PV_D0(d0) do { s16x4 l0, l1, l2, l3, h0, h1, h2, h3; constexpr int b_ = (d0) * 512;   \
        TRRD(l0, b_); TRRD(h0, b_ + 2048); TRRD(l1, b_ + 4096); TRRD(h1, b_ + 6144); TRRD(l2, b_ + 8192); TRRD(h2, b_ + 10240); TRRD(l3, b_ + 12288); TRRD(h3, b_ + 14336); \
        asm volatile("s_waitcnt lgkmcnt(0)" ::: "memory"); SBAR();   \
        o[d0] = __builtin_amdgcn_mfma_f32_32x32x16_bf16(pa0, (bf16x8){l0[0], l0[1], l0[2], l0[3], h0[0], h0[1], h0[2], h0[3]}, o[d0], 0, 0, 0);   \
        o[d0] = __builtin_amdgcn_mfma_f32_32x32x16_bf16(pa1, (bf16x8){l1[0], l1[1], l1[2], l1[3], h1[0], h1[1], h1[2], h1[3]}, o[d0], 0, 0, 0);   \
        o[d0] = __builtin_amdgcn_mfma_f32_32x32x16_bf16(pa2, (bf16x8){l2[0], l2[1], l2[2], l2[3], h2[0], h2[1], h2[2], h2[3]}, o[d0], 0, 0, 0);   \
        o[d0] = __builtin_amdgcn_mfma_f32_32x32x16_bf16(pa3, (bf16x8){l3[0], l3[1], l3[2], l3[3], h3[0], h3[1], h3[2], h3[3]}, o[d0], 0, 0, 0); } while (0)
#define PV(slot) do { const int vbs_ = vb0 + (slot) * SLOT_V; PV_D0(0); PV_D0(1); PV_D0(2); PV_D0(3); } while (0)
#define RESC(a) do { if (__any((a) < 1.f)) { if (hi == 0) al_l[r32] = (a); asm volatile("s_waitcnt lgkmcnt(0)" ::: "memory");              \
                     _Pragma("unroll") for (int d_ = 0; d_ < 4; ++d_) _Pragma("unroll") for (int r = 0; r < 16; ++r) o[d_][r] *= al_l[crow(r, hi)]; } } while (0)
#define MASKT(P0_, P1_, t) do { const int kb_ = (t) * KVBLK; if (kb_ + KVBLK - 1 > qlo) mask_tile(P0_, P1_, qm - kb_); } while (0)
    f32x16 pA0, pA1, pB0, pB1; float mnA, mnB, alA, alB; bf16x8 pa0, pa1, pa2, pa3;
    MLA_WAITBAR(0);
    DMA_K(2, 2); DMA_V(1, 1);
    SBAR(); QKT(pA0, pA1, 0); MASKT(pA0, pA1, 0); partialSM(pA0, pA1, m_reg, mnA, alA);
    MLA_WAITBAR(5);
    int s0 = 0, s1 = 1, s2 = 2;
#define HALF_STEP(PX0, PX1, mnX, alX, PY0, PY1, alY, t) do {                                                                 \
        if ((t) + 2 < NT) DMA_K((t) + 2, s0);                                                                                 \
        if ((t) + 1 < NT) DMA_V((t) + 1, s2);                                                                                 \
        SBAR(); QKT(PX0, PX1, s1);                                                                                           \
        finishSM(PY0, PY1, alY, l_reg, pa0, pa1, pa2, pa3); SBAR();                                                           \
        PV(s0); MASKT(PX0, PX1, (t)); partialSM(PX0, PX1, m_reg, mnX, alX);                                                   \
        RESC(alX);                                                                                                            \
        if ((t) + 2 < NT) MLA_WAITBAR(5); else if ((t) + 1 < NT) MLA_WAITBAR(2); else MLA_WAITBAR(0);                         \
        { const int r_ = s0; s0 = s1; s1 = s2; s2 = r_; } } while (0)
    int t = 1;
    for (; t + 1 < NT; t += 2) {
        HALF_STEP(pB0, pB1, mnB, alB, pA0, pA1, alA, t);
        HALF_STEP(pA0, pA1, mnA, alA, pB0, pB1, alB, t + 1);
    }
    HALF_STEP(pB0, pB1, mnB, alB, pA0, pA1, alA, t);
    finishSM(pB0, pB1, alB, l_reg, pa0, pa1, pa2, pa3); SBAR(); PV(s0);
    if (hi == 0) li_l[r32] = l_reg; asm volatile("s_waitcnt lgkmcnt(0)" ::: "memory");
    float rli[16];
#pragma unroll
    for (int r = 0; r < 16; ++r) rli[r] = __builtin_amdgcn_rcpf(li_l[crow(r, hi)]);
    bf16* Ow = (bf16*)(const_cast<unsigned char*>(wsb) + WS_OA) + row0 * PO + h * 128;
    unsigned oo = (unsigned)r32; asm volatile("" : "+v"(oo));
#pragma unroll
    for (int r = 0; r < 16; ++r) { const int orow = crow(r, hi);
#pragma unroll
        for (int d0 = 0; d0 < 4; ++d0) { const float v = o[d0][r] * rli[r];
            const float vn = __shfl_xor(v, 1);
            if ((r32 & 1) == 0) *(unsigned*)(Ow + orow * PO + d0 * 32 + oo) = cvtpk(v, vn); } }
    MLA_WAITBAR(0);
#undef DMA_K
#undef DMA_V
#undef QPF
#undef QKT
#undef TRRD
#undef PV_D0
#undef PV
#undef RESC
#undef MASKT
#undef HALF_STEP
}
__device__ __forceinline__ void mla_phase(char* lds, int vcu, int G, const unsigned char* wsb) {
    for (int L = vcu; L < 1024; L += G) { const int bh = L >> 4, y = L & 15;
        for (int pass = 0; pass < 2; ++pass) mla_block(wsb, bh >> 5, bh & 31, pass ? 31 - y : y, lds); }
}
#undef MLA_GLDS
#undef MLA_WAITBAR
#undef SBAR
}

namespace swa {
typedef short bf16x8 __attribute__((ext_vector_type(8)));
typedef short s16x4 __attribute__((ext_vector_type(4)));
typedef float f32x16 __attribute__((ext_vector_type(16)));
typedef unsigned u32x4 __attribute__((ext_vector_type(4)));
typedef unsigned short bf16;
constexpr int OFF_K = 0, OFF_V = 24576, OFF_O = 49152, LDS_BYTES = 49152 + 8 * 8192;
__device__ __forceinline__ int v_st64(int k, int c) { const int kk = (k & ~0xC) | ((k & 4) << 1) | ((k & 8) >> 1); return ((kk >> 3) * 2 + (c >> 5)) * 512 + ((kk & 7) * 32 + (c & 31)) * 2; }
__device__ __forceinline__ int v_rd_base(int lane) { return ((lane & 3) << 3) | (((lane >> 2) & 3) << 6) | (((lane >> 4) & 1) << 5) | (((lane >> 5) & 1) << 8); }
__device__ __forceinline__ int crow(int r, int hi) { return (r & 3) + 8 * (r >> 2) + 4 * hi; }
__device__ __forceinline__ unsigned cvtpk(float lo, float hi) { unsigned r; asm volatile("v_cvt_pk_bf16_f32 %0, %1, %2" : "=v"(r) : "v"(lo), "v"(hi)); return r; }
__device__ __forceinline__ float sigm(float v) { return __builtin_amdgcn_rcpf(1.f + __builtin_amdgcn_exp2f(-v * 1.4426950408889634f)); }
#define SWA_PK4(P, B_, OUT) do { unsigned a0 = cvtpk(P[B_+0], P[B_+1]), a1 = cvtpk(P[B_+2], P[B_+3]);                          \
        unsigned b0 = cvtpk(P[B_+4], P[B_+5]), b1 = cvtpk(P[B_+6], P[B_+7]);                                             \
        auto r0 = __builtin_amdgcn_permlane32_swap(a0, b0, false, false); auto r1 = __builtin_amdgcn_permlane32_swap(a1, b1, false, false); \
        u32x4 w = {r0[0], r1[0], r0[1], r1[1]}; OUT = *reinterpret_cast<bf16x8*>(&w); } while (0)
__device__ __forceinline__ void swa_phase(char* lds, int vcu, int G, const bf16* ZSQ, const bf16* ZSK, const bf16* ZSV, const float* sinks,
                                          const bf16* OA, const bf16* ZA, const bf16* ZB, bf16* MIX) {
    const int tid = threadIdx.x, wid = __builtin_amdgcn_readfirstlane(tid >> 6), lane = tid & 63, r32 = lane & 31, hi = lane >> 5;
    const int vb0 = (int)(uintptr_t)lds + OFF_V + v_rd_base(lane);
    float* ost = (float*)(lds + OFF_O + wid * 8192);
    for (int unit = vcu; unit < 4096; unit += G) {
        const int qt = unit & 255, g = (unit >> 8) & 7, b = unit >> 11, q0 = qt * 32, kbase = ((qt >> 1) - 2) * 64, hq = g * 8 + wid;
        const size_t brow = (size_t)b * 8192;
#pragma unroll
        for (int i = 0; i < 3; ++i) { const int idx = tid + 512 * i, key = idx >> 3, ch = idx & 7; int kpos = kbase + key; kpos = kpos < 0 ? 0 : kpos;
            const u32x4 kv = *(const u32x4*)(ZSK + (brow + kpos) * 512 + g * 64 + ch * 8);
            const u32x4 vv = *(const u32x4*)(ZSV + (brow + kpos) * 512 + g * 64 + ch * 8);
            *(u32x4*)(lds + OFF_K + key * 128 + ((ch ^ ((key >> 1) & 7)) << 4)) = kv;
            *(u32x4*)(lds + OFF_V + (key >> 6) * 8192 + v_st64(key & 63, ch * 8)) = vv; }
        bf16x8 qr[4];
#pragma unroll
        for (int d0 = 0; d0 < 4; ++d0) qr[d0] = *(const bf16x8*)(ZSQ + (brow + q0 + r32) * 4096 + hq * 64 + d0 * 16 + hi * 8);
        __syncthreads();
        f32x16 p[3][2];
#pragma unroll
        for (int t = 0; t < 3; ++t)
#pragma unroll
            for (int hf = 0; hf < 2; ++hf) { f32x16 acc = {}; const int key = t * 64 + hf * 32 + r32;
#pragma unroll
                for (int d0 = 0; d0 < 4; ++d0) { const bf16x8 a = *(const bf16x8*)(lds + OFF_K + key * 128 + (((2 * d0 + hi) ^ ((key >> 1) & 7)) << 4));
                    acc = __builtin_amdgcn_mfma_f32_32x32x16_bf16(a, qr[d0], acc, 0, 0, 0); }
                p[t][hf] = acc; }
        const float slope2 = exp2f(-(float)(hq + 1) * 0.125f) * 1.4426950408889634f;
        const float sink2 = sinks[hq] * 1.4426950408889634f;
        const int qpos = q0 + r32; float mx = sink2;
#pragma unroll
        for (int t = 0; t < 3; ++t)
#pragma unroll
            for (int hf = 0; hf < 2; ++hf)
#pragma unroll
                for (int r = 0; r < 16; ++r) { const int kpos = kbase + t * 64 + hf * 32 + crow(r, hi); const int dist = qpos - kpos;
                    const bool valid = kpos >= 0 && dist >= 0 && dist < 128;
                    const float s = valid ? p[t][hf][r] - slope2 * (float)dist : -__builtin_inff();
                    p[t][hf][r] = s; mx = fmaxf(mx, s); }
        { auto rr = __builtin_amdgcn_permlane32_swap(__float_as_uint(mx), __float_as_uint(mx), false, false); mx = fmaxf(__uint_as_float(rr[0]), __uint_as_float(rr[1])); }
        float ps = 0.f;
#pragma unroll
        for (int t = 0; t < 3; ++t)
#pragma unroll
            for (int hf = 0; hf < 2; ++hf)
#pragma unroll
                for (int r = 0; r < 16; ++r) { const float e = __builtin_amdgcn_exp2f(p[t][hf][r] - mx); p[t][hf][r] = e; ps += e; }
        { auto rr = __builtin_amdgcn_permlane32_swap(__float_as_uint(ps), __float_as_uint(ps), false, false); ps = __uint_as_float(rr[0]) + __uint_as_float(rr[1]); }
        const float linv = __builtin_amdgcn_rcpf(ps + __builtin_amdgcn_exp2f(sink2 - mx));
        f32x16 o[2] = {};
#pragma unroll
        for (int t = 0; t < 3; ++t) { bf16x8 pa[4];
            SWA_PK4(p[t][0], 0, pa[0]); SWA_PK4(p[t][0], 8, pa[1]); SWA_PK4(p[t][1], 0, pa[2]); SWA_PK4(p[t][1], 8, pa[3]);
#pragma unroll
            for (int d0 = 0; d0 < 2; ++d0) { s16x4 lo[4], hh[4];
#pragma unroll
                for (int ks = 0; ks < 4; ++ks) {
                    asm volatile("ds_read_b64_tr_b16 %0, %1 offset:%2" : "=&v"(lo[ks]) : "v"(vb0), "i"(t * 8192 + d0 * 512 + ks * 2048) : "memory");
                    asm volatile("ds_read_b64_tr_b16 %0, %1 offset:%2" : "=&v"(hh[ks]) : "v"(vb0), "i"(t * 8192 + d0 * 512 + ks * 2048 + 1024) : "memory"); }
                asm volatile("s_waitcnt lgkmcnt(0)" ::: "memory"); __builtin_amdgcn_sched_barrier(0);
#pragma unroll
                for (int ks = 0; ks < 4; ++ks)
                    o[d0] = __builtin_amdgcn_mfma_f32_32x32x16_bf16(pa[ks], (bf16x8){lo[ks][0], lo[ks][1], lo[ks][2], lo[ks][3], hh[ks][0], hh[ks][1], hh[ks][2], hh[ks][3]}, o[d0], 0, 0, 0); } }
        if (hi == 0) ost[r32] = linv;
        asm volatile("s_waitcnt lgkmcnt(0)" ::: "memory");
        float rl[16];
#pragma unroll
        for (int r = 0; r < 16; ++r) rl[r] = ost[crow(r, hi)];
        asm volatile("s_waitcnt lgkmcnt(0)" ::: "memory"); __builtin_amdgcn_sched_barrier(0);
#pragma unroll
        for (int r = 0; r < 16; ++r)
#pragma unroll
            for (int d0 = 0; d0 < 2; ++d0) ost[crow(r, hi) * 64 + d0 * 32 + r32] = o[d0][r] * rl[r];
        asm volatile("s_waitcnt lgkmcnt(0)" ::: "memory"); __builtin_amdgcn_sched_barrier(0);
#pragma unroll
        for (int i = 0; i < 4; ++i) { const int idx = lane + 64 * i, row = idx >> 3, c8 = idx & 7;
            const f32x4 oa_ = *(const f32x4*)(ost + row * 64 + c8 * 8), ob_ = *(const f32x4*)(ost + row * 64 + c8 * 8 + 4);
            const size_t off = (brow + q0 + row) * 4096 + hq * 64 + c8 * 8;
            const u32x4 a = *(const u32x4*)(OA + off), za = *(const u32x4*)(ZA + off), zb = *(const u32x4*)(ZB + off);
            float m[8];
            m[0] = sigm(bflo(za.x)) * bflo(a.x) + sigm(bflo(zb.x)) * oa_.x; m[1] = sigm(bfhi(za.x)) * bfhi(a.x) + sigm(bfhi(zb.x)) * oa_.y;
            m[2] = sigm(bflo(za.y)) * bflo(a.y) + sigm(bflo(zb.y)) * oa_.z; m[3] = sigm(bfhi(za.y)) * bfhi(a.y) + sigm(bfhi(zb.y)) * oa_.w;
            m[4] = sigm(bflo(za.z)) * bflo(a.z) + sigm(bflo(zb.z)) * ob_.x; m[5] = sigm(bfhi(za.z)) * bfhi(a.z) + sigm(bfhi(zb.z)) * ob_.y;
            m[6] = sigm(bflo(za.w)) * bflo(a.w) + sigm(bflo(zb.w)) * ob_.z; m[7] = sigm(bfhi(za.w)) * bfhi(a.w) + sigm(bfhi(zb.w)) * ob_.w;
            u32x4 w; w.x = cvtpk(m[0], m[1]); w.y = cvtpk(m[2], m[3]); w.z = cvtpk(m[4], m[5]); w.w = cvtpk(m[6], m[7]);
            *(u32x4*)(MIX + off) = w; }
        __syncthreads();
    }
}
}

namespace peer {
typedef short bf16x8 __attribute__((ext_vector_type(8)));
typedef float f32x16 __attribute__((ext_vector_type(16)));
typedef unsigned u32x4 __attribute__((ext_vector_type(4)));
typedef unsigned short bf16;
constexpr int OFF_E = 0, OFF_G = 16384, LDS_BYTES = 32768;
__device__ __forceinline__ int crow(int r, int hi) { return (r & 3) + 8 * (r >> 2) + 4 * hi; }
__device__ __forceinline__ unsigned mono(float f) { const unsigned u = __float_as_uint(f); return (u & 0x80000000u) ? ~u : (u | 0x80000000u); }
__device__ __forceinline__ float unmono(unsigned k) { return __uint_as_float((k & 0x80000000u) ? (k & 0x7fffffffu) : ~k); }
__device__ __forceinline__ unsigned umax(unsigned a, unsigned b) { return a > b ? a : b; }
__device__ __forceinline__ unsigned umin(unsigned a, unsigned b) { return a < b ? a : b; }
template <int N> __device__ __forceinline__ void bitonic_sort_desc(unsigned* v) {
#pragma unroll
    for (int k = 2; k <= N; k <<= 1)
#pragma unroll
        for (int j = k >> 1; j > 0; j >>= 1)
#pragma unroll
            for (int i = 0; i < N; ++i) { const int l = i ^ j;
                if (l > i) { const unsigned x = v[i], y = v[l]; const bool desc = ((i & k) == 0);
                    v[i] = desc ? umax(x, y) : umin(x, y); v[l] = desc ? umin(x, y) : umax(x, y); } }
}
template <int N> __device__ __forceinline__ void bitonic_merge_desc(unsigned* v) {
#pragma unroll
    for (int j = N >> 1; j > 0; j >>= 1)
#pragma unroll
        for (int i = 0; i < N; ++i) { const int l = i ^ j; if (l > i) { const unsigned x = v[i], y = v[l]; v[i] = umax(x, y); v[l] = umin(x, y); } }
}
__device__ __forceinline__ void merge_top16(unsigned* a, const unsigned* b) {
#pragma unroll
    for (int i = 0; i < 16; ++i) a[i] = umax(a[i], b[15 - i]);
    bitonic_merge_desc<16>(a);
}
__device__ __forceinline__ void top16_of_64(unsigned (&k)[64]) {
    bitonic_sort_desc<16>(k); bitonic_sort_desc<16>(k + 16); bitonic_sort_desc<16>(k + 32); bitonic_sort_desc<16>(k + 48);
    merge_top16(k, k + 16); merge_top16(k + 32, k + 48); merge_top16(k, k + 32);
}
__device__ __forceinline__ void top16_pair(unsigned (&k)[64], unsigned (&out)[16]) {
    top16_of_64(k);
    unsigned pb[16];
#pragma unroll
    for (int i = 0; i < 16; ++i) pb[i] = (unsigned)__shfl_xor((int)k[i], 32);
    merge_top16(k, pb);
#pragma unroll
    for (int i = 0; i < 16; ++i) out[i] = k[i];
}
__device__ __forceinline__ float gelu_erf(float v) { return 0.5f * v * (1.0f + erff(v * 0.70710678118654752f)); }

__device__ __forceinline__ void peer_phase(char* lds, int vcu, int G, const bf16* PQ, const bf16* SUBK, const bf16* H2, const bf16* UB, const bf16* VB,
                                           const float* ada, const float* g_post, float* out) {
    const int tid = threadIdx.x, wid = __builtin_amdgcn_readfirstlane(tid >> 6), lane0 = tid & 63;
    int* sel_e = (int*)(lds + OFF_E); float* sel_g = (float*)(lds + OFF_G);
    for (int tile = vcu; tile < 512; tile += G) {
        const int t0 = tile * 32;
        {
            int lane = lane0; asm volatile("" : "+v"(lane));
            const int r32 = lane & 31, hi = lane >> 5;
            const int h = wid; unsigned la[16], lb[16];
            const int koff = r32 * 128 + hi * 8;
#pragma unroll
            for (int p = 0; p < 2; ++p) {
                bf16x8 q[8];
#pragma unroll
                for (int ks = 0; ks < 8; ++ks) q[ks] = *(const bf16x8*)(PQ + (size_t)(t0 + r32) * 2048 + (h * 2 + p) * 128 + ks * 16 + hi * 8);
                unsigned k[64];
#pragma unroll
                for (int blk = 0; blk < 4; ++blk) { f32x16 acc = {};
#pragma unroll
                    for (int ks = 0; ks < 8; ++ks) { const bf16x8 a = *(const bf16x8*)(SUBK + ((h * 2 + p) * 128 + blk * 32) * 128 + ks * 16 + koff);
                        acc = __builtin_amdgcn_mfma_f32_32x32x16_bf16(a, q[ks], acc, 0, 0, 0); }
#pragma unroll
                    for (int r = 0; r < 16; ++r) { const int n = blk * 32 + crow(r, hi); k[blk * 16 + r] = (mono(acc[r]) & ~0x7fu) | (unsigned)(127 - n); } }
                if (p == 0) top16_pair(k, la); else top16_pair(k, lb);
            }
            float va[16], vb[16];
#pragma unroll
            for (int i = 0; i < 16; ++i) { va[i] = unmono(la[i] & ~0x7fu); vb[i] = unmono(lb[i] & ~0x7fu); }
            unsigned c[64]; int nc = 0;
#pragma unroll
            for (int i = 0; i < 16; ++i)
#pragma unroll
                for (int j = 0; j < 16; ++j) if ((i + 1) * (j + 1) <= 16) { c[nc] = (mono(va[i] + vb[j]) & ~0xffu) | (unsigned)(255 - (i * 16 + j)); ++nc; }
#pragma unroll
            for (int i = 50; i < 64; ++i) c[i] = 0u;
            top16_of_64(c);
            unsigned ia[4], ib[4];
#pragma unroll
            for (int w = 0; w < 4; ++w) { ia[w] = 0u; ib[w] = 0u;
#pragma unroll
                for (int e = 0; e < 4; ++e) { ia[w] |= (127u - (la[4 * w + e] & 0x7fu)) << (8 * e); ib[w] |= (127u - (lb[4 * w + e] & 0x7fu)) << (8 * e); } }
            float bs[16]; int be[16];
#pragma unroll
            for (int kk = 0; kk < 16; ++kk) {
                const unsigned m = c[kk];
                const unsigned code = 255u - (m & 0xffu), ci = code >> 4, cj = code & 15u;
                const unsigned wa = (ci < 8u) ? ((ci < 4u) ? ia[0] : ia[1]) : ((ci < 12u) ? ia[2] : ia[3]);
                const unsigned wb = (cj < 8u) ? ((cj < 4u) ? ib[0] : ib[1]) : ((cj < 12u) ? ib[2] : ib[3]);
                const unsigned i1 = (wa >> ((ci & 3u) * 8u)) & 0xffu, i2 = (wb >> ((cj & 3u) * 8u)) & 0xffu;
                bs[kk] = unmono(m & ~0xffu);
                be[kk] = (int)(i1 * 128u + i2);
            }
            float mx = bs[0];
#pragma unroll
            for (int kk = 1; kk < 16; ++kk) mx = fmaxf(mx, bs[kk]);
            float sum = 0.f;
#pragma unroll
            for (int kk = 0; kk < 16; ++kk) { bs[kk] = __expf(bs[kk] - mx); sum += bs[kk]; }
            const float inv = 1.0f / sum;
            if (hi == 0) {
#pragma unroll
                for (int kk = 0; kk < 16; ++kk) { sel_e[r32 * 128 + h * 16 + kk] = be[kk]; sel_g[r32 * 128 + h * 16 + kk] = bs[kk] * inv; } }
        }
        __syncthreads();
        for (int tt = 0; tt < 4; ++tt) {
            int lane = lane0; asm volatile("" : "+v"(lane));
            const int tl = wid * 4 + tt, tok = t0 + tl, b = tok >> 13;
            u32x4 xr[8];
#pragma unroll
            for (int i = 0; i < 8; ++i) xr[i] = *(const u32x4*)(H2 + (size_t)tok * 4096 + 8 * (lane + 64 * i));
            float acc[64];
#pragma unroll
            for (int e = 0; e < 64; ++e) acc[e] = 0.f;
            for (int j = 0; j < 128; ++j) {
                const int ex = __builtin_amdgcn_readfirstlane(sel_e[tl * 128 + j]); const float gt = sel_g[tl * 128 + j];
                const bf16* up = UB + (size_t)ex * 4096 + 8 * lane; const bf16* vp = VB + (size_t)ex * 4096 + 8 * lane;
                u32x4 u[8], v[8];
#pragma unroll
                for (int i = 0; i < 8; ++i) u[i] = *(const u32x4*)(up + 512 * i);
#pragma unroll
                for (int i = 0; i < 8; ++i) v[i] = *(const u32x4*)(vp + 512 * i);
                float d0 = 0.f, d1 = 0.f, d2 = 0.f, d3 = 0.f;
#pragma unroll
                for (int i = 0; i < 8; ++i) { d0 = dot2bf(u[i].x, xr[i].x, d0); d1 = dot2bf(u[i].y, xr[i].y, d1); d2 = dot2bf(u[i].z, xr[i].z, d2); d3 = dot2bf(u[i].w, xr[i].w, d3); }
                const float d = wave_sum((d0 + d1) + (d2 + d3));
                const float a = gelu_erf(d) * gt;
#pragma unroll
                for (int i = 0; i < 8; ++i) {
                    acc[8 * i + 0] += a * bflo(v[i].x); acc[8 * i + 1] += a * bfhi(v[i].x); acc[8 * i + 2] += a * bflo(v[i].y); acc[8 * i + 3] += a * bfhi(v[i].y);
                    acc[8 * i + 4] += a * bflo(v[i].z); acc[8 * i + 5] += a * bfhi(v[i].z); acc[8 * i + 6] += a * bflo(v[i].w); acc[8 * i + 7] += a * bfhi(v[i].w); }
            }
            float ss = 0.f;
#pragma unroll
            for (int e = 0; e < 64; ++e) ss += acc[e] * acc[e];
            const float rstd = 1.0f / sqrtf(wave_sum(ss) * (1.f / 4096.f) + 1e-6f);
            const float* gf = ada + b * 24576 + 5 * 4096;
#pragma unroll
            for (int i = 0; i < 8; ++i) { const int col = 8 * (lane + 64 * i); float* op = out + (size_t)tok * 4096 + col;
                const f32x4 x0 = *(const f32x4*)op, x1 = *(const f32x4*)(op + 4), g0 = *(const f32x4*)(g_post + col), g1 = *(const f32x4*)(g_post + col + 4),
                            f0 = *(const f32x4*)(gf + col), f1 = *(const f32x4*)(gf + col + 4);
                f32x4 o0, o1;
                o0.x = x0.x + f0.x * (acc[8 * i + 0] * rstd * g0.x); o0.y = x0.y + f0.y * (acc[8 * i + 1] * rstd * g0.y); o0.z = x0.z + f0.z * (acc[8 * i + 2] * rstd * g0.z); o0.w = x0.w + f0.w * (acc[8 * i + 3] * rstd * g0.w);
                o1.x = x1.x + f1.x * (acc[8 * i + 4] * rstd * g1.x); o1.y = x1.y + f1.y * (acc[8 * i + 5] * rstd * g1.y); o1.z = x1.z + f1.z * (acc[8 * i + 6] * rstd * g1.z); o1.w = x1.w + f1.w * (acc[8 * i + 7] * rstd * g1.w);
                *(f32x4*)op = o0; *(f32x4*)(op + 4) = o1; }
        }
        __syncthreads();
    }
}
}

#ifndef MK_N_LAUNCHES
#define MK_N_LAUNCHES 12
#endif
constexpr int N_PHASES = 12;
constexpr int N_LAUNCHES = MK_N_LAUNCHES;
struct Args { const float* in[19]; float* out; unsigned char* ws; int ph_lo, ph_hi; };
__global__ void __launch_bounds__(NWAVES * 64, 2) hybrid_fwd(Args args) {
    extern __shared__ __attribute__((aligned(16))) unsigned char lds[];
    Frame F;
    F.lds = (LAS unsigned char*)lds;
    F.MISC = (volatile LAS unsigned*)(F.lds + MISC_OFF);
    F.tid = threadIdx.x; F.lane = F.tid & 63; F.wave = __builtin_amdgcn_readfirstlane(F.tid >> 6);
    F.G = gridDim.x; { const int bx = blockIdx.x; F.vcu = (F.G % 8 == 0) ? (bx % 8) * (F.G / 8) + bx / 8 : bx; }
    F.ctl = (gu32*)(args.ws + WS_CTL);
    for (int u = F.tid; u < (LDS_BYTES - LDSCTL_OFF) / 4; u += NWAVES * 64) ((LAS unsigned*)(F.lds + LDSCTL_OFF))[u] = 0u;
    __syncthreads();
    XcdBarrier bar; bar.bar = (unsigned*)(F.ctl + CW_BAR); bar.x = 0; bar.st = nullptr;
    if (N_LAUNCHES == 1) bar = xcd_barrier_post((unsigned*)(F.ctl + CW_BAR), F.MISC + 8);
#define GRID_BAR() do { if (N_LAUNCHES == 1) xcd_barrier(bar); } while (0)
    const int lo = args.ph_lo, hi = args.ph_hi;
#ifdef ONLY_PHASE
#define PH_ON(k) ((k) == ONLY_PHASE)
#else
#define PH_ON(k) true
#endif
#define IN(k) (PH_ON(k) && lo <= (k) && (k) < hi)
#define BOTH(k) (IN(k) && IN((k) + 1))
    typedef const __attribute__((address_space(4))) Args* kargs_t;
    const kargs_t kap0 = (kargs_t)__builtin_amdgcn_kernarg_segment_ptr();
#define INP(i) ({ kargs_t p_ = kap0; asm volatile("" : "+s"(p_)); p_->in[i]; })
#define OUTP() ({ kargs_t p_ = kap0; asm volatile("" : "+s"(p_)); p_->out; })
#define WSP() ({ kargs_t p_ = kap0; asm volatile("" : "+s"(p_)); p_->ws; })

    if (IN(0)) { unsigned char* ws = WSP(); p0_prologue(F, INP(1), INP(2), INP(6), INP(8), INP(10), INP(12), INP(15), INP(16), ws); if (BOTH(0)) GRID_BAR(); }
    if (IN(1)) { unsigned char* ws = WSP(); p1_ada_reduce(F, INP(3), ws); if (BOTH(1)) GRID_BAR(); }
    if (IN(2)) { unsigned char* ws = WSP(); p2_modnorm(F, INP(0), INP(4), ws); if (BOTH(2)) GRID_BAR(); }
    if (IN(3)) {
        unsigned char* ws = WSP();
        pg8::Gemm g{(const bf16*)(ws + WS_H), (const bf16*)(ws + WS_WIN), M, NZ, DM}; pg8::StaticOrder S; S.init(M, NZ, F.G, (int)blockIdx.x);
        pg8::EpiZ E{(bf16*)(ws + WS_ZQ), (bf16*)(ws + WS_ZSQ), (bf16*)(ws + WS_ZA), (bf16*)(ws + WS_ZB), (bf16*)(ws + WS_ZSK), (bf16*)(ws + WS_ZSV), (bf16*)(ws + WS_ZKV), 0.125f * LOG2E};
        pg8::gemm_phase<pg8::EpiZ, pg8::StaticOrder, true, true>(F.lds + RING_OFF, g, S, E);
        if (BOTH(3)) GRID_BAR();
    }
    if (IN(4)) { unsigned char* ws = WSP(); p4_latent(F, INP(7), INP(9), ws); if (BOTH(4)) GRID_BAR(); }
    if (IN(5)) {
        unsigned char* ws = WSP();
        { pg8::Gemm g{(const bf16*)(ws + WS_ZQN), (const bf16*)(ws + WS_WQB), M, 6144, 1024}; pg8::StaticOrder S; S.init(M, 6144, F.G, (int)blockIdx.x);
          pg8::EpiQ E{(bf16*)(ws + WS_QN), (bf16*)(ws + WS_QP), (const float*)(ws + WS_ROPE), (const float*)(ws + WS_ROPE) + SEQ * 32};
          pg8::gemm_phase<pg8::EpiQ, pg8::StaticOrder, true, true>(F.lds + RING_OFF, g, S, E); }
        __syncthreads();
        { pg8::Gemm g{(const bf16*)(ws + WS_CKV), (const bf16*)(ws + WS_WKVB), M, 8192, 512}; pg8::StaticOrder S; S.init(M, 8192, F.G, (int)blockIdx.x);
          pg8::EpiBf16<0> E{(bf16*)(ws + WS_KN), 4096, nullptr, 4096, (size_t)(WS_VM - WS_KN) / 2, 1.f};
          pg8::gemm_phase<pg8::EpiBf16<0>, pg8::StaticOrder, true, true>(F.lds + RING_OFF, g, S, E); }
        if (BOTH(5)) GRID_BAR();
    }
    if (IN(6)) {
        unsigned char* ws = WSP();
        mla::mla_phase((char*)lds + RING_OFF, F.vcu, F.G, ws);
        if (BOTH(6)) GRID_BAR();
    }
    if (IN(7)) {
        unsigned char* ws = WSP(); const float* sinks = INP(11); const float* peer_u = INP(17); const float* peer_v = INP(18);
        swa::swa_phase((char*)lds + RING_OFF, F.vcu, F.G, (const bf16*)(ws + WS_ZSQ), (const bf16*)(ws + WS_ZSK), (const bf16*)(ws + WS_ZSV), sinks,
                       (const bf16*)(ws + WS_OA), (const bf16*)(ws + WS_ZA), (const bf16*)(ws + WS_ZB), (bf16*)(ws + WS_H));
        convert_bf16(F, peer_u, (bf16*)(ws + WS_UB), (size_t)16384 * 4096 / 8);
        convert_bf16(F, peer_v, (bf16*)(ws + WS_VB), (size_t)16384 * 4096 / 8);
        if (BOTH(7)) GRID_BAR();
    }
    if (IN(8)) {
        unsigned char* ws = WSP();
        pg8::Gemm g{(const bf16*)(ws + WS_H), (const bf16*)(ws + WS_WOUT), M, DM, DM}; pg8::StaticOrder S; S.init(M, DM, F.G, (int)blockIdx.x);
        pg8::EpiT E{(bf16*)(ws + WS_T), (float*)(ws + WS_RSQ)};
        pg8::gemm_phase<pg8::EpiT, pg8::StaticOrder, true, true>(F.lds + RING_OFF, g, S, E);
        if (BOTH(8)) GRID_BAR();
    }
    if (IN(9)) { unsigned char* ws = WSP(); p9_post_attn(F, INP(0), INP(5), INP(13), OUTP(), ws); if (BOTH(9)) GRID_BAR(); }
    if (IN(10)) {
        unsigned char* ws = WSP();
        pg8::Gemm g{(const bf16*)(ws + WS_H), (const bf16*)(ws + WS_WPQ), M, 2048, DM}; pg8::StaticOrder S; S.init(M, 2048, F.G, (int)blockIdx.x);
        pg8::EpiBf16<0> E{(bf16*)(ws + WS_PQ), 2048, nullptr, 0, 0, 1.f};
        pg8::gemm_phase<pg8::EpiBf16<0>, pg8::StaticOrder, true, true>(F.lds + RING_OFF, g, S, E);
        if (BOTH(10)) GRID_BAR();
    }
    if (IN(11)) {
        unsigned char* ws = WSP(); const float* g_ffn_post = INP(14); float* out = OUTP();
        peer::peer_phase((char*)lds + RING_OFF, F.vcu, F.G, (const bf16*)(ws + WS_PQ), (const bf16*)(ws + WS_SUBK), (const bf16*)(ws + WS_H), (const bf16*)(ws + WS_UB), (const bf16*)(ws + WS_VB),
                         (const float*)(ws + WS_ADA), g_ffn_post, out);
    }
#undef IN
#undef BOTH
#undef GRID_BAR
}

extern "C" void kernel_launch(void* const* d_in, const int* in_sizes, int n_in, void* d_out, int out_size, void* d_ws, size_t ws_size, hipStream_t stream) {
    static int grid = 0;
    if (grid == 0) {
        if (n_in != 19 || out_size != M * DM || ws_size < WS_END) { fprintf(stderr, "kernel_launch: unexpected shapes (n_in %d out %d ws %zu)\n", n_in, out_size, ws_size); grid = -1; return; }
        int dev = 0, cus = 0, per_cu = 0;
        if (hipGetDevice(&dev) != hipSuccess || hipDeviceGetAttribute(&cus, hipDeviceAttributeMultiprocessorCount, dev) != hipSuccess) { grid = -1; return; }
        if (hipFuncSetAttribute((const void*)hybrid_fwd, hipFuncAttributeMaxDynamicSharedMemorySize, LDS_BYTES) != hipSuccess) { fprintf(stderr, "kernel_launch: hipFuncSetAttribute failed\n"); grid = -1; return; }
        if (hipOccupancyMaxActiveBlocksPerMultiprocessor(&per_cu, (const void*)hybrid_fwd, NWAVES * 64, LDS_BYTES) != hipSuccess || per_cu < 1)
            fprintf(stderr, "kernel_launch: note: occupancy query reports %d workgroups per CU\n", per_cu);
        (void)hipGetLastError();
        grid = cus;
    }
    if (grid < 0) return;
    if (hipMemsetAsync((char*)d_ws + WS_CTL, 0, CTL_ZERO_BYTES, stream) != hipSuccess) return;
    Args a{};
    for (int i = 0; i < 19; ++i) a.in[i] = (const float*)d_in[i];
    a.out = (float*)d_out; a.ws = (unsigned char*)d_ws;
    if (N_LAUNCHES == 1) { a.ph_lo = 0; a.ph_hi = N_PHASES; hipLaunchKernelGGL(hybrid_fwd, dim3(grid), dim3(NWAVES * 64), LDS_BYTES, stream, a); }
    else { for (int p = 0; p < N_PHASES; ++p) { a.ph_lo = p; a.ph_hi = p + 1; hipLaunchKernelGGL(hybrid_fwd, dim3(grid), dim3(NWAVES * 64), LDS_BYTES, stream, a); } }
}
```

```cpp
#include <hip/hip_runtime.h>
#include <cstdio>
#include <cstdint>
#include <cmath>
namespace pg8 {
#define PG8_LAS __attribute__((address_space(3)))
typedef unsigned short bf16_t;
typedef short bf16x8 __attribute__((ext_vector_type(8)));
typedef float f32x4 __attribute__((ext_vector_type(4)));
typedef unsigned u32x4 __attribute__((ext_vector_type(4)));
constexpr int BM = 256, BK = 64, HALF = 128, HTB = HALF * BK * 2  , STAGE_BYTES = 8 * HTB, NXCD = 8, WGM = 8;

__host__ __device__ __forceinline__ int lds_byte(int r, int c) { const int st = (r >> 4) * 2 + (c >> 5), rr = r & 15, cc = c & 31, ob = rr * 64 + cc * 2; return st * 1024 + (ob ^ (((ob >> 9) & 1) << 5)); }
__host__ __device__ __forceinline__ void stage_rc(int b, int& R, int& C) { const int st = b / 1024, sb = b % 1024, swz = sb ^ (((sb >> 9) & 1) << 5); R = (st >> 1) * 16 + swz / 64; C = (st & 1) * 32 + (swz % 64) / 2; }
__host__ __device__ __forceinline__ int perm32(int rho) { const int n = rho >> 4, i = rho & 15; return 8 * (i >> 2) + 4 * n + (i & 3); }

struct Unit { int pm, pn; };
struct Gemm { const bf16_t* A; const bf16_t* Bt; int M, N, K; };

struct StaticOrder {
    int nM, nN, nwg, G, c;
    __host__ __device__ void init(int M, int N, int G_, int c_) { nM = M / BM; nN = N / BM; nwg = nM * nN; G = G_; c = c_; }
    __host__ __device__ bool next(int i, Unit& u) const {
        const long L = (long)i * G + c; if (L >= nwg) return false;
        int wgid = (int)L; { const int q = nwg / NXCD, r = nwg % NXCD, xcd = wgid % NXCD, off = wgid / NXCD; wgid = (xcd < r ? xcd * (q + 1) : r * (q + 1) + (xcd - r) * q) + off; }
        const int nig = WGM * nN, gid = wgid / nig, fm = gid * WGM, gsz = (nM - fm) < WGM ? (nM - fm) : WGM;
        u.pm = fm + ((wgid % nig) % gsz); u.pn = (wgid % nig) / gsz; return true;
    }
    __device__ __forceinline__ void a_ready(const Unit&) const {}
    __device__ __forceinline__ void done(const Unit&) const {}
};

__device__ __forceinline__ unsigned cvt_pk_bf16(float lo, float hi) { unsigned r; asm volatile("v_cvt_pk_bf16_f32 %0, %1, %2" : "=v"(r) : "v"(lo), "v"(hi)); return r; }
typedef float f32x2 __attribute__((ext_vector_type(2)));
__device__ __forceinline__ f32x2 gelu_pk(f32x2 v) {
    const f32x2 av = __builtin_elementwise_abs(v), d = av * 0.2316418882f + 1.0f;
    f32x2 t; t.x = __builtin_amdgcn_rcpf(d.x); t.y = __builtin_amdgcn_rcpf(d.y);
    f32x2 q = t * 0.5307027145f + (-0.7265760135f); q = q * t + 0.7107068705f; q = q * t + (-0.142248368f); q = q * t + 0.127414796f; q = q * t;
    const f32x2 s = (v * v) * (-0.72134752044f);
    f32x2 e; e.x = __builtin_amdgcn_exp2f(s.x); e.y = __builtin_amdgcn_exp2f(s.y);
    const f32x2 m = v * (q * e), r = v - m;
    f32x2 o; o.x = v.x < 0.f ? m.x : r.x; o.y = v.y < 0.f ? m.y : r.y; return o;
}

template <int ACT  > struct EpiBf16 {
    static constexpr bool PERM = true, AFTER_DRAIN = false; static_assert(ACT == 0 || ACT == 1, "EpiBf16: ACT is 0 (none) or 1 (gelu_pk)");
    bf16_t* O; int ldc; const float* bias; int split_cols; size_t split_stride; float scale0;
    __device__ __forceinline__ void operator()(const f32x4 (&acc)[2][2][4][2], const Unit& u, int wr, int wc, int fr, int fq) const {
        const int row0 = u.pm * BM + wr * 64 + fr; int colt = u.pn * BM; bf16_t* base = O;
        float sc = 1.f; if (split_cols) { const int t = colt / split_cols; base += (size_t)t * split_stride; colt -= t * split_cols; if (t == 0) sc = scale0; }
        const int col0 = colt + wc * 32 + 8 * fq, bcol0 = u.pn * BM + wc * 32 + 8 * fq;
        f32x4 bv[2][2];
#pragma unroll
        for (int bj = 0; bj < 2; ++bj)
#pragma unroll
            for (int n = 0; n < 2; ++n) bv[bj][n] = bias ? *(const f32x4*)(bias + bcol0 + bj * HALF + 4 * n) : (f32x4){0.f, 0.f, 0.f, 0.f};
#pragma unroll
        for (int ai = 0; ai < 2; ++ai)
#pragma unroll
            for (int m = 0; m < 4; ++m) { bf16_t* rowp = base + (size_t)(row0 + ai * HALF + m * 16) * ldc + col0;
#pragma unroll
                for (int bj = 0; bj < 2; ++bj) { f32x4 v0 = acc[ai][bj][m][0] + bv[bj][0], v1 = acc[ai][bj][m][1] + bv[bj][1];
                    if (ACT == 1) { f32x2 a = gelu_pk((f32x2){v0[0], v0[1]}), b = gelu_pk((f32x2){v0[2], v0[3]}), c = gelu_pk((f32x2){v1[0], v1[1]}), d = gelu_pk((f32x2){v1[2], v1[3]});
                        v0 = (f32x4){a.x, a.y, b.x, b.y}; v1 = (f32x4){c.x, c.y, d.x, d.y}; }
                    v0 = v0 * sc; v1 = v1 * sc; u32x4 w; w.x = cvt_pk_bf16(v0[0], v0[1]); w.y = cvt_pk_bf16(v0[2], v0[3]); w.z = cvt_pk_bf16(v1[0], v1[1]); w.w = cvt_pk_bf16(v1[2], v1[3]);
                    *(u32x4*)(rowp + bj * HALF) = w; } }
    }
};
#ifndef GATE_FP8
#define GATE_FP8 1
#endif
constexpr float GATE_SCALE = 8.f;
struct EpiZ {
    static constexpr bool PERM = true, AFTER_DRAIN = false;
    bf16_t *zq, *zsq, *za, *zb, *zsk, *zsv, *zkv; float sq_scale, oscale;
    __device__ __forceinline__ void operator()(const f32x4 (&acc)[2][2][4][2], const Unit& u, int wr, int wc, int fr, int fq) const {
        const int pn = u.pn; bf16_t* base; int ld, ct; float sc = oscale; const bool gate8 = GATE_FP8 && pn >= 20 && pn < 52;
        if (pn < 4) { base = zq; ld = 1024; ct = pn; }
        else if (pn < 20) { base = zsq; ld = 4096; ct = pn - 4; sc = sq_scale * oscale; }
        else if (pn < 36) { base = za; ld = 4096; ct = pn - 20; }
        else if (pn < 52) { base = zb; ld = 4096; ct = pn - 36; }
        else if (pn < 54) { base = zsk; ld = 512; ct = pn - 52; }
        else if (pn < 56) { base = zsv; ld = 512; ct = pn - 54; }
        else { base = zkv; ld = 768; ct = pn - 56; }
        const int row0 = u.pm * BM + wr * 64 + fr, col0 = ct * BM + wc * 32 + 8 * fq;
#pragma unroll
        for (int ai = 0; ai < 2; ++ai)
#pragma unroll
            for (int m = 0; m < 4; ++m) { bf16_t* rowp = base + (size_t)(row0 + ai * HALF + m * 16) * ld + col0;
#pragma unroll
                for (int bj = 0; bj < 2; ++bj) { const f32x4 v0 = acc[ai][bj][m][0] * sc, v1 = acc[ai][bj][m][1] * sc;
                    if (gate8) {
                        int t0 = __builtin_amdgcn_cvt_pk_fp8_f32(v0[0] * GATE_SCALE, v0[1] * GATE_SCALE, 0, false); t0 = __builtin_amdgcn_cvt_pk_fp8_f32(v0[2] * GATE_SCALE, v0[3] * GATE_SCALE, t0, true);
                        int t1 = __builtin_amdgcn_cvt_pk_fp8_f32(v1[0] * GATE_SCALE, v1[1] * GATE_SCALE, 0, false); t1 = __builtin_amdgcn_cvt_pk_fp8_f32(v1[2] * GATE_SCALE, v1[3] * GATE_SCALE, t1, true);
                        *(unsigned long long*)((unsigned char*)base + (size_t)(row0 + ai * HALF + m * 16) * ld + col0 + bj * HALF) = (unsigned long long)(unsigned)t0 | ((unsigned long long)(unsigned)t1 << 32); }
                    else {
                    u32x4 w; w.x = cvt_pk_bf16(v0[0], v0[1]); w.y = cvt_pk_bf16(v0[2], v0[3]); w.z = cvt_pk_bf16(v1[0], v1[1]); w.w = cvt_pk_bf16(v1[2], v1[3]);
                    *(u32x4*)(rowp + bj * HALF) = w; } } }
    }
};
struct EpiQ {
    static constexpr bool PERM = true, AFTER_DRAIN = false;
    bf16_t *qn, *qp; const float* rc; const float* rs; float oscale; float q8;
    __device__ __forceinline__ void operator()(const f32x4 (&acc)[2][2][4][2], const Unit& u, int wr, int wc, int fr, int fq) const {
        const int pn = u.pn; const bool rope = pn >= 16;
        bf16_t* base = rope ? qp : qn; const int ld = rope ? 2048 : 4096, ct = rope ? pn - 16 : pn;
        const int row0 = u.pm * BM + wr * 64 + fr, col0 = ct * BM + wc * 32 + 8 * fq;
#pragma unroll
        for (int ai = 0; ai < 2; ++ai)
#pragma unroll
            for (int m = 0; m < 4; ++m) { const int row = row0 + ai * HALF + m * 16; bf16_t* rowp = base + (size_t)row * ld + col0;
#pragma unroll
                for (int bj = 0; bj < 2; ++bj) { f32x4 v0 = acc[ai][bj][m][0] * oscale, v1 = acc[ai][bj][m][1] * oscale;
                    if (rope) { const int i0 = ((col0 + bj * HALF) & 63) >> 1; const int pos = row & 8191;
                        const f32x4 c = *(const f32x4*)(rc + pos * 32 + i0), s = *(const f32x4*)(rs + pos * 32 + i0);
                        const f32x4 a = v0, b = v1;
                        v0[0] = a[0] * c[0] - a[1] * s[0]; v0[1] = a[1] * c[0] + a[0] * s[0]; v0[2] = a[2] * c[1] - a[3] * s[1]; v0[3] = a[3] * c[1] + a[2] * s[1];
                        v1[0] = b[0] * c[2] - b[1] * s[2]; v1[1] = b[1] * c[2] + b[0] * s[2]; v1[2] = b[2] * c[3] - b[3] * s[3]; v1[3] = b[3] * c[3] + b[2] * s[3]; }
                    if (q8 > 0.f) { int t0 = __builtin_amdgcn_cvt_pk_fp8_f32(v0[0] * q8, v0[1] * q8, 0, false); t0 = __builtin_amdgcn_cvt_pk_fp8_f32(v0[2] * q8, v0[3] * q8, t0, true);
                        int t1 = __builtin_amdgcn_cvt_pk_fp8_f32(v1[0] * q8, v1[1] * q8, 0, false); t1 = __builtin_amdgcn_cvt_pk_fp8_f32(v1[2] * q8, v1[3] * q8, t1, true);
                        *(unsigned long long*)((unsigned char*)base + (size_t)row * ld + col0 + bj * HALF) = (unsigned long long)(unsigned)t0 | ((unsigned long long)(unsigned)t1 << 32); }
                    else { u32x4 w; w.x = cvt_pk_bf16(v0[0], v0[1]); w.y = cvt_pk_bf16(v0[2], v0[3]); w.z = cvt_pk_bf16(v1[0], v1[1]); w.w = cvt_pk_bf16(v1[2], v1[3]);
                    *(u32x4*)(rowp + bj * HALF) = w; } } }
    }
};
struct EpiT {
    static constexpr bool PERM = true, AFTER_DRAIN = false;
    bf16_t* T; float* rsq; float oscale;
    __device__ __forceinline__ void operator()(const f32x4 (&acc)[2][2][4][2], const Unit& u, int wr, int wc, int fr, int fq) const {
        const int row0 = u.pm * BM + wr * 64 + fr, col0 = u.pn * BM + wc * 32 + 8 * fq;
#pragma unroll
        for (int ai = 0; ai < 2; ++ai)
#pragma unroll
            for (int m = 0; m < 4; ++m) { const int row = row0 + ai * HALF + m * 16; bf16_t* rowp = T + (size_t)row * 4096 + col0; float s = 0.f;
#pragma unroll
                for (int bj = 0; bj < 2; ++bj) { const f32x4 v0 = acc[ai][bj][m][0] * oscale, v1 = acc[ai][bj][m][1] * oscale;
                    s += (v0[0] * v0[0] + v0[1] * v0[1]) + (v0[2] * v0[2] + v0[3] * v0[3]) + (v1[0] * v1[0] + v1[1] * v1[1]) + (v1[2] * v1[2] + v1[3] * v1[3]);
                    u32x4 w; w.x = cvt_pk_bf16(v0[0], v0[1]); w.y = cvt_pk_bf16(v0[2], v0[3]); w.z = cvt_pk_bf16(v1[0], v1[1]); w.w = cvt_pk_bf16(v1[2], v1[3]);
                    *(u32x4*)(rowp + bj * HALF) = w; }
                s += __shfl_xor(s, 16); s += __shfl_xor(s, 32);
                if (fq == 0) rsq[(size_t)row * 64 + u.pn * 4 + wc] = s; }
    }
};
struct EpiKV {
    static constexpr bool PERM = true, AFTER_DRAIN = false;
    bf16_t *kn, *vm; float oscale; float k8;
    __device__ __forceinline__ void operator()(const f32x4 (&acc)[2][2][4][2], const Unit& u, int wr, int wc, int fr, int fq) const {
        const int pn = u.pn; bf16_t* base = pn < 16 ? kn : vm; const int ct = pn & 15; const bool f8 = pn < 16 && k8 > 0.f;
        const int row0 = u.pm * BM + wr * 64 + fr, col0 = ct * BM + wc * 32 + 8 * fq;
#pragma unroll
        for (int ai = 0; ai < 2; ++ai)
#pragma unroll
            for (int m = 0; m < 4; ++m) { bf16_t* rowp = base + (size_t)(row0 + ai * HALF + m * 16) * 4096 + col0;
#pragma unroll
                for (int bj = 0; bj < 2; ++bj) { const f32x4 v0 = acc[ai][bj][m][0] * oscale, v1 = acc[ai][bj][m][1] * oscale;
                    if (f8) { int t0 = __builtin_amdgcn_cvt_pk_fp8_f32(v0[0] * k8, v0[1] * k8, 0, false); t0 = __builtin_amdgcn_cvt_pk_fp8_f32(v0[2] * k8, v0[3] * k8, t0, true);
                        int t1 = __builtin_amdgcn_cvt_pk_fp8_f32(v1[0] * k8, v1[1] * k8, 0, false); t1 = __builtin_amdgcn_cvt_pk_fp8_f32(v1[2] * k8, v1[3] * k8, t1, true);
                        *(unsigned long long*)((unsigned char*)base + (size_t)(row0 + ai * HALF + m * 16) * 4096 + col0 + bj * HALF) = (unsigned long long)(unsigned)t0 | ((unsigned long long)(unsigned)t1 << 32); continue; }
                    u32x4 w; w.x = cvt_pk_bf16(v0[0], v0[1]); w.y = cvt_pk_bf16(v0[2], v0[3]); w.z = cvt_pk_bf16(v1[0], v1[1]); w.w = cvt_pk_bf16(v1[2], v1[3]);
                    *(u32x4*)(rowp + bj * HALF) = w; } }
    }
};
struct EpiVT {
    static constexpr bool PERM = true, AFTER_DRAIN = false;
    unsigned char* vt; float oscale;
    __device__ __forceinline__ void operator()(const f32x4 (&acc)[2][2][4][2], const Unit& u, int wr, int wc, int fr, int fq) const {
        const int row0 = u.pm * BM + wr * 64 + fr, col0 = u.pn * BM + wc * 32 + 8 * fq;
#pragma unroll
        for (int ai = 0; ai < 2; ++ai)
#pragma unroll
            for (int m = 0; m < 4; ++m) { unsigned char* rowp = vt + (size_t)(row0 + ai * HALF + m * 16) * 16384 + col0;
#pragma unroll
                for (int bj = 0; bj < 2; ++bj) { const f32x4 v0 = acc[ai][bj][m][0] * oscale, v1 = acc[ai][bj][m][1] * oscale;
                    int t0 = __builtin_amdgcn_cvt_pk_fp8_f32(v0[0], v0[1], 0, false); t0 = __builtin_amdgcn_cvt_pk_fp8_f32(v0[2], v0[3], t0, true);
                    int t1 = __builtin_amdgcn_cvt_pk_fp8_f32(v1[0], v1[1], 0, false); t1 = __builtin_amdgcn_cvt_pk_fp8_f32(v1[2], v1[3], t1, true);
                    *(unsigned long long*)(rowp + bj * HALF) = (unsigned long long)(unsigned)t0 | ((unsigned long long)(unsigned)t1 << 32); } }
    }
};

#ifndef G8_BAL
#define G8_BAL 1
#endif
template <class Epi, class Sched, bool ALIGN_EPI = false, bool SP2 = false>
__device__ __forceinline__ void gemm_phase(PG8_LAS unsigned char* lds, const Gemm g, const Sched& S, const Epi& E) {
    const int tid = threadIdx.x, wid = __builtin_amdgcn_readfirstlane(tid >> 6), lane = tid & 63, wr = wid >> 2, wc = wid & 3, fr = lane & 15, fq = lane >> 4;
    const int K = g.K, nt = K / BK;
    unsigned voffA[2], voffB[2];
#pragma unroll
    for (int i = 0; i < 2; ++i) { int R, C; stage_rc(tid * 16 + i * 8192, R, C); const int Rb = Epi::PERM ? ((R & ~31) + perm32(R & 31)) : R;
        voffA[i] = (unsigned)(R * K + C) * 2u; voffB[i] = (unsigned)(Rb * K + C) * 2u; }
    const size_t kstep = (size_t)(BK * 2);
    const size_t hstep = (size_t)HALF * K * 2;
    const size_t tstep = 2 * hstep;
    const unsigned ldsw = (unsigned)wid * 1024u;
    const int aoff = lds_byte(wr * 64 + fr, fq * 8), boff = lds_byte(wc * 32 + fr, fq * 8);
#define PG8_SA(b, h) (((b) * 2 + (h)) * HTB)
#define PG8_SB(b, h) ((4 + (b) * 2 + (h)) * HTB)
#define PG8_STAGE(bufoff, gbase, voff) do { _Pragma("unroll") for (int _i = 0; _i < 2; ++_i) \
        __builtin_amdgcn_global_load_lds((const unsigned*)((const char*)(gbase) + (voff)[_i]), (PG8_LAS unsigned*)(lds + (bufoff) + ldsw + _i * 8192), 16, 0, 0); } while (0)
#define PG8_LDA(dst, b, h) do { _Pragma("unroll") for (int m = 0; m < 4; ++m) _Pragma("unroll") for (int k = 0; k < 2; ++k) dst[m][k] = *(const PG8_LAS bf16x8*)(lds + PG8_SA(b, h) + aoff + m * 2048 + k * 1024); } while (0)
#define PG8_LDB(dst, b, h) do { _Pragma("unroll") for (int n = 0; n < 2; ++n) _Pragma("unroll") for (int k = 0; k < 2; ++k) dst[n][k] = *(const PG8_LAS bf16x8*)(lds + PG8_SB(b, h) + boff + n * 2048 + k * 1024); } while (0)
#define PG8_MMA(ai, bj, At, Bt) do { __builtin_amdgcn_s_setprio(1); _Pragma("unroll") for (int m = 0; m < 4; ++m) _Pragma("unroll") for (int n = 0; n < 2; ++n) _Pragma("unroll") for (int k = 0; k < 2; ++k) \
        acc[ai][bj][m][n] = __builtin_amdgcn_mfma_f32_16x16x32_bf16(Bt[n][k], At[m][k], acc[ai][bj][m][n], 0, 0, 0); __builtin_amdgcn_s_setprio(0); } while (0)
#define PG8_WAIT_V(n) asm volatile("s_waitcnt vmcnt(" #n ")" ::: "memory")
#define PG8_WAIT_L(n) asm volatile("s_waitcnt lgkmcnt(" #n ")" ::: "memory")
#define PG8_BAR __builtin_amdgcn_s_barrier()
#define PG8_SCHED __builtin_amdgcn_sched_barrier(0)
    Unit cur, nxt; int ui = 0;
    if (!S.next(0, cur)) return;
    f32x4 acc[2][2][4][2];
#pragma unroll
    for (int a = 0; a < 2; ++a)
#pragma unroll
        for (int b = 0; b < 2; ++b)
#pragma unroll
            for (int m = 0; m < 4; ++m)
#pragma unroll
                for (int n = 0; n < 2; ++n) acc[a][b][m][n] = (f32x4){0.f, 0.f, 0.f, 0.f};
    bf16x8 At[4][2], B0[2][2], B1[2][2];
    const char* cA = (const char*)g.A + (size_t)cur.pm * tstep; const char* cB = (const char*)g.Bt + (size_t)cur.pn * tstep;
    S.a_ready(cur);
    if constexpr (SP2) {
        PG8_STAGE(PG8_SB(0, 0), cB, voffB); PG8_STAGE(PG8_SB(0, 1), cB + hstep, voffB); PG8_STAGE(PG8_SA(0, 0), cA, voffA); PG8_STAGE(PG8_SA(0, 1), cA + hstep, voffA);
        if (wr == 1) PG8_BAR;
        PG8_WAIT_V(2); PG8_BAR;
        if (G8_BAL) { PG8_STAGE(PG8_SB(1, 0), cB + kstep, voffB); PG8_STAGE(PG8_SB(1, 1), cB + hstep + kstep, voffB); PG8_WAIT_V(4); PG8_BAR; }
        else {
        PG8_STAGE(PG8_SB(1, 0), cB + kstep, voffB); PG8_STAGE(PG8_SA(1, 0), cA + kstep, voffA); PG8_STAGE(PG8_SB(1, 1), cB + hstep + kstep, voffB);
        PG8_WAIT_V(6); PG8_BAR; }
    } else {
        PG8_STAGE(PG8_SB(0, 0), cB, voffB); PG8_STAGE(PG8_SA(0, 0), cA, voffA); PG8_STAGE(PG8_SB(0, 1), cB + hstep, voffB); PG8_STAGE(PG8_SA(0, 1), cA + hstep, voffA);
        if (wr == 1) PG8_BAR;
        PG8_WAIT_V(4); PG8_BAR;
        PG8_STAGE(PG8_SB(1, 0), cB + kstep, voffB); PG8_STAGE(PG8_SA(1, 0), cA + kstep, voffA); PG8_STAGE(PG8_SB(1, 1), cB + hstep + kstep, voffB);
        PG8_WAIT_V(6); PG8_BAR;
    }
    for (;;) {
        const bool has_next = S.next(ui + 1, nxt);
        const char* nA = has_next ? (const char*)g.A + (size_t)nxt.pm * tstep : cA; const char* nB = has_next ? (const char*)g.Bt + (size_t)nxt.pn * tstep : cB;
        for (int t = 0; t < nt; t += 2) {
            const bool last = (t == nt - 2);
            const char* a1 = cA + (size_t)(t + 1) * kstep;
            const char* a2 = last ? nA : cA + (size_t)(t + 2) * kstep; const char* b2 = last ? nB : cB + (size_t)(t + 2) * kstep;
            const char* a3 = a2 + kstep; const char* b3 = b2 + kstep;
            if (last && has_next) S.a_ready(nxt);
            if constexpr (SP2) {
            if constexpr (G8_BAL != 0) {
            PG8_LDB(B0, 0, 0); PG8_LDB(B1, 0, 1); PG8_SCHED; PG8_LDA(At, 0, 0); PG8_STAGE(PG8_SA(1, 0), a1, voffA); PG8_STAGE(PG8_SA(1, 1), a1 + hstep, voffA);
            PG8_WAIT_V(8); PG8_WAIT_L(0); PG8_BAR; PG8_MMA(0, 0, At, B0); PG8_MMA(0, 1, At, B1); PG8_BAR; PG8_SCHED;
            PG8_LDA(At, 0, 1); PG8_STAGE(PG8_SB(0, 0), b2, voffB); PG8_STAGE(PG8_SB(0, 1), b2 + hstep, voffB);
            PG8_WAIT_V(6); PG8_WAIT_L(0); PG8_BAR; PG8_MMA(1, 0, At, B0); PG8_MMA(1, 1, At, B1); PG8_BAR; PG8_SCHED;
            PG8_LDB(B0, 1, 0); PG8_LDB(B1, 1, 1); PG8_SCHED; PG8_LDA(At, 1, 0); PG8_STAGE(PG8_SA(0, 0), a2, voffA); PG8_STAGE(PG8_SA(0, 1), a2 + hstep, voffA);
            PG8_WAIT_V(8); PG8_WAIT_L(0); PG8_BAR; PG8_MMA(0, 0, At, B0); PG8_MMA(0, 1, At, B1); PG8_BAR; PG8_SCHED;
            PG8_LDA(At, 1, 1); PG8_STAGE(PG8_SB(1, 0), b3, voffB); PG8_STAGE(PG8_SB(1, 1), b3 + hstep, voffB);
            PG8_WAIT_V(6); PG8_WAIT_L(0); PG8_BAR; PG8_MMA(1, 0, At, B0); PG8_MMA(1, 1, At, B1); PG8_BAR; PG8_SCHED;
            } else {
            PG8_LDB(B0, 0, 0); PG8_LDB(B1, 0, 1); PG8_SCHED; PG8_LDA(At, 0, 0); PG8_STAGE(PG8_SA(1, 1), a1 + hstep, voffA);
            PG8_WAIT_V(8); PG8_WAIT_L(0); PG8_BAR; PG8_MMA(0, 0, At, B0); PG8_MMA(0, 1, At, B1); PG8_BAR; PG8_SCHED;
            PG8_LDA(At, 0, 1); PG8_STAGE(PG8_SB(0, 0), b2, voffB); PG8_STAGE(PG8_SB(0, 1), b2 + hstep, voffB); PG8_STAGE(PG8_SA(0, 0), a2, voffA);
            PG8_WAIT_V(8); PG8_WAIT_L(0); PG8_BAR; PG8_MMA(1, 0, At, B0); PG8_MMA(1, 1, At, B1); PG8_BAR; PG8_SCHED;
            PG8_LDB(B0, 1, 0); PG8_LDB(B1, 1, 1); PG8_SCHED; PG8_LDA(At, 1, 0); PG8_STAGE(PG8_SA(0, 1), a2 + hstep, voffA);
            PG8_WAIT_V(8); PG8_WAIT_L(0); PG8_BAR; PG8_MMA(0, 0, At, B0); PG8_MMA(0, 1, At, B1); PG8_BAR; PG8_SCHED;
            PG8_LDA(At, 1, 1); PG8_STAGE(PG8_SB(1, 0), b3, voffB); PG8_STAGE(PG8_SB(1, 1), b3 + hstep, voffB); PG8_STAGE(PG8_SA(1, 0), a3, voffA);
            PG8_WAIT_V(8); PG8_WAIT_L(0); PG8_BAR; PG8_MMA(1, 0, At, B0); PG8_MMA(1, 1, At, B1); PG8_BAR; PG8_SCHED;
            }
            } else {
            PG8_LDB(B0, 0, 0); PG8_SCHED; PG8_LDA(At, 0, 0); PG8_STAGE(PG8_SA(1, 1), a1 + hstep, voffA);
            PG8_WAIT_L(8); PG8_BAR; PG8_WAIT_L(0); PG8_MMA(0, 0, At, B0); PG8_BAR; PG8_SCHED;
            PG8_LDB(B1, 0, 1); PG8_STAGE(PG8_SB(0, 0), b2, voffB);
            PG8_BAR; PG8_WAIT_L(0); PG8_MMA(0, 1, At, B1); PG8_BAR;
            PG8_LDA(At, 0, 1); PG8_STAGE(PG8_SA(0, 0), a2, voffA);
            PG8_BAR; PG8_WAIT_L(0); PG8_MMA(1, 0, At, B0); PG8_BAR; PG8_SCHED;
            PG8_STAGE(PG8_SB(0, 1), b2 + hstep, voffB);
            PG8_WAIT_V(6); PG8_BAR; PG8_MMA(1, 1, At, B1); PG8_BAR;
            PG8_LDB(B0, 1, 0); PG8_SCHED; PG8_LDA(At, 1, 0); PG8_STAGE(PG8_SA(0, 1), a2 + hstep, voffA);
            PG8_WAIT_L(8); PG8_BAR; PG8_WAIT_L(0); PG8_MMA(0, 0, At, B0); PG8_BAR; PG8_SCHED;
            PG8_LDB(B1, 1, 1); PG8_STAGE(PG8_SB(1, 0), b3, voffB);
            PG8_BAR; PG8_WAIT_L(0); PG8_MMA(0, 1, At, B1); PG8_BAR;
            PG8_LDA(At, 1, 1); PG8_STAGE(PG8_SA(1, 0), a3, voffA);
            PG8_BAR; PG8_WAIT_L(0); PG8_MMA(1, 0, At, B0); PG8_BAR; PG8_SCHED;
            PG8_STAGE(PG8_SB(1, 1), b3 + hstep, voffB);
            PG8_WAIT_V(6); PG8_BAR; PG8_MMA(1, 1, At, B1); PG8_BAR;
            }
        }
        if constexpr (ALIGN_EPI) { if (wr == 0) PG8_BAR; }
        if constexpr (!Epi::AFTER_DRAIN) { E(acc, cur, wr, wc, fr, fq); S.done(cur); }
        if (!has_next) break;
#pragma unroll
        for (int a = 0; a < 2; ++a)
#pragma unroll
            for (int b = 0; b < 2; ++b)
#pragma unroll
                for (int m = 0; m < 4; ++m)
#pragma unroll
                    for (int n = 0; n < 2; ++n) acc[a][b][m][n] = (f32x4){0.f, 0.f, 0.f, 0.f};
        cur = nxt; cA = nA; cB = nB; ++ui;
        if constexpr (ALIGN_EPI) { if (wr == 1) PG8_BAR; }
    }
    PG8_WAIT_V(0);
    if constexpr (!ALIGN_EPI) { if (wr == 0) PG8_BAR; }
    PG8_BAR;
    if constexpr (Epi::AFTER_DRAIN) { E.fused(acc, cur, wr, wc, fr, fq, lds, wid, lane); S.done(cur); }
#undef PG8_SA
#undef PG8_SB
#undef PG8_STAGE
#undef PG8_LDA
#undef PG8_LDB
#undef PG8_MMA
#undef PG8_WAIT_V
#undef PG8_WAIT_L
#undef PG8_BAR
#undef PG8_SCHED
}

typedef int v8i __attribute__((ext_vector_type(8)));
struct Gemm8 { const unsigned char* A; const unsigned char* Bt; int M, N, K; };
template <class Epi, class Sched, bool ALIGN_EPI = false, bool SP2 = false>
__device__ __forceinline__ void gemm_phase8(PG8_LAS unsigned char* lds, const Gemm8 g, const Sched& S, const Epi& E) {
    constexpr bool BAL = G8_BAL != 0;
    int tid_ = threadIdx.x; asm volatile("" : "+v"(tid_));
    const int tid = tid_, wid = __builtin_amdgcn_readfirstlane(tid >> 6), lane = tid & 63, wr = wid >> 2, wc = wid & 3, fr = lane & 15, fq = lane >> 4;
    const int K = g.K, nt = K / 128;
    unsigned voffA[2], voffB[2];
#pragma unroll
    for (int i = 0; i < 2; ++i) { int R, C; stage_rc(tid * 16 + i * 8192, R, C); const int Rb = Epi::PERM ? ((R & ~31) + perm32(R & 31)) : R;
        const int Cs = C ^ (((R >> 3) & 1) << 3);
        voffA[i] = (unsigned)(R * K + Cs * 2); voffB[i] = (unsigned)(Rb * K + Cs * 2); }
    const size_t kstep = (size_t)128;
    const size_t hstep = (size_t)HALF * K;
    const size_t tstep = 2 * hstep;
    const unsigned ldsw = (unsigned)wid * 1024u;
    const int hp = (fr >> 3) & 1, aoff = lds_byte(wr * 64 + fr, fq * 16) | (hp << 4), boff = lds_byte(wc * 32 + fr, fq * 16) | (hp << 4);
#define PG8_SA(b, h) (((b) * 2 + (h)) * HTB)
#define PG8_SB(b, h) ((4 + (b) * 2 + (h)) * HTB)
#define PG8_STAGE(bufoff, gbase, voff) do { _Pragma("unroll") for (int _i = 0; _i < 2; ++_i) { unsigned vo_ = (voff)[_i]; asm volatile("" : "+v"(vo_)); \
        __builtin_amdgcn_global_load_lds((const unsigned*)((const char*)(gbase) + vo_), (PG8_LAS unsigned*)(lds + (bufoff) + ldsw + _i * 8192), 16, 0, 0); } } while (0)
#define PG8_LDA(dst, b, h) do { int ah_ = aoff ^ 16; asm volatile("" : "+v"(ah_)); _Pragma("unroll") for (int m = 0; m < 4; ++m) { const u32x4 lo_ = *(const PG8_LAS u32x4*)(lds + PG8_SA(b, h) + aoff + m * 2048), hi_ = *(const PG8_LAS u32x4*)(lds + PG8_SA(b, h) + ah_ + m * 2048); dst[m] = (v8i){(int)lo_.x, (int)lo_.y, (int)lo_.z, (int)lo_.w, (int)hi_.x, (int)hi_.y, (int)hi_.z, (int)hi_.w}; } } while (0)
#define PG8_LDB(dst, b, h) do { int bh_ = boff ^ 16; asm volatile("" : "+v"(bh_)); _Pragma("unroll") for (int n = 0; n < 2; ++n) { const u32x4 lo_ = *(const PG8_LAS u32x4*)(lds + PG8_SB(b, h) + boff + n * 2048), hi_ = *(const PG8_LAS u32x4*)(lds + PG8_SB(b, h) + bh_ + n * 2048); dst[n] = (v8i){(int)lo_.x, (int)lo_.y, (int)lo_.z, (int)lo_.w, (int)hi_.x, (int)hi_.y, (int)hi_.z, (int)hi_.w}; } } while (0)
#define PG8_MMA(ai, bj, At, Bt) do { __builtin_amdgcn_s_setprio(1); _Pragma("unroll") for (int m = 0; m < 4; ++m) _Pragma("unroll") for (int n = 0; n < 2; ++n) \
        acc[ai][bj][m][n] = __builtin_amdgcn_mfma_scale_f32_16x16x128_f8f6f4(Bt[n], At[m], acc[ai][bj][m][n], 0, 0, 0, 0, 0, 0); __builtin_amdgcn_s_setprio(0); } while (0)
#define PG8_WAIT_V(n) asm volatile("s_waitcnt vmcnt(" #n ")" ::: "memory")
#define PG8_WAIT_L(n) asm volatile("s_waitcnt lgkmcnt(" #n ")" ::: "memory")
#define PG8_BAR __builtin_amdgcn_s_barrier()
#define PG8_SCHED __builtin_amdgcn_sched_barrier(0)
    Unit cur, nxt; int ui = 0;
    if (!S.next(0, cur)) return;
    f32x4 acc[2][2][4][2];
#pragma unroll
    for (int a = 0; a < 2; ++a)
#pragma unroll
        for (int b = 0; b < 2; ++b)
#pragma unroll
            for (int m = 0; m < 4; ++m)
#pragma unroll
                for (int n = 0; n < 2; ++n) acc[a][b][m][n] = (f32x4){0.f, 0.f, 0.f, 0.f};
    v8i At[4], B0[2], B1[2];
    const char* cA = (const char*)g.A + (size_t)cur.pm * tstep; const char* cB = (const char*)g.Bt + (size_t)cur.pn * tstep;
    S.a_ready(cur);
    if constexpr (SP2) {
        PG8_STAGE(PG8_SB(0, 0), cB, voffB); PG8_STAGE(PG8_SB(0, 1), cB + hstep, voffB); PG8_STAGE(PG8_SA(0, 0), cA, voffA); PG8_STAGE(PG8_SA(0, 1), cA + hstep, voffA);
        if (wr == 1) PG8_BAR;
        PG8_WAIT_V(2); PG8_BAR;
        if (BAL) { PG8_STAGE(PG8_SB(1, 0), cB + kstep, voffB); PG8_STAGE(PG8_SB(1, 1), cB + hstep + kstep, voffB); PG8_WAIT_V(4); PG8_BAR; }
        else {
        PG8_STAGE(PG8_SB(1, 0), cB + kstep, voffB); PG8_STAGE(PG8_SA(1, 0), cA + kstep, voffA); PG8_STAGE(PG8_SB(1, 1), cB + hstep + kstep, voffB);
        PG8_WAIT_V(6); PG8_BAR; }
    } else {
        PG8_STAGE(PG8_SB(0, 0), cB, voffB); PG8_STAGE(PG8_SA(0, 0), cA, voffA); PG8_STAGE(PG8_SB(0, 1), cB + hstep, voffB); PG8_STAGE(PG8_SA(0, 1), cA + hstep, voffA);
        if (wr == 1) PG8_BAR;
        PG8_WAIT_V(4); PG8_BAR;
        PG8_STAGE(PG8_SB(1, 0), cB + kstep, voffB); PG8_STAGE(PG8_SA(1, 0), cA + kstep, voffA); PG8_STAGE(PG8_SB(1, 1), cB + hstep + kstep, voffB);
        PG8_WAIT_V(6); PG8_BAR;
    }
    for (;;) {
        const bool has_next = S.next(ui + 1, nxt);
        const char* nA = has_next ? (const char*)g.A + (size_t)nxt.pm * tstep : cA; const char* nB = has_next ? (const char*)g.Bt + (size_t)nxt.pn * tstep : cB;
#pragma clang loop unroll(disable)
        for (int t = 0; t < nt; t += 2) {
            const bool last = (t == nt - 2);
            const char* a1 = cA + (size_t)(t + 1) * kstep;
            const char* a2 = last ? nA : cA + (size_t)(t + 2) * kstep; const char* b2 = last ? nB : cB + (size_t)(t + 2) * kstep;
            const char* a3 = a2 + kstep; const char* b3 = b2 + kstep;
            if (last && has_next) S.a_ready(nxt);
            if constexpr (SP2) {
            if constexpr (BAL) {
            PG8_LDB(B0, 0, 0); PG8_LDB(B1, 0, 1); PG8_SCHED; PG8_LDA(At, 0, 0); PG8_STAGE(PG8_SA(1, 0), a1, voffA); PG8_STAGE(PG8_SA(1, 1), a1 + hstep, voffA);
            PG8_WAIT_V(8); PG8_WAIT_L(0); PG8_BAR; PG8_MMA(0, 0, At, B0); PG8_MMA(0, 1, At, B1); PG8_BAR; PG8_SCHED;
            PG8_LDA(At, 0, 1); PG8_STAGE(PG8_SB(0, 0), b2, voffB); PG8_STAGE(PG8_SB(0, 1), b2 + hstep, voffB);
            PG8_WAIT_V(6); PG8_WAIT_L(0); PG8_BAR; PG8_MMA(1, 0, At, B0); PG8_MMA(1, 1, At, B1); PG8_BAR; PG8_SCHED;
            PG8_LDB(B0, 1, 0); PG8_LDB(B1, 1, 1); PG8_SCHED; PG8_LDA(At, 1, 0); PG8_STAGE(PG8_SA(0, 0), a2, voffA); PG8_STAGE(PG8_SA(0, 1), a2 + hstep, voffA);
            PG8_WAIT_V(8); PG8_WAIT_L(0); PG8_BAR; PG8_MMA(0, 0, At, B0); PG8_MMA(0, 1, At, B1); PG8_BAR; PG8_SCHED;
            PG8_LDA(At, 1, 1); PG8_STAGE(PG8_SB(1, 0), b3, voffB); PG8_STAGE(PG8_SB(1, 1), b3 + hstep, voffB);
            PG8_WAIT_V(6); PG8_WAIT_L(0); PG8_BAR; PG8_MMA(1, 0, At, B0); PG8_MMA(1, 1, At, B1); PG8_BAR; PG8_SCHED;
            } else {
            PG8_LDB(B0, 0, 0); PG8_LDB(B1, 0, 1); PG8_SCHED; PG8_LDA(At, 0, 0); PG8_STAGE(PG8_SA(1, 1), a1 + hstep, voffA);
            PG8_WAIT_V(8); PG8_WAIT_L(0); PG8_BAR; PG8_MMA(0, 0, At, B0); PG8_MMA(0, 1, At, B1); PG8_BAR; PG8_SCHED;
            PG8_LDA(At, 0, 1); PG8_STAGE(PG8_SB(0, 0), b2, voffB); PG8_STAGE(PG8_SB(0, 1), b2 + hstep, voffB); PG8_STAGE(PG8_SA(0, 0), a2, voffA);
            PG8_WAIT_V(8); PG8_WAIT_L(0); PG8_BAR; PG8_MMA(1, 0, At, B0); PG8_MMA(1, 1, At, B1); PG8_BAR; PG8_SCHED;
            PG8_LDB(B0, 1, 0); PG8_LDB(B1, 1, 1); PG8_SCHED; PG8_LDA(At, 1, 0); PG8_STAGE(PG8_SA(0, 1), a2 + hstep, voffA);
            PG8_WAIT_V(8); PG8_WAIT_L(0); PG8_BAR; PG8_MMA(0, 0, At, B0); PG8_MMA(0, 1, At, B1); PG8_BAR; PG8_SCHED;
            PG8_LDA(At, 1, 1); PG8_STAGE(PG8_SB(1, 0), b3, voffB); PG8_STAGE(PG8_SB(1, 1), b3 + hstep, voffB); PG8_STAGE(PG8_SA(1, 0), a3, voffA);
            PG8_WAIT_V(8); PG8_WAIT_L(0); PG8_BAR; PG8_MMA(1, 0, At, B0); PG8_MMA(1, 1, At, B1); PG8_BAR; PG8_SCHED;
            }
            } else {
            PG8_LDB(B0, 0, 0); PG8_SCHED; PG8_LDA(At, 0, 0); PG8_STAGE(PG8_SA(1, 1), a1 + hstep, voffA);
            PG8_WAIT_L(8); PG8_BAR; PG8_WAIT_L(0); PG8_MMA(0, 0, At, B0); PG8_BAR; PG8_SCHED;
            PG8_LDB(B1, 0, 1); PG8_STAGE(PG8_SB(0, 0), b2, voffB);
            PG8_BAR; PG8_WAIT_L(0); PG8_MMA(0, 1, At, B1); PG8_BAR;
            PG8_LDA(At, 0, 1); PG8_STAGE(PG8_SA(0, 0), a2, voffA);
            PG8_BAR; PG8_WAIT_L(0); PG8_MMA(1, 0, At, B0); PG8_BAR; PG8_SCHED;
            PG8_STAGE(PG8_SB(0, 1), b2 + hstep, voffB);
            PG8_WAIT_V(6); PG8_BAR; PG8_MMA(1, 1, At, B1); PG8_BAR;
            PG8_LDB(B0, 1, 0); PG8_SCHED; PG8_LDA(At, 1, 0); PG8_STAGE(PG8_SA(0, 1), a2 + hstep, voffA);
            PG8_WAIT_L(8); PG8_BAR; PG8_WAIT_L(0); PG8_MMA(0, 0, At, B0); PG8_BAR; PG8_SCHED;
            PG8_LDB(B1, 1, 1); PG8_STAGE(PG8_SB(1, 0), b3, voffB);
            PG8_BAR; PG8_WAIT_L(0); PG8_MMA(0, 1, At, B1); PG8_BAR;
            PG8_LDA(At, 1, 1); PG8_STAGE(PG8_SA(1, 0), a3, voffA);
            PG8_BAR; PG8_WAIT_L(0); PG8_MMA(1, 0, At, B0); PG8_BAR; PG8_SCHED;
            PG8_STAGE(PG8_SB(1, 1), b3 + hstep, voffB);
            PG8_WAIT_V(6); PG8_BAR; PG8_MMA(1, 1, At, B1); PG8_BAR;
            }
        }
        if constexpr (ALIGN_EPI) { if (wr == 0) PG8_BAR; }
        if constexpr (!Epi::AFTER_DRAIN) { int t2_ = threadIdx.x; asm volatile("" : "+v"(t2_)); const int fr_ = t2_ & 15, fq_ = (t2_ >> 4) & 3; E(acc, cur, wr, wc, fr_, fq_); S.done(cur); }
        if (!has_next) break;
#pragma unroll
        for (int a = 0; a < 2; ++a)
#pragma unroll
            for (int b = 0; b < 2; ++b)
#pragma unroll
                for (int m = 0; m < 4; ++m)
#pragma unroll
                    for (int n = 0; n < 2; ++n) acc[a][b][m][n] = (f32x4){0.f, 0.f, 0.f, 0.f};
        cur = nxt; cA = nA; cB = nB; ++ui;
        if constexpr (ALIGN_EPI) { if (wr == 1) PG8_BAR; }
    }
    PG8_WAIT_V(0);
    if constexpr (!ALIGN_EPI) { if (wr == 0) PG8_BAR; }
    PG8_BAR;
    if constexpr (Epi::AFTER_DRAIN) { E.fused(acc, cur, wr, wc, fr, fq, lds, wid, lane); S.done(cur); }
#undef PG8_SA
#undef PG8_SB
#undef PG8_STAGE
#undef PG8_LDA
#undef PG8_LDB
#undef PG8_MMA
#undef PG8_WAIT_V
#undef PG8_WAIT_L
#undef PG8_BAR
#undef PG8_SCHED
}
}
#define GAS __attribute__((address_space(1)))
#define LAS __attribute__((address_space(3)))
typedef unsigned short bf16;
typedef unsigned v4u __attribute__((ext_vector_type(4)));
typedef float f32x4 __attribute__((ext_vector_type(4)));
typedef short bf16x8 __attribute__((ext_vector_type(8)));
typedef GAS unsigned gu32;
typedef GAS unsigned long long gu64;
#define RLX_AGENT __ATOMIC_RELAXED, __HIP_MEMORY_SCOPE_AGENT
#define LDS_WAIT() asm volatile("s_waitcnt lgkmcnt(0)" ::: "memory")
#define VM_WAIT() asm volatile("s_waitcnt vmcnt(0)" ::: "memory")
__device__ __forceinline__ unsigned long long rt() { return __builtin_amdgcn_s_memrealtime(); }
__device__ __forceinline__ unsigned f2bf(float f) { unsigned u = __builtin_bit_cast(unsigned, f); return (u + 0x7fffu + ((u >> 16) & 1u)) >> 16; }
__device__ __forceinline__ unsigned pk2(float lo, float hi) { return f2bf(lo) | (f2bf(hi) << 16); }

#define XB_TMO      128
#define XB_XCNT(j)  (256  + 64 * (j))
#define XB_XSUB(j)  (1280 + 64 * (j))
#define XB_XGEN(j)  (2304 + 64 * (j))
#define XB_TOP      3328
#define XB_TOPGEN   3392
#define XCD_BAR_WORDS 3456
#define XB_SPIN_CAP (1u << 18)

__device__ __forceinline__ unsigned xb_ld(unsigned* p)              { return __hip_atomic_load(p, __ATOMIC_RELAXED, __HIP_MEMORY_SCOPE_AGENT); }
__device__ __forceinline__ unsigned xb_add(unsigned* p, unsigned v) { return __hip_atomic_fetch_add(p, v, __ATOMIC_RELAXED, __HIP_MEMORY_SCOPE_AGENT); }
__device__ __forceinline__ unsigned xb_xcc_id() { return (unsigned)__builtin_amdgcn_s_getreg((3 << 11) | 20) & 0xFu; }
#define XB_SPIN(cond, bar) do { unsigned _sp = 0; while (cond) { __builtin_amdgcn_s_sleep(1); \
    if ((++_sp & 255u) == 0u) { if (xb_ld(&(bar)[XB_TMO])) break; if (_sp > XB_SPIN_CAP) { atomicAdd(&(bar)[XB_TMO], 1u); break; } } } } while (0)

struct XcdBarrier {
    unsigned* bar; unsigned x;
    volatile LAS unsigned* st;
};

__device__ __forceinline__ XcdBarrier xcd_barrier_post(unsigned* bar, volatile LAS unsigned* st) {
    XcdBarrier b; b.bar = bar; b.x = xb_xcc_id(); b.st = st;
    if (threadIdx.x == 0) (void)xb_add(&bar[XB_XCNT(b.x)], 1u);
    return b;
}
__device__ __forceinline__ void xcd_barrier_complete(unsigned* bar, unsigned x, unsigned& nloc, unsigned& nx) {
    const unsigned G = gridDim.x * gridDim.y * gridDim.z;
    unsigned sum, cnt, mine, sp = 0u;
    for (;;) {
        sum = 0u; cnt = 0u; mine = 0u;
#pragma unroll
        for (unsigned j = 0; j < 16; ++j) { const unsigned c = xb_ld(&bar[XB_XCNT(j)]); sum += c; cnt += (c > 0u) ? 1u : 0u; mine = (j == x) ? c : mine; }
        if (sum == G) break;
        __builtin_amdgcn_s_sleep(1);
        if ((++sp & 255u) == 0u) { if (xb_ld(&bar[XB_TMO])) break; if (sp > XB_SPIN_CAP) { atomicAdd(&bar[XB_TMO], 1u); break; } }
    }
    nloc = mine > 0u ? mine : 1u; nx = cnt > 0u ? cnt : 1u;
}

__device__ __forceinline__ void xcd_barrier(const XcdBarrier& b) {
    asm volatile("s_waitcnt vmcnt(0)" ::: "memory");
    __syncthreads();
    if (threadIdx.x == 0) {
        unsigned* bar = b.bar;
        __builtin_amdgcn_s_waitcnt(0);
        unsigned nloc = b.st[0], nx = b.st[1];
        if (nloc == 0u) { xcd_barrier_complete(bar, b.x, nloc, nx); b.st[0] = nloc; b.st[1] = nx; }
        const unsigned old = xb_add(&bar[XB_XSUB(b.x)], 1u);
        const unsigned gen = old / nloc;
        if (old + 1u == (gen + 1u) * nloc) {
            __builtin_amdgcn_fence(__ATOMIC_RELEASE, "agent");
            asm volatile("s_waitcnt vmcnt(0)" ::: "memory");
            const unsigned og = xb_add(&bar[XB_TOP], 1u);
            const unsigned tg = og / nx;
            if (og + 1u == (tg + 1u) * nx) xb_add(&bar[XB_TOPGEN], 1u);
            else XB_SPIN(xb_ld(&bar[XB_TOPGEN]) == tg, bar);
            __builtin_amdgcn_fence(__ATOMIC_ACQUIRE, "agent");
            xb_add(&bar[XB_XGEN(b.x)], 1u);
            asm volatile("s_waitcnt vmcnt(0)" ::: "memory");
        } else {
            XB_SPIN(xb_ld(&bar[XB_XGEN(b.x)]) == gen, bar);
            __builtin_amdgcn_fence(__ATOMIC_ACQUIRE, "agent");
            asm volatile("s_waitcnt vmcnt(0)" ::: "memory");
        }
    }
    __syncthreads();
}

constexpr int NWAVES = 8;
constexpr int BATCH = 2, SEQ = 8192, DM = 4096, M = BATCH * SEQ;
constexpr int NZ = 15104;
constexpr int NADA = 6 * DM;
constexpr int IN_W = 14912;
constexpr float NORM_EPS = 1e-6f;
constexpr float LOG2E = 1.4426950408889634f;
constexpr float H_SCALE = 16.f, WIN_SCALE = 512.f, MIX_SCALE = 64.f, WOUT_SCALE = 512.f, LAT_SCALE = 16.f, WQB_SCALE = 256.f, WKVB_SCALE = 256.f, QK8_SCALE = 16.f, V8_SCALE = 16.f, P8_SCALE = 256.f;

constexpr size_t MiB = 1u << 20;
constexpr size_t WS_CTL = 0, CTL_ZERO_BYTES = 1 * MiB;
constexpr size_t WS_ADA = 1 * MiB;
constexpr size_t WS_ROPE = 2 * MiB;
constexpr size_t WS_SUBK = 4 * MiB;
constexpr size_t WS_RSQ = 5 * MiB;
constexpr size_t WS_ADAP = 9 * MiB;
constexpr size_t WS_WIN = 22 * MiB;
constexpr size_t WS_WQB = 140 * MiB;
constexpr size_t WS_WKVB = 152 * MiB;
constexpr size_t WS_WOUT = 160 * MiB;
constexpr size_t WS_WPQ = 192 * MiB;
constexpr size_t WS_H = 208 * MiB;
constexpr size_t WS_ZQ = 336 * MiB;
constexpr size_t WS_ZSQ = 368 * MiB;
constexpr size_t WS_ZA = 496 * MiB;
constexpr size_t WS_ZB = 624 * MiB;
constexpr size_t WS_ZSK = 752 * MiB;
constexpr size_t WS_ZSV = 768 * MiB;
constexpr size_t WS_ZKV = 784 * MiB;
constexpr size_t WS_ZQN = 808 * MiB;
constexpr size_t WS_CKV = 840 * MiB;
constexpr size_t WS_KPE = 856 * MiB;
constexpr size_t WS_QN = 860 * MiB;
constexpr size_t WS_QP = 988 * MiB;
constexpr size_t WS_KN = 1052 * MiB;
constexpr size_t WS_VM = 1180 * MiB;
constexpr size_t WS_OA = 1308 * MiB;
constexpr size_t WS_END = 1436 * MiB;
constexpr size_t WS_T = WS_ZSQ;
constexpr size_t WS_PQ = WS_ZA;
constexpr size_t WS_EXP = WS_ZA + 64 * MiB;
constexpr size_t WS_GATE = WS_ZA + 72 * MiB;
constexpr size_t WS_UB = WS_QN;
constexpr size_t WS_VB = WS_KN;
constexpr size_t WS_PX = WS_ZB;
constexpr size_t WS_AV = WS_ZB + 64 * MiB;
constexpr size_t WS_Y = WS_OA;
constexpr size_t WS_RS = WS_ADAP;
constexpr int CW_TMO = 0, CW_CODE = 1;
constexpr int CW_CEN = 8192;
constexpr int CW_BAR = 4096;

constexpr int RING_OFF = 0, RING_BYTES = 131072;
constexpr int LDSCTL_OFF = RING_BYTES, MISC_OFF = LDSCTL_OFF + 320;
constexpr int LDS_BYTES = 147456;


#ifndef MLA_FP8QK
#define MLA_FP8QK 1
#endif
#ifndef MLA_FP8PV
#define MLA_FP8PV 1
#endif
#ifndef P5_FP8
#define P5_FP8 1
#endif
#ifndef WOUT_FP8
#define WOUT_FP8 1
#endif
typedef __bf16 bf16x2_t __attribute__((ext_vector_type(2)));
struct Frame {
    LAS unsigned char* lds;
    volatile LAS unsigned* MISC;
    gu32* ctl;
    int tid, lane, wave;
    int vcu, G;
};
__device__ __forceinline__ float dpp_add_(float v, int dummy) { return v; }
#define WS_DPP(v, ctrl) ((v) + __builtin_bit_cast(float, __builtin_amdgcn_update_dpp(0, __builtin_bit_cast(int, (v)), (ctrl), 0xf, 0xf, true)))
__device__ __forceinline__ float wave_sum(float v) {
    v = WS_DPP(v, 0xB1); v = WS_DPP(v, 0x4E); v = WS_DPP(v, 0x141); v = WS_DPP(v, 0x140);
    { auto r = __builtin_amdgcn_permlane16_swap(__float_as_uint(v), __float_as_uint(v), false, false); v = __uint_as_float(r[0]) + __uint_as_float(r[1]); }
    { auto r = __builtin_amdgcn_permlane32_swap(__float_as_uint(v), __float_as_uint(v), false, false); v = __uint_as_float(r[0]) + __uint_as_float(r[1]); }
    return v;
}
__device__ __forceinline__ float bflo(unsigned w) { return __uint_as_float(w << 16); }
__device__ __forceinline__ float bfhi(unsigned w) { return __uint_as_float(w & 0xffff0000u); }
__device__ __forceinline__ unsigned cvtpk(float lo, float hi) { unsigned r; asm volatile("v_cvt_pk_bf16_f32 %0, %1, %2" : "=v"(r) : "v"(lo), "v"(hi)); return r; }
__device__ __forceinline__ float dot2bf(unsigned a, unsigned b, float acc) { return __builtin_amdgcn_fdot2_f32_bf16(__builtin_bit_cast(bf16x2_t, a), __builtin_bit_cast(bf16x2_t, b), acc, false); }

struct MapId { __device__ __forceinline__ int operator()(int n) const { return n; } };
struct MapWin { __device__ __forceinline__ int operator()(int n) const {
    if (n < 1024) return n;
    if (n < 5120) return 1600 + (n - 1024);
    if (n < 9216) return 6720 + (n - 5120);
    if (n < 13312) return 10816 + (n - 9216);
    if (n < 13824) return 5696 + (n - 13312);
    if (n < 14336) return 6208 + (n - 13824);
    if (n < 14912) return 1024 + (n - 14336);
    return -1; } };
struct MapWqb { __device__ __forceinline__ int operator()(int n) const {
    if (n < 4096) return (n >> 7) * 192 + (n & 127);
    const int m = n - 4096, h = m >> 6, p = m & 63, dim = (p >> 1) + ((p & 1) << 5);
    return h * 192 + 128 + dim; } };
struct MapWkvb { __device__ __forceinline__ int operator()(int n) const {
    if (n < 4096) return (n >> 7) * 256 + (n & 127);
    const int m = n - 4096; return (m >> 7) * 256 + 128 + (m & 127); } };
template <class Map>
__device__ __forceinline__ void transpose_item(const float* W, int K, int N, bf16* WT, LAS float* scr, int item, int nblk, int lane, const Map& map) {
    const int kb = item / nblk, nb = item % nblk, k0 = 64 * kb, n0 = 32 * nb;
    const int sc = map(n0 + (lane & 31));
#pragma unroll 8
    for (int i = 0; i < 32; ++i) { const int kk = 2 * i + (lane >> 5); scr[kk * 33 + (lane & 31)] = sc >= 0 ? W[(size_t)(k0 + kk) * N + sc] : 0.f; }
    LDS_WAIT(); asm volatile("" ::: "memory");
    const int c = lane & 7;
#pragma unroll
    for (int j = 0; j < 4; ++j) { const int n = (lane >> 3) + 8 * j; const LAS float* s = scr + (8 * c) * 33 + n;
        v4u o; o.x = pk2(s[0 * 33], s[1 * 33]); o.y = pk2(s[2 * 33], s[3 * 33]); o.z = pk2(s[4 * 33], s[5 * 33]); o.w = pk2(s[6 * 33], s[7 * 33]);
        *(GAS v4u*)(WT + (size_t)(n0 + n) * K + k0 + 8 * c) = o; }
    LDS_WAIT(); asm volatile("" ::: "memory");
}
template <class Map, int FP8, bool VEC4>
__device__ __forceinline__ void transpose_item64(const float* W, int K, int N, unsigned char* WT, float scale, LAS float* scr, int item, int nblk, int lane, const Map& map) {
    const int kb = item / nblk, nb = item % nblk, k0 = 64 * kb, n0 = 64 * nb, j4 = (lane & 15) * 4, kr = lane >> 4;
    int sc[4];
#pragma unroll
    for (int e = 0; e < 4; ++e) sc[e] = map(n0 + j4 + e);
    f32x4 ld[16];
#pragma unroll
    for (int i = 0; i < 16; ++i) { const int kk = 4 * i + kr; const float* wr = W + (size_t)(k0 + kk) * N;
        if (VEC4) { ld[i] = sc[0] >= 0 ? *(const GAS f32x4*)(wr + sc[0]) : (f32x4){0.f, 0.f, 0.f, 0.f}; }
        else { ld[i].x = sc[0] >= 0 ? wr[sc[0]] : 0.f; ld[i].y = sc[1] >= 0 ? wr[sc[1]] : 0.f; ld[i].z = sc[2] >= 0 ? wr[sc[2]] : 0.f; ld[i].w = sc[3] >= 0 ? wr[sc[3]] : 0.f; } }
#pragma unroll
    for (int i = 0; i < 16; ++i) { const int kk = 4 * i + kr; LAS float* row = scr + kk * 64;
        row[(j4 + 0 + kk) & 63] = ld[i].x; row[(j4 + 1 + kk) & 63] = ld[i].y; row[(j4 + 2 + kk) & 63] = ld[i].z; row[(j4 + 3 + kk) & 63] = ld[i].w; }
    LDS_WAIT(); asm volatile("" ::: "memory");
    float v[64];
#pragma unroll
    for (int k = 0; k < 64; ++k) v[k] = scr[k * 64 + ((lane + k) & 63)] * scale;
    if (FP8) { GAS v4u* o = (GAS v4u*)(WT + (size_t)(n0 + lane) * K + k0);
#pragma unroll
        for (int q = 0; q < 4; ++q) { v4u w; int t;
            t = __builtin_amdgcn_cvt_pk_fp8_f32(v[16 * q + 0], v[16 * q + 1], 0, false); t = __builtin_amdgcn_cvt_pk_fp8_f32(v[16 * q + 2], v[16 * q + 3], t, true); w.x = (unsigned)t;
            t = __builtin_amdgcn_cvt_pk_fp8_f32(v[16 * q + 4], v[16 * q + 5], 0, false); t = __builtin_amdgcn_cvt_pk_fp8_f32(v[16 * q + 6], v[16 * q + 7], t, true); w.y = (unsigned)t;
            t = __builtin_amdgcn_cvt_pk_fp8_f32(v[16 * q + 8], v[16 * q + 9], 0, false); t = __builtin_amdgcn_cvt_pk_fp8_f32(v[16 * q + 10], v[16 * q + 11], t, true); w.z = (unsigned)t;
            t = __builtin_amdgcn_cvt_pk_fp8_f32(v[16 * q + 12], v[16 * q + 13], 0, false); t = __builtin_amdgcn_cvt_pk_fp8_f32(v[16 * q + 14], v[16 * q + 15], t, true); w.w = (unsigned)t;
            o[q] = w; } }
    else { GAS v4u* o = (GAS v4u*)(WT + ((size_t)(n0 + lane) * K + k0) * 2);
#pragma unroll
        for (int q = 0; q < 8; ++q) { v4u w; w.x = cvtpk(v[8 * q + 0], v[8 * q + 1]); w.y = cvtpk(v[8 * q + 2], v[8 * q + 3]); w.z = cvtpk(v[8 * q + 4], v[8 * q + 5]); w.w = cvtpk(v[8 * q + 6], v[8 * q + 7]); o[q] = w; } }
    LDS_WAIT(); asm volatile("" ::: "memory");
}
__device__ __forceinline__ void convert_bf16(Frame& F, const float* src, bf16* dst, size_t n8) {
    const size_t nthr = (size_t)F.G * 512, t0 = (size_t)blockIdx.x * 512 + F.tid;
    for (size_t i = t0; i < n8; i += nthr) { const f32x4 a = *(const GAS f32x4*)(src + i * 8), b = *(const GAS f32x4*)(src + i * 8 + 4);
        v4u o; o.x = cvtpk(a.x, a.y); o.y = cvtpk(a.z, a.w); o.z = cvtpk(b.x, b.y); o.w = cvtpk(b.z, b.w); *(GAS v4u*)(dst + i * 8) = o; }
}

__device__ __forceinline__ void convert_slices(Frame& F, const float* src, bf16* dst) {
    const size_t n8 = (size_t)16384 * 512, nthr = (size_t)F.G * 512, t0 = (size_t)blockIdx.x * 512 + F.tid;
    for (size_t i = t0; i < n8; i += nthr) { const f32x4 a = *(const GAS f32x4*)(src + i * 8), b = *(const GAS f32x4*)(src + i * 8 + 4);
        const size_t e = i >> 9; const int g = (int)(i & 511), s = g >> 3, c = g & 7;
        v4u o; o.x = cvtpk(a.x, a.y); o.y = cvtpk(a.z, a.w); o.z = cvtpk(b.x, b.y); o.w = cvtpk(b.z, b.w); *(GAS v4u*)(dst + ((size_t)s * 16384 + e) * 64 + c * 8) = o; }
}
__device__ __forceinline__ void convert_slices_fp8(Frame& F, const float* src, unsigned char* dst, float scale) {
    const size_t n16 = (size_t)16384 * 256, nthr = (size_t)F.G * 512, t0 = (size_t)blockIdx.x * 512 + F.tid;
    for (size_t i = t0; i < n16; i += nthr) { const GAS f32x4* p = (const GAS f32x4*)(src + i * 16); const f32x4 a = p[0] * scale, b = p[1] * scale, c4 = p[2] * scale, d = p[3] * scale;
        const size_t e = i >> 8; const int g = (int)(i & 255), s = g >> 3, c = g & 7;
        v4u o; int w;
        w = __builtin_amdgcn_cvt_pk_fp8_f32(a.x, a.y, 0, false); w = __builtin_amdgcn_cvt_pk_fp8_f32(a.z, a.w, w, true); o.x = (unsigned)w;
        w = __builtin_amdgcn_cvt_pk_fp8_f32(b.x, b.y, 0, false); w = __builtin_amdgcn_cvt_pk_fp8_f32(b.z, b.w, w, true); o.y = (unsigned)w;
        w = __builtin_amdgcn_cvt_pk_fp8_f32(c4.x, c4.y, 0, false); w = __builtin_amdgcn_cvt_pk_fp8_f32(c4.z, c4.w, w, true); o.z = (unsigned)w;
        w = __builtin_amdgcn_cvt_pk_fp8_f32(d.x, d.y, 0, false); w = __builtin_amdgcn_cvt_pk_fp8_f32(d.z, d.w, w, true); o.w = (unsigned)w;
        *(GAS v4u*)(dst + ((size_t)s * 16384 + e) * 128 + c * 16) = o; }
}
__device__ __forceinline__ void p0_prologue(Frame& F, const float* c, const float* w_ada, const float* w_in, const float* w_q_b, const float* w_kv_b, const float* w_out,
                                            const float* w_peer_q, const float* sub_keys, unsigned char* ws) {
    { LAS float* sl = (LAS float*)(F.lds);
      float* adap = (float*)(ws + WS_ADAP);
      for (int w = blockIdx.x; w < 256; w += F.G) {
          const int kc = w >> 2, cq = w & 3;
          __syncthreads();
          if (F.tid < 128) { const int b = F.tid >> 6, kk = F.tid & 63; const float v = c[b * DM + kc * 64 + kk]; sl[F.tid] = v / (1.f + __expf(-v)); }
          __syncthreads();
          for (int cg = F.tid; cg < 1536; cg += 512) {
              const int col = cq * 6144 + 4 * cg; f32x4 a0 = {0.f, 0.f, 0.f, 0.f}, a1 = {0.f, 0.f, 0.f, 0.f};
              const float* wp = w_ada + (size_t)(kc * 64) * NADA + col;
#pragma unroll 8
              for (int kk = 0; kk < 64; ++kk) { const f32x4 w4 = *(const GAS f32x4*)(wp + (size_t)kk * NADA); a0 += w4 * sl[kk]; a1 += w4 * sl[64 + kk]; }
              *(GAS f32x4*)(adap + (size_t)(kc * 2 + 0) * NADA + col) = a0;
              *(GAS f32x4*)(adap + (size_t)(kc * 2 + 1) * NADA + col) = a1;
          }
      }
      __syncthreads(); }
    { float* rc = (float*)(ws + WS_ROPE); float* rs = rc + SEQ * 32;
      for (int e = blockIdx.x * 512 + F.tid; e < SEQ * 32; e += F.G * 512) { const int pos = e >> 5, i = e & 31;
          const float invf = exp2f(-(float)(2 * i) * (13.287712379549449f / 64.f));
          const float ang = (float)pos * invf;
          double t = (double)ang * 0.15915494309189535; t -= floor(t);
          const float r = (float)(t * 6.283185307179586);
          rc[e] = cosf(r); rs[e] = sinf(r); } }
    convert_bf16(F, sub_keys, (bf16*)(ws + WS_SUBK), (size_t)16 * 128 * 128 / 8);
    { LAS float* scr = (LAS float*)(F.lds + RING_OFF + F.wave * 16384);
      const int gw = F.vcu * NWAVES + F.wave, NGW = F.G * NWAVES;
      constexpr int I_IN = 64 * (NZ / 64), I_QB = 16 * (6144 / 64), I_KVB = 8 * (8192 / 64), I_OUT = 64 * (4096 / 64), I_PQ = 64 * (2048 / 64);
      constexpr int NITEMS = I_IN + I_QB + I_KVB + I_OUT + I_PQ;
      for (int it = gw; it < NITEMS; it += NGW) {
          int r = it;
          if (r < I_IN) { transpose_item64<MapWin, 1, true>(w_in, DM, IN_W, ws + WS_WIN, WIN_SCALE, scr, r, NZ / 64, F.lane, MapWin()); continue; } r -= I_IN;
          if (r < I_QB) { transpose_item64<MapWqb, P5_FP8, false>(w_q_b, 1024, 6144, ws + WS_WQB, P5_FP8 ? WQB_SCALE : 1.f, scr, r, 6144 / 64, F.lane, MapWqb()); continue; } r -= I_QB;
          if (r < I_KVB) { transpose_item64<MapWkvb, P5_FP8, true>(w_kv_b, 512, 8192, ws + WS_WKVB, P5_FP8 ? WKVB_SCALE : 1.f, scr, r, 8192 / 64, F.lane, MapWkvb()); continue; } r -= I_KVB;
          if (r < I_OUT) { transpose_item64<MapId, WOUT_FP8, true>(w_out, DM, DM, ws + WS_WOUT, WOUT_FP8 ? WOUT_SCALE : 1.f, scr, r, 4096 / 64, F.lane, MapId()); continue; } r -= I_OUT;
          transpose_item64<MapId, 0, true>(w_peer_q, DM, 2048, ws + WS_WPQ, 1.f, scr, r, 2048 / 64, F.lane, MapId());
      } }
}
__device__ __forceinline__ void p1_ada_reduce(Frame& F, const float* b_ada, unsigned char* ws) {
    const float* adap = (const float*)(ws + WS_ADAP); float* ada = (float*)(ws + WS_ADA);
    for (int o = blockIdx.x * 512 + F.tid; o < 2 * NADA; o += F.G * 512) { const int b = o / NADA, j = o - b * NADA; float s = b_ada[j];
#pragma unroll 8
        for (int kc = 0; kc < 64; ++kc) s += adap[(size_t)(kc * 2 + b) * NADA + j];
        ada[o] = s; }
}
__device__ __forceinline__ void p2_modnorm(Frame& F, const float* x, const float* g, unsigned char* ws) {
    const int gw = F.vcu * NWAVES + F.wave, NGW = F.G * NWAVES; const float* ada = (const float*)(ws + WS_ADA); unsigned char* H = ws + WS_H;
    LAS f32x4* L = (LAS f32x4*)(F.lds + RING_OFF);
    for (int i = F.tid; i < 2048; i += 512) { const int b = i >> 10, q = i & 1023;
        const f32x4 g4 = *(const f32x4*)(g + 4 * q), s4 = *(const f32x4*)(ada + b * NADA + DM + 4 * q), h4 = *(const f32x4*)(ada + b * NADA + 4 * q);
        L[b * 2048 + q] = g4 * (s4 + 1.0f) * H_SCALE; L[b * 2048 + 1024 + q] = h4 * H_SCALE; }
    __syncthreads();
    for (int m = gw; m < M; m += NGW) { const int b = m >> 13;
        int lane = F.lane; asm volatile("" : "+v"(lane));
        const GAS f32x4* xr = (const GAS f32x4*)(x + (size_t)m * DM) + lane; f32x4 v[16]; float s = 0.f;
#pragma unroll
        for (int j = 0; j < 16; ++j) v[j] = xr[64 * j];
        __builtin_amdgcn_sched_barrier(0);
#pragma unroll
        for (int j = 0; j < 16; ++j) s += (v[j].x * v[j].x + v[j].y * v[j].y) + (v[j].z * v[j].z + v[j].w * v[j].w);
        const float rstd = 1.0f / sqrtf(wave_sum(s) * (1.f / DM) + NORM_EPS);
        const LAS f32x4* Lb = L + b * 2048 + lane;
        GAS unsigned* o4 = (GAS unsigned*)(H + (size_t)m * DM) + lane;
#pragma unroll
        for (int j = 0; j < 16; ++j) {
            const f32x4 o = v[j] * rstd * Lb[64 * j] + Lb[1024 + 64 * j];
            int t = __builtin_amdgcn_cvt_pk_fp8_f32(o.x, o.y, 0, false); t = __builtin_amdgcn_cvt_pk_fp8_f32(o.z, o.w, t, true); o4[64 * j] = (unsigned)t; }
    }
    __syncthreads();
}
__device__ __forceinline__ void p4_latent(Frame& F, const float* g_q, const float* g_kv, unsigned char* ws) {
    const int gw = F.vcu * NWAVES + F.wave, NGW = F.G * NWAVES;
    const bf16* ZQ = (const bf16*)(ws + WS_ZQ); const bf16* ZKV = (const bf16*)(ws + WS_ZKV);
    bf16* ZQN = (bf16*)(ws + WS_ZQN); bf16* CKV = (bf16*)(ws + WS_CKV); bf16* KPE = (bf16*)(ws + WS_KPE);
    const float* rc = (const float*)(ws + WS_ROPE); const float* rs = rc + SEQ * 32;
    for (int m = gw; m < M; m += NGW) {
        { v4u a[2]; float f[16]; float s = 0.f;
#pragma unroll
          for (int j = 0; j < 2; ++j) { a[j] = *(const GAS v4u*)(ZQ + (size_t)m * 1024 + 512 * j + 8 * F.lane);
              f[8 * j + 0] = bflo(a[j].x); f[8 * j + 1] = bfhi(a[j].x); f[8 * j + 2] = bflo(a[j].y); f[8 * j + 3] = bfhi(a[j].y);
              f[8 * j + 4] = bflo(a[j].z); f[8 * j + 5] = bfhi(a[j].z); f[8 * j + 6] = bflo(a[j].w); f[8 * j + 7] = bfhi(a[j].w); }
#pragma unroll
          for (int e = 0; e < 16; ++e) s += f[e] * f[e];
          const float rstd = 1.0f / sqrtf(wave_sum(s) * (1.f / 1024.f) + NORM_EPS);
#pragma unroll
          for (int j = 0; j < 2; ++j) { const int col = 512 * j + 8 * F.lane; const f32x4 g0 = *(const f32x4*)(g_q + col), g1 = *(const f32x4*)(g_q + col + 4);
              const float o0 = f[8 * j + 0] * rstd * g0.x, o1 = f[8 * j + 1] * rstd * g0.y, o2 = f[8 * j + 2] * rstd * g0.z, o3 = f[8 * j + 3] * rstd * g0.w,
                          o4 = f[8 * j + 4] * rstd * g1.x, o5 = f[8 * j + 5] * rstd * g1.y, o6 = f[8 * j + 6] * rstd * g1.z, o7 = f[8 * j + 7] * rstd * g1.w;
              if (P5_FP8) { int t0 = __builtin_amdgcn_cvt_pk_fp8_f32(o0 * LAT_SCALE, o1 * LAT_SCALE, 0, false); t0 = __builtin_amdgcn_cvt_pk_fp8_f32(o2 * LAT_SCALE, o3 * LAT_SCALE, t0, true);
                  int t1 = __builtin_amdgcn_cvt_pk_fp8_f32(o4 * LAT_SCALE, o5 * LAT_SCALE, 0, false); t1 = __builtin_amdgcn_cvt_pk_fp8_f32(o6 * LAT_SCALE, o7 * LAT_SCALE, t1, true);
                  *(GAS unsigned long long*)((unsigned char*)ZQN + (size_t)m * 1024 + col) = (unsigned long long)(unsigned)t0 | ((unsigned long long)(unsigned)t1 << 32); }
              else { v4u o; o.x = cvtpk(o0, o1); o.y = cvtpk(o2, o3); o.z = cvtpk(o4, o5); o.w = cvtpk(o6, o7); *(GAS v4u*)(ZQN + (size_t)m * 1024 + col) = o; } } }
        { const v4u a = *(const GAS v4u*)(ZKV + (size_t)m * 768 + 8 * F.lane); float f[8];
          f[0] = bflo(a.x); f[1] = bfhi(a.x); f[2] = bflo(a.y); f[3] = bfhi(a.y); f[4] = bflo(a.z); f[5] = bfhi(a.z); f[6] = bflo(a.w); f[7] = bfhi(a.w);
          float s = 0.f;
#pragma unroll
          for (int e = 0; e < 8; ++e) s += f[e] * f[e];
          const float rstd = 1.0f / sqrtf(wave_sum(s) * (1.f / 512.f) + NORM_EPS);
          const int col = 8 * F.lane; const f32x4 g0 = *(const f32x4*)(g_kv + col), g1 = *(const f32x4*)(g_kv + col + 4);
          const float o0 = f[0] * rstd * g0.x, o1 = f[1] * rstd * g0.y, o2 = f[2] * rstd * g0.z, o3 = f[3] * rstd * g0.w, o4 = f[4] * rstd * g1.x, o5 = f[5] * rstd * g1.y, o6 = f[6] * rstd * g1.z, o7 = f[7] * rstd * g1.w;
          if (P5_FP8) { int t0 = __builtin_amdgcn_cvt_pk_fp8_f32(o0 * LAT_SCALE, o1 * LAT_SCALE, 0, false); t0 = __builtin_amdgcn_cvt_pk_fp8_f32(o2 * LAT_SCALE, o3 * LAT_SCALE, t0, true);
              int t1 = __builtin_amdgcn_cvt_pk_fp8_f32(o4 * LAT_SCALE, o5 * LAT_SCALE, 0, false); t1 = __builtin_amdgcn_cvt_pk_fp8_f32(o6 * LAT_SCALE, o7 * LAT_SCALE, t1, true);
              *(GAS unsigned long long*)((unsigned char*)CKV + (size_t)m * 512 + col) = (unsigned long long)(unsigned)t0 | ((unsigned long long)(unsigned)t1 << 32); }
          else { v4u o; o.x = cvtpk(o0, o1); o.y = cvtpk(o2, o3); o.z = cvtpk(o4, o5); o.w = cvtpk(o6, o7); *(GAS v4u*)(CKV + (size_t)m * 512 + col) = o; } }
        if (F.lane < 32) { const int pos = m & (SEQ - 1);
          const float x1 = __uint_as_float((unsigned)ZKV[(size_t)m * 768 + 512 + F.lane] << 16), x2 = __uint_as_float((unsigned)ZKV[(size_t)m * 768 + 544 + F.lane] << 16);
          const float cc = rc[pos * 32 + F.lane], ss = rs[pos * 32 + F.lane];
          if (MLA_FP8QK) { const int t8 = __builtin_amdgcn_cvt_pk_fp8_f32((x1 * cc - x2 * ss) * QK8_SCALE, (x2 * cc + x1 * ss) * QK8_SCALE, 0, false);
              *(GAS unsigned short*)((unsigned char*)KPE + (size_t)m * 64 + 2 * F.lane) = (unsigned short)t8; }
          else *(GAS unsigned*)(KPE + (size_t)m * 64 + 2 * F.lane) = cvtpk(x1 * cc - x2 * ss, x2 * cc + x1 * ss); }
    }
}
__device__ __forceinline__ void p9_post_attn(Frame& F, const float* x, const float* g_post, const float* g_ffn_pre, float* out, unsigned char* ws) {
    const int gw = F.vcu * NWAVES + F.wave, NGW = F.G * NWAVES; const float* ada = (const float*)(ws + WS_ADA);
    const bf16* T = (const bf16*)(ws + WS_T); const float* rsq = (const float*)(ws + WS_RSQ); bf16* H2 = (bf16*)(ws + WS_H);
    LAS f32x4* L = (LAS f32x4*)(F.lds + RING_OFF);
    for (int i = F.tid; i < 2048; i += 512) { const int b = i >> 10, q = i & 1023, slot = ((q >> 7) * 2 + (q & 1)) * 64 + ((q >> 1) & 63);
        const f32x4 gp = *(const f32x4*)(g_post + 4 * q), ga = *(const f32x4*)(ada + b * NADA + 2 * DM + 4 * q), gf = *(const f32x4*)(g_ffn_pre + 4 * q),
                    sc = *(const f32x4*)(ada + b * NADA + 4 * DM + 4 * q), sh = *(const f32x4*)(ada + b * NADA + 3 * DM + 4 * q);
        L[b * 3072 + slot] = ga * gp; L[b * 3072 + 1024 + slot] = gf * (sc + 1.0f); L[b * 3072 + 2048 + slot] = sh; }
    __syncthreads();
    for (int m = gw; m < M; m += NGW) { const int b = m >> 13;
        int lane = F.lane; asm volatile("" : "+v"(lane));
        const float rq = rsq[(size_t)m * 64 + lane];
        const GAS v4u* Tr = (const GAS v4u*)(T + (size_t)m * DM) + lane; const GAS f32x4* xr = (const GAS f32x4*)(x + (size_t)m * DM) + 2 * lane;
        v4u t[8]; f32x4 xa[16];
#pragma unroll
        for (int j = 0; j < 8; ++j) t[j] = Tr[64 * j];
#pragma unroll
        for (int j = 0; j < 8; ++j) { xa[2 * j] = xr[128 * j]; xa[2 * j + 1] = xr[128 * j + 1]; }
        __builtin_amdgcn_sched_barrier(0);
        const float rstd = 1.0f / sqrtf(wave_sum(rq) * (1.f / DM) + NORM_EPS);
        const LAS f32x4* Lb = L + b * 3072 + lane; float s2 = 0.f;
#pragma unroll
        for (int j = 0; j < 8; ++j) { const f32x4 a0 = Lb[128 * j], a1 = Lb[128 * j + 64];
            f32x4 u0, u1; u0.x = bflo(t[j].x); u0.y = bfhi(t[j].x); u0.z = bflo(t[j].y); u0.w = bfhi(t[j].y); u1.x = bflo(t[j].z); u1.y = bfhi(t[j].z); u1.z = bflo(t[j].w); u1.w = bfhi(t[j].w);
            xa[2 * j] = xa[2 * j] + a0 * (u0 * rstd); xa[2 * j + 1] = xa[2 * j + 1] + a1 * (u1 * rstd);
            const f32x4 p = xa[2 * j] * xa[2 * j] + xa[2 * j + 1] * xa[2 * j + 1]; s2 += (p.x + p.y) + (p.z + p.w); }
        const float rstd2 = 1.0f / sqrtf(wave_sum(s2) * (1.f / DM) + NORM_EPS);
        GAS v4u* Hr = (GAS v4u*)(H2 + (size_t)m * DM) + lane;
#pragma unroll
        for (int j = 0; j < 8; ++j) {
            const f32x4 o0 = xa[2 * j] * rstd2 * Lb[1024 + 128 * j] + Lb[2048 + 128 * j], o1 = xa[2 * j + 1] * rstd2 * Lb[1024 + 128 * j + 64] + Lb[2048 + 128 * j + 64];
            v4u w; w.x = cvtpk(o0.x, o0.y); w.y = cvtpk(o0.z, o0.w); w.z = cvtpk(o1.x, o1.y); w.w = cvtpk(o1.z, o1.w); Hr[64 * j] = w; }
    }
    __syncthreads();
}

namespace mla {
typedef short bf16x8 __attribute__((ext_vector_type(8)));
typedef short s16x4 __attribute__((ext_vector_type(4)));
typedef float f32x16 __attribute__((ext_vector_type(16)));
typedef unsigned u32x4 __attribute__((ext_vector_type(4)));
typedef unsigned short bf16;
#ifndef MLA_STAGGER
#define MLA_STAGGER 0
#endif
#ifndef MLA_DMAPOS
#define MLA_DMAPOS 1
#endif
#ifndef MLA_ROPE4
#define MLA_ROPE4 1
#endif
#ifndef MLA_QP_LDS
#define MLA_QP_LDS 0
#endif
constexpr int NW = 8, QBLK = 32, KVBLK = 64, QB = NW * QBLK;
constexpr int PQN = 4096, PQP = 2048, PKN = 4096, PKP = 64, PVV = 4096, PO = 4096;
#if MLA_FP8QK
constexpr int SLOT_K = 8192, SLOT_V = MLA_FP8PV ? 8192 : 16384, SLOT_P = 4096;
#else
constexpr int SLOT_K = 16384, SLOT_V = 16384, SLOT_P = 8192;
#endif
typedef int v8i __attribute__((ext_vector_type(8)));
constexpr int OFF_K = 0, OFF_V = 3 * SLOT_K, OFF_KP = OFF_V + 3 * SLOT_V, OFF_QP = OFF_KP + 3 * SLOT_P, OFF_WS = OFF_QP + (MLA_QP_LDS ? NW * 4096 : 0), LDS_BYTES = OFF_WS + NW * 64 * 4;
constexpr float SCALE = MLA_FP8QK ? 0.07216878364870322f / (QK8_SCALE * QK8_SCALE) : 0.07216878364870322f;
constexpr float THR = MLA_FP8PV ? 0.5f : 8.f;
#define SBAR() __builtin_amdgcn_sched_barrier(0)
__device__ __forceinline__ int crow(int r, int hi) { return (r & 3) + 8 * (r >> 2) + 4 * hi; }
__device__ __forceinline__ unsigned cvtpk(float lo, float hi) { unsigned r; asm volatile("v_cvt_pk_bf16_f32 %0, %1, %2" : "=v"(r) : "v"(lo), "v"(hi)); return r; }
__device__ __forceinline__ bf16x8 load8(const bf16* p) { return *reinterpret_cast<const bf16x8*>(p); }
__device__ __forceinline__ void mask_tile(f32x16& p0, f32x16& p1, int dq) {
    const float NEG = -__builtin_inff();
#pragma unroll
    for (int r = 0; r < 16; ++r) { const int c = (r & 3) + 8 * (r >> 2);
        if (dq - c < 0) p0[r] = NEG;
        if (dq - c - 32 < 0) p1[r] = NEG; }
}
__device__ __forceinline__ void partialSM(f32x16& p0, f32x16& p1, float& m_reg, float& mn, float& alpha) {
    float pmax = p0[0];
#pragma unroll
    for (int r = 1; r < 16; ++r) pmax = fmaxf(pmax, p0[r]);
#pragma unroll
    for (int r = 0; r < 16; ++r) pmax = fmaxf(pmax, p1[r]);
    { auto rr = __builtin_amdgcn_permlane32_swap(__float_as_uint(pmax), __float_as_uint(pmax), false, false);
      pmax = fmaxf(__uint_as_float(rr[0]), __uint_as_float(rr[1])); }
    constexpr float C2 = 1.4426950408889634f * SCALE;
    { const bool keep = __all((pmax - m_reg) * SCALE <= THR);
      const float mx = fmaxf(m_reg, pmax); mn = keep ? m_reg : mx; alpha = __builtin_amdgcn_exp2f((m_reg - mn) * C2); m_reg = mn; }
    const float mnL = -mn * C2 + (MLA_FP8PV ? 8.0f : 0.0f);
#pragma unroll
    for (int r = 0; r < 16; ++r) p0[r] = fmaf(p0[r], C2, mnL);
#pragma unroll
    for (int r = 0; r < 16; ++r) p1[r] = fmaf(p1[r], C2, mnL);
#pragma unroll
    for (int r = 0; r < 16; ++r) p0[r] = __builtin_amdgcn_exp2f(p0[r]);
}
#define MLA_PK4(P, B_, OUT) do { unsigned a0 = cvtpk(P[B_+0], P[B_+1]), a1 = cvtpk(P[B_+2], P[B_+3]);                          \
        unsigned b0 = cvtpk(P[B_+4], P[B_+5]), b1 = cvtpk(P[B_+6], P[B_+7]);                                             \
        auto r0 = __builtin_amdgcn_permlane32_swap(a0, b0, false, false); auto r1 = __builtin_amdgcn_permlane32_swap(a1, b1, false, false); \
        u32x4 w = {r0[0], r1[0], r0[1], r1[1]}; OUT = *reinterpret_cast<bf16x8*>(&w); } while (0)
__device__ __forceinline__ void finishSM(f32x16& p0, f32x16& p1, float alpha, float& l_reg, bf16x8& pa0, bf16x8& pa1, bf16x8& pa2, bf16x8& pa3) {
#pragma unroll
    for (int r = 0; r < 16; ++r) p1[r] = __builtin_amdgcn_exp2f(p1[r]);
    float ps = 0;
#pragma unroll
    for (int r = 0; r < 16; ++r) ps += p0[r];
#pragma unroll
    for (int r = 0; r < 16; ++r) ps += p1[r];
    { auto rr = __builtin_amdgcn_permlane32_swap(__float_as_uint(ps), __float_as_uint(ps), false, false);
      ps = __uint_as_float(rr[0]) + __uint_as_float(rr[1]); }
    l_reg = l_reg * alpha + ps;
    MLA_PK4(p0, 0, pa0); MLA_PK4(p0, 8, pa1); MLA_PK4(p1, 0, pa2); MLA_PK4(p1, 8, pa3);
}
__device__ __forceinline__ void finishSM8(f32x16& p0, f32x16& p1, v8i& pf) {
#pragma unroll
    for (int r = 0; r < 16; ++r) p1[r] = __builtin_amdgcn_exp2f(p1[r]);
    int f[8];
#pragma unroll
    for (int m = 0; m < 4; ++m) {
        int a = __builtin_amdgcn_cvt_pk_fp8_f32(p0[4 * m], p0[4 * m + 1], 0, false); a = __builtin_amdgcn_cvt_pk_fp8_f32(p0[4 * m + 2], p0[4 * m + 3], a, true);
        int b = __builtin_amdgcn_cvt_pk_fp8_f32(p1[4 * m], p1[4 * m + 1], 0, false); b = __builtin_amdgcn_cvt_pk_fp8_f32(p1[4 * m + 2], p1[4 * m + 3], b, true);
        auto r = __builtin_amdgcn_permlane32_swap((unsigned)a, (unsigned)b, false, false);
        f[2 * m] = (int)r[0]; f[2 * m + 1] = (int)r[1]; }
    pf = (v8i){f[0], f[1], f[2], f[3], f[4], f[5], f[6], f[7]};
}
#define MLA_GLDS(gp, ldsoff) __builtin_amdgcn_global_load_lds((const unsigned*)(gp), (__attribute__((address_space(3))) unsigned*)(lds3 + (ldsoff)), 16, 0, 0)
#if MLA_FP8PV
#ifndef MLA_PRIO
#define MLA_PRIO 0
#endif
#ifndef MLA_ILV_ON
#define MLA_ILV_ON 1
#endif
#define MLA_ILV() do { if (!MLA_ILV_ON) break; __builtin_amdgcn_sched_group_barrier(0x100, 8, 0); \
        _Pragma("unroll") for (int g_ = 0; g_ < 5; ++g_) { __builtin_amdgcn_sched_group_barrier(0x008, 1, 0); __builtin_amdgcn_sched_group_barrier(0x002, 14, 0); __builtin_amdgcn_sched_group_barrier(0x400, 4, 0); } } while (0)
#else
#define MLA_ILV() do { } while (0)
#endif
#define MLA_WAITBAR(N) asm volatile("s_waitcnt vmcnt(" #N ") lgkmcnt(0)\n\ts_barrier" ::: "memory")
#define MLA_WAITBAR_KV() do { if (MLA_FP8QK && MLA_FP8PV) { if (MLA_ROPE4 && wid >= 4) MLA_WAITBAR(2); else MLA_WAITBAR(3); } else if (MLA_FP8QK) MLA_WAITBAR(4); else MLA_WAITBAR(5); } while (0)
#define MLA_WAITBAR_V() do { if (MLA_FP8PV) MLA_WAITBAR(1); else MLA_WAITBAR(2); } while (0)
__device__ __forceinline__ void mla_block(const unsigned char* wsb, int b, int h, int qb, char* lds) {
    typedef __attribute__((address_space(3))) unsigned char* lds3_t;
    const lds3_t lds3 = (lds3_t)lds;
    const int tid = threadIdx.x, wid = __builtin_amdgcn_readfirstlane(tid >> 6), lane = tid & 63, r32 = lane & 31, hi = lane >> 5;
    const int P0 = qb * QB; const int NT = (P0 + QB) / KVBLK;
    const int qlo = P0 + wid * QBLK, qm = qlo + r32 - 4 * hi;
    float* ws = (float*)(lds + OFF_WS) + wid * 64; float* li_l = ws, * al_l = ws + 32;
    unsigned offK, offV, offP;
#if MLA_FP8QK
    { const int row = 8 * wid + (lane >> 3), sl = lane & 7, ch = sl ^ (((row >> 1) & 3) << 1) ^ ((row >> 3) & 1); offK = (unsigned)(row * 4096 + ch * 16); }
#else
    { const int row = 4 * wid + (lane >> 4), sl = lane & 15, ch = sl ^ (row & 7); offK = (unsigned)(row * PKN + ch * 8); }
#endif
#if MLA_FP8PV
    { const int row = 16 * wid + (lane >> 2), sl = lane & 3, ch = sl ^ (((row >> 2) & 1) << 1) ^ ((row >> 3) & 1); offV = (unsigned)(row * 16384 + ch * 16); }
#else
    { const int st = 2 * wid + (lane >> 5), kg = st >> 2, cblk = st & 3, kk = kg * 8 + ((lane & 31) >> 2), k = (kk & ~0xC) | ((kk & 4) << 1) | ((kk & 8) >> 1), c = cblk * 32 + (lane & 3) * 8;
      offV = (unsigned)(k * PVV + c); }
#endif
#if MLA_FP8QK
    { const int row = 16 * (wid & 3) + (lane >> 2), sl = lane & 3, ch = sl ^ (((row >> 2) & 1) << 1) ^ ((row >> 3) & 1); offP = (unsigned)(row * 64 + ch * 16); }
#else
    { const int row = 8 * wid + (lane >> 3), sl = lane & 7, ch = sl ^ ((row >> 1) & 7); offP = (unsigned)(row * PKP + ch * 8); }
#endif
    #if MLA_FP8QK
    const unsigned char* kn = wsb + WS_KN + (size_t)b * 8192 * 4096 + h * 128; const unsigned char* kp = wsb + WS_KPE + (size_t)b * 8192 * 64;
#else
    const bf16* kn = (const bf16*)(wsb + WS_KN) + (size_t)b * 8192 * PKN + h * 128; const bf16* kp = (const bf16*)(wsb + WS_KPE) + (size_t)b * 8192 * PKP;
#endif
    #if MLA_FP8PV
    const unsigned char* vv = wsb + WS_VM + (size_t)h * 128 * 16384 + (size_t)b * 8192;
#else
    const bf16* vv = (const bf16*)(wsb + WS_VM) + (size_t)b * 8192 * PVV + h * 128;
#endif
    const size_t row0 = (size_t)b * 8192 + (size_t)P0 + wid * QBLK;
#if MLA_FP8QK
#define DMA_K(t, slot) do { const unsigned char* b_ = (const unsigned char*)kn + (size_t)(t) * (KVBLK * 4096); unsigned ok_ = offK, op_ = offP; asm volatile("" : "+v"(ok_), "+v"(op_));   \
        MLA_GLDS(b_ + ok_, __builtin_amdgcn_readfirstlane(OFF_K + (slot) * SLOT_K + wid * 1024));                                                              \
        if (!MLA_ROPE4 || wid < 4) { const unsigned char* bp_ = (const unsigned char*)kp + (size_t)(t) * (KVBLK * 64); MLA_GLDS(bp_ + op_, __builtin_amdgcn_readfirstlane(OFF_KP + (slot) * SLOT_P + (wid & 3) * 1024)); } } while (0)
#define MLA_NK 2
#else
#define DMA_K(t, slot) do { const bf16* b_ = kn + (size_t)(t) * (KVBLK * PKN); const int d_ = __builtin_amdgcn_readfirstlane(OFF_K + (slot) * SLOT_K + wid * 1024);   \
        unsigned ok_ = offK, op_ = offP; asm volatile("" : "+v"(ok_), "+v"(op_));   \
        MLA_GLDS(b_ + ok_, d_); MLA_GLDS(b_ + 32 * PKN + ok_, d_ + 8192);                                                                                      \
        const bf16* bp_ = kp + (size_t)(t) * (KVBLK * PKP); MLA_GLDS(bp_ + op_, __builtin_amdgcn_readfirstlane(OFF_KP + (slot) * SLOT_P + wid * 1024)); } while (0)
#define MLA_NK 3
#endif
#if MLA_FP8PV
#define DMA_V(t, slot) do { const unsigned char* b_ = vv + (size_t)(t) * KVBLK; unsigned ov_ = offV; asm volatile("" : "+v"(ov_));   \
        MLA_GLDS(b_ + ov_, __builtin_amdgcn_readfirstlane(OFF_V + (slot) * SLOT_V + wid * 1024)); } while (0)
#define MLA_NV 1
#else
#define DMA_V(t, slot) do { const bf16* b_ = vv + (size_t)(t) * (KVBLK * PVV); const int d_ = __builtin_amdgcn_readfirstlane(OFF_V + (slot) * SLOT_V + wid * 1024);   \
        unsigned ov_ = offV; asm volatile("" : "+v"(ov_));   \
        MLA_GLDS(b_ + ov_, d_); MLA_GLDS(b_ + 32 * PVV + ov_, d_ + 8192); } while (0)
#define MLA_NV 2
#endif
#if MLA_FP8QK
    int kbo8[2];
#pragma unroll
    for (int e = 0; e < 2; ++e) kbo8[e] = OFF_K + r32 * 128 + (((4 * e + 2 * hi) ^ (((r32 >> 1) & 3) << 1) ^ ((r32 >> 3) & 1)) << 4);
    const int kpo8 = OFF_KP + r32 * 64 + (((2 * hi) ^ (((r32 >> 2) & 1) << 1) ^ ((r32 >> 3) & 1)) << 4);
#else
    int kbo[4];
#pragma unroll
    for (int dd = 0; dd < 4; ++dd) kbo[dd] = OFF_K + r32 * 256 + (((dd * 16 + hi * 8) * 2) ^ ((r32 & 7) << 4));
    int kpo[4];
#pragma unroll
    for (int e = 0; e < 4; ++e) kpo[e] = OFF_KP + r32 * 128 + (((2 * e + hi) ^ ((r32 >> 1) & 7)) << 4);
#endif
    [[maybe_unused]] const int vb0 = (int)(uintptr_t)lds + OFF_V + (((lane & 3) << 3) | (((lane >> 2) & 3) << 6) | (((lane >> 4) & 1) << 5) | (((lane >> 5) & 1) << 8));
    DMA_K(0, 0); DMA_V(0, 0); DMA_K(1, 1);
#if MLA_FP8QK
    v8i q8[3];
    { unsigned qon = (unsigned)(r32 * 4096 + hi * 32), qop = (unsigned)(r32 * 2048 + hi * 32); asm volatile("" : "+v"(qon), "+v"(qop));
      const unsigned char* qn_ = wsb + WS_QN + row0 * 4096 + h * 128; const unsigned char* qp_ = wsb + WS_QP + row0 * 2048 + h * 64;
#pragma unroll
      for (int e = 0; e < 2; ++e) { const u32x4 lo_ = *(const u32x4*)(qn_ + 64 * e + qon), hi_ = *(const u32x4*)(qn_ + 64 * e + 16 + qon);
          q8[e] = (v8i){(int)lo_.x, (int)lo_.y, (int)lo_.z, (int)lo_.w, (int)hi_.x, (int)hi_.y, (int)hi_.z, (int)hi_.w}; }
      { const u32x4 lo_ = *(const u32x4*)(qp_ + qop), hi_ = *(const u32x4*)(qp_ + 16 + qop);
          q8[2] = (v8i){(int)lo_.x, (int)lo_.y, (int)lo_.z, (int)lo_.w, (int)hi_.x, (int)hi_.y, (int)hi_.z, (int)hi_.w}; } }
#define QPF(e) 0
#else
    bf16x8 qr[8];
    unsigned qon = (unsigned)(r32 * PQN + hi * 8), qop = (unsigned)(r32 * PQP + hi * 8); asm volatile("" : "+v"(qon), "+v"(qop));
#pragma unroll
    for (int d0 = 0; d0 < 8; ++d0) qr[d0] = load8((const bf16*)(wsb + WS_QN) + row0 * PQN + h * 128 + d0 * 16 + qon);
#if MLA_QP_LDS
    { char* qpl = lds + OFF_QP + wid * 4096 + lane * 16;
#pragma unroll
      for (int e = 0; e < 4; ++e) *(bf16x8*)(qpl + e * 1024) = load8((const bf16*)(wsb + WS_QP) + row0 * PQP + h * 64 + e * 16 + qop); }
    const char* qpl_r = lds + OFF_QP + wid * 4096 + lane * 16;
#define QPF(e) (*(const bf16x8*)(qpl_r + (e) * 1024))
#else
    bf16x8 qp[4];
#pragma unroll
    for (int e = 0; e < 4; ++e) qp[e] = load8((const bf16*)(wsb + WS_QP) + row0 * PQP + h * 64 + e * 16 + qop);
#define QPF(e) qp[e]
#endif
#endif
#if MLA_FP8PV
    float m_reg = -1e30f; f32x16 o[5] = {};
    v8i ones8 = {0x38383838, 0x38383838, 0x38383838, 0x38383838, 0x38383838, 0x38383838, 0x38383838, 0x38383838}; asm volatile("" : "+v"(ones8));
#else
    float m_reg = -1e30f, l_reg = 0; f32x16 o[4] = {};
#endif
#if MLA_FP8QK
#define K8F(b_, o_) ({ const u32x4 lo_ = *reinterpret_cast<const u32x4*>((b_) + (o_)), hi_ = *reinterpret_cast<const u32x4*>((b_) + ((o_) ^ 16)); (v8i){(int)lo_.x, (int)lo_.y, (int)lo_.z, (int)lo_.w, (int)hi_.x, (int)hi_.y, (int)hi_.z, (int)hi_.w}; })
#define QKT(P0_, P1_, slot) do { P0_ = f32x16{}; P1_ = f32x16{}; const char* kb_ = lds + (slot) * SLOT_K; const char* kq_ = lds + (slot) * SLOT_P;   \
        _Pragma("unroll") for (int e = 0; e < 2; ++e) { const v8i b0 = K8F(kb_, kbo8[e]); const v8i b1 = K8F(kb_ + 32 * 128, kbo8[e]);       \
            P0_ = __builtin_amdgcn_mfma_scale_f32_32x32x64_f8f6f4(b0, q8[e], P0_, 0, 0, 0, 0, 0, 0); P1_ = __builtin_amdgcn_mfma_scale_f32_32x32x64_f8f6f4(b1, q8[e], P1_, 0, 0, 0, 0, 0, 0); }  \
        { const v8i b0 = K8F(kq_, kpo8); const v8i b1 = K8F(kq_ + 32 * 64, kpo8);                                                         \
            P0_ = __builtin_amdgcn_mfma_scale_f32_32x32x64_f8f6f4(b0, q8[2], P0_, 0, 0, 0, 0, 0, 0); P1_ = __builtin_amdgcn_mfma_scale_f32_32x32x64_f8f6f4(b1, q8[2], P1_, 0, 0, 0, 0, 0, 0); } } while (0)
#else
#define QKT(P0_, P1_, slot) do { P0_ = f32x16{}; P1_ = f32x16{}; const char* kb_ = lds + (slot) * SLOT_K; const char* kq_ = lds + (slot) * SLOT_P;   \
        _Pragma("unroll") for (int d0 = 0; d0 < 8; ++d0) { const char* a_ = kb_ + kbo[d0 & 3] + (d0 >> 2) * 128;                                         \
            const bf16x8 b0 = *reinterpret_cast<const bf16x8*>(a_); const bf16x8 b1 = *reinterpret_cast<const bf16x8*>(a_ + 32 * 256);                    \
            P0_ = __builtin_amdgcn_mfma_f32_32x32x16_bf16(b0, qr[d0], P0_, 0, 0, 0); P1_ = __builtin_amdgcn_mfma_f32_32x32x16_bf16(b1, qr[d0], P1_, 0, 0, 0); }  \
        _Pragma("unroll") for (int e = 0; e < 4; ++e) { const char* a_ = kq_ + kpo[e];                                                                  \
            const bf16x8 b0 = *reinterpret_cast<const bf16x8*>(a_); const bf16x8 b1 = *reinterpret_cast<const bf16x8*>(a_ + 32 * 128); const bf16x8 q_ = QPF(e);   \
            P0_ = __builtin_amdgcn_mfma_f32_32x32x16_bf16(b0, q_, P0_, 0, 0, 0); P1_ = __builtin_amdgcn_mfma_f32_32x32x16_bf16(b1, q_, P1_, 0, 0, 0); } } while (0)
#endif
#if MLA_FP8PV
    const int vbo8 = OFF_V + r32 * 64 + (((2 * hi) ^ (((r32 >> 2) & 1) << 1) ^ ((r32 >> 3) & 1)) << 4);
#define PV(slot) do { const char* vb_ = lds + (slot) * SLOT_V; const int vh_ = vbo8 ^ 16; if (MLA_PRIO) __builtin_amdgcn_s_setprio(1);                                                  \
        _Pragma("unroll") for (int blk = 0; blk < 4; ++blk) { const u32x4 lo_ = *reinterpret_cast<const u32x4*>(vb_ + vbo8 + blk * 2048), hi_ = *reinterpret_cast<const u32x4*>(vb_ + vh_ + blk * 2048); \
            o[blk] = __builtin_amdgcn_mfma_scale_f32_32x32x64_f8f6f4(pf8, (v8i){(int)lo_.x, (int)lo_.y, (int)lo_.z, (int)lo_.w, (int)hi_.x, (int)hi_.y, (int)hi_.z, (int)hi_.w}, o[blk], 0, 0, 0, 0, 0, 0); } \
        o[4] = __builtin_amdgcn_mfma_scale_f32_32x32x64_f8f6f4(pf8, ones8, o[4], 0, 0, 0, 0, 0, 0); if (MLA_PRIO) __builtin_amdgcn_s_setprio(0); } while (0)
#define FINISH(P0_, P1_, al_) finishSM8(P0_, P1_, pf8)
#else
#define TRRD(dst, off) asm volatile("ds_read_b64_tr_b16 %0, %1 offset:%2" : "=&v"(dst) : "v"(vbs_), "i"(off) : "memory")
#define PV_D0(d0) do { s16x4 l0, l1, l2, l3, h0, h1, h2, h3; constexpr int b_ = (d0) * 512;   \
        TRRD(l0, b_); TRRD(h0, b_ + 2048); TRRD(l1, b_ + 4096); TRRD(h1, b_ + 6144); TRRD(l2, b_ + 8192); TRRD(h2, b_ + 10240); TRRD(l3, b_ + 12288); TRRD(h3, b_ + 14336); \
        asm volatile("s_waitcnt lgkmcnt(0)" ::: "memory"); SBAR();   \
        o[d0] = __builtin_amdgcn_mfma_f32_32x32x16_bf16(pa0, (bf16x8){l0[0], l0[1], l0[2], l0[3], h0[0], h0[1], h0[2], h0[3]}, o[d0], 0, 0, 0);   \
        o[d0] = __builtin_amdgcn_mfma_f32_32x32x16_bf16(pa1, (bf16x8){l1[0], l1[1], l1[2], l1[3], h1[0], h1[1], h1[2], h1[3]}, o[d0], 0, 0, 0);   \
        o[d0] = __builtin_amdgcn_mfma_f32_32x32x16_bf16(pa2, (bf16x8){l2[0], l2[1], l2[2], l2[3], h2[0], h2[1], h2[2], h2[3]}, o[d0], 0, 0, 0);   \
        o[d0] = __builtin_amdgcn_mfma_f32_32x32x16_bf16(pa3, (bf16x8){l3[0], l3[1], l3[2], l3[3], h3[0], h3[1], h3[2], h3[3]}, o[d0], 0, 0, 0); } while (0)
#define PV(slot) do { const int vbs_ = vb0 + (slot) * SLOT_V; PV_D0(0); PV_D0(1); PV_D0(2); PV_D0(3); } while (0)
#define FINISH(P0_, P1_, al_) finishSM(P0_, P1_, al_, l_reg, pa0, pa1, pa2, pa3)
#endif
#define RESC(a) do { if (__any((a) < 1.f)) { if (hi == 0) al_l[r32] = (a); asm volatile("s_waitcnt lgkmcnt(0)" ::: "memory");              \
                     _Pragma("unroll") for (int d_ = 0; d_ < (MLA_FP8PV ? 5 : 4); ++d_) _Pragma("unroll") for (int r = 0; r < 16; ++r) o[d_][r] *= al_l[crow(r, hi)]; } } while (0)
#define MASKT(P0_, P1_, t) do { const int kb_ = (t) * KVBLK; if (kb_ + KVBLK - 1 > qlo) mask_tile(P0_, P1_, qm - kb_); } while (0)
    f32x16 pA0, pA1, pB0, pB1; float mnA, mnB, alA, alB; [[maybe_unused]] bf16x8 pa0, pa1, pa2, pa3; [[maybe_unused]] v8i pf8;
    MLA_WAITBAR(0);
    DMA_K(2, 2); DMA_V(1, 1);
    const bool late = MLA_STAGGER == 2 || (MLA_STAGGER == 1 && wid >= 4);
    SBAR(); QKT(pA0, pA1, 0); if (!late) { MASKT(pA0, pA1, 0); partialSM(pA0, pA1, m_reg, mnA, alA); }
    MLA_WAITBAR_KV();
    int s0 = 0, s1 = 1, s2 = 2;
#define HALF_STEP(PX0, PX1, mnX, alX, PY0, PY1, mnY, alY, t) do {                                                                 \
        if (MLA_DMAPOS == 0) { if ((t) + 2 < NT) DMA_K((t) + 2, s0); if ((t) + 1 < NT) DMA_V((t) + 1, s2); }                     \
        if (late) { MASKT(PY0, PY1, (t) - 1); partialSM(PY0, PY1, m_reg, mnY, alY); RESC(alY); }                              \
        SBAR(); QKT(PX0, PX1, s1);                                                                                           \
        FINISH(PY0, PY1, alY); SBAR();                                                           \
        if (MLA_DMAPOS == 1) { if ((t) + 2 < NT) DMA_K((t) + 2, s0); if ((t) + 1 < NT) DMA_V((t) + 1, s2); SBAR(); }             \
        if (!late) { MASKT(PX0, PX1, (t)); SBAR(); PV(s0); partialSM(PX0, PX1, m_reg, mnX, alX); MLA_ILV(); SBAR();           \
        RESC(alX); } else { PV(s0); }                                                                                         \
        if (MLA_DMAPOS == 2) { SBAR(); if ((t) + 2 < NT) DMA_K((t) + 2, s0); if ((t) + 1 < NT) DMA_V((t) + 1, s2); }             \
        if ((t) + 2 < NT) MLA_WAITBAR_KV(); else if ((t) + 1 < NT) MLA_WAITBAR_V(); else MLA_WAITBAR(0);                         \
        { const int r_ = s0; s0 = s1; s1 = s2; s2 = r_; } } while (0)
    int t = 1;
    for (; t + 1 < NT; t += 2) {
        HALF_STEP(pB0, pB1, mnB, alB, pA0, pA1, mnA, alA, t);
        HALF_STEP(pA0, pA1, mnA, alA, pB0, pB1, mnB, alB, t + 1);
    }
    HALF_STEP(pB0, pB1, mnB, alB, pA0, pA1, mnA, alA, t);
    if (late) { MASKT(pB0, pB1, NT - 1); partialSM(pB0, pB1, m_reg, mnB, alB); RESC(alB); }
    FINISH(pB0, pB1, alB); SBAR(); PV(s0);
    float rli[16];
#if MLA_FP8PV
#pragma unroll
    for (int r = 0; r < 16; ++r) rli[r] = __builtin_amdgcn_rcpf(o[4][r] * V8_SCALE);
#else
    if (hi == 0) li_l[r32] = l_reg; asm volatile("s_waitcnt lgkmcnt(0)" ::: "memory");
#pragma unroll
    for (int r = 0; r < 16; ++r) rli[r] = __builtin_amdgcn_rcpf(li_l[crow(r, hi)]);
#endif
    bf16* Ow = (bf16*)(const_cast<unsigned char*>(wsb) + WS_OA) + row0 * PO + h * 128;
    unsigned oo = (unsigned)r32; asm volatile("" : "+v"(oo));
#pragma unroll
    for (int r = 0; r < 16; ++r) { const int orow = crow(r, hi);
#pragma unroll
        for (int d0 = 0; d0 < 4; ++d0) { const float v = o[d0][r] * rli[r];
            const float vn = __shfl_xor(v, 1);
            if ((r32 & 1) == 0) *(unsigned*)(Ow + orow * PO + d0 * 32 + oo) = cvtpk(v, vn); } }
    MLA_WAITBAR(0);
#undef DMA_K
#undef DMA_V
#undef QPF
#undef QKT
#undef K8F
#undef MLA_NK
#undef TRRD
#undef PV_D0
#undef PV
#undef FINISH
#undef MLA_NV
#undef RESC
#undef MASKT
#undef HALF_STEP
}
__device__ __forceinline__ void mla_phase(char* lds, int vcu, int G, const unsigned char* wsb) {
    for (int L = vcu; L < 1024; L += G) { const int bh = L >> 4, y = L & 15;
        for (int pass = 0; pass < 2; ++pass) mla_block(wsb, bh >> 5, bh & 31, pass ? 31 - y : y, lds); }
}
#undef MLA_GLDS
#undef MLA_WAITBAR
#undef SBAR
}

namespace swa {
typedef short bf16x8 __attribute__((ext_vector_type(8)));
typedef short s16x4 __attribute__((ext_vector_type(4)));
typedef float f32x16 __attribute__((ext_vector_type(16)));
typedef unsigned u32x4 __attribute__((ext_vector_type(4)));
typedef unsigned short bf16;
constexpr int OFF_K = 0, OFF_V = 24576, OFF_O = 49152, LDS_BYTES = 49152 + 8 * 8192;
__device__ __forceinline__ int v_st64(int k, int c) { const int kk = (k & ~0xC) | ((k & 4) << 1) | ((k & 8) >> 1); return ((kk >> 3) * 2 + (c >> 5)) * 512 + ((kk & 7) * 32 + (c & 31)) * 2; }
__device__ __forceinline__ int v_rd_base(int lane) { return ((lane & 3) << 3) | (((lane >> 2) & 3) << 6) | (((lane >> 4) & 1) << 5) | (((lane >> 5) & 1) << 8); }
__device__ __forceinline__ int crow(int r, int hi) { return (r & 3) + 8 * (r >> 2) + 4 * hi; }
__device__ __forceinline__ unsigned cvtpk(float lo, float hi) { unsigned r; asm volatile("v_cvt_pk_bf16_f32 %0, %1, %2" : "=v"(r) : "v"(lo), "v"(hi)); return r; }
__device__ __forceinline__ float sigm(float v) { return __builtin_amdgcn_rcpf(1.f + __builtin_amdgcn_exp2f(-v * 1.4426950408889634f)); }
typedef float f32x2v __attribute__((ext_vector_type(2)));
__device__ __forceinline__ float sigm8(float v) { return __builtin_amdgcn_rcpf(1.f + __builtin_amdgcn_exp2f(-v * (1.4426950408889634f / pg8::GATE_SCALE))); }
#define SWA_PK4(P, B_, OUT) do { unsigned a0 = cvtpk(P[B_+0], P[B_+1]), a1 = cvtpk(P[B_+2], P[B_+3]);                          \
        unsigned b0 = cvtpk(P[B_+4], P[B_+5]), b1 = cvtpk(P[B_+6], P[B_+7]);                                             \
        auto r0 = __builtin_amdgcn_permlane32_swap(a0, b0, false, false); auto r1 = __builtin_amdgcn_permlane32_swap(a1, b1, false, false); \
        u32x4 w = {r0[0], r1[0], r0[1], r1[1]}; OUT = *reinterpret_cast<bf16x8*>(&w); } while (0)
template <bool MIX_FP8>
__device__ __forceinline__ void swa_phase(float MIXS, char* lds, int vcu, int G, const bf16* ZSQ, const bf16* ZSK, const bf16* ZSV, const float* sinks,
                                          const bf16* OA, const bf16* ZA, const bf16* ZB, bf16* MIX,
                                          const float* cu, const float* cv, unsigned char* du, unsigned char* dv, float su, float sv) {
    const size_t CV_N = (size_t)2 * 16384 * 256, cv_stride = (size_t)G * 512; size_t cv_i = (size_t)blockIdx.x * 512 + threadIdx.x;
#define CV_LOAD(R, idx) do { const size_t i_ = (idx); if (cu != nullptr && i_ < CV_N) { const bool second_ = i_ >= CV_N / 2; const size_t j_ = second_ ? i_ - CV_N / 2 : i_; \
            const f32x4* p_ = (const f32x4*)((second_ ? cv : cu) + j_ * 16); R[0] = p_[0]; R[1] = p_[1]; R[2] = p_[2]; R[3] = p_[3]; } } while (0)
#define CV_STORE(R, idx) do { const size_t i_ = (idx); if (cu != nullptr && i_ < CV_N) { const bool second_ = i_ >= CV_N / 2; const size_t j_ = second_ ? i_ - CV_N / 2 : i_; const float sc_ = second_ ? sv : su; \
            const size_t e_ = j_ >> 8; const int g_ = (int)(j_ & 255), s_ = g_ >> 3, c_ = g_ & 7; u32x4 o_; int w_; \
            w_ = __builtin_amdgcn_cvt_pk_fp8_f32(R[0].x * sc_, R[0].y * sc_, 0, false); w_ = __builtin_amdgcn_cvt_pk_fp8_f32(R[0].z * sc_, R[0].w * sc_, w_, true); o_.x = (unsigned)w_; \
            w_ = __builtin_amdgcn_cvt_pk_fp8_f32(R[1].x * sc_, R[1].y * sc_, 0, false); w_ = __builtin_amdgcn_cvt_pk_fp8_f32(R[1].z * sc_, R[1].w * sc_, w_, true); o_.y = (unsigned)w_; \
            w_ = __builtin_amdgcn_cvt_pk_fp8_f32(R[2].x * sc_, R[2].y * sc_, 0, false); w_ = __builtin_amdgcn_cvt_pk_fp8_f32(R[2].z * sc_, R[2].w * sc_, w_, true); o_.z = (unsigned)w_; \
            w_ = __builtin_amdgcn_cvt_pk_fp8_f32(R[3].x * sc_, R[3].y * sc_, 0, false); w_ = __builtin_amdgcn_cvt_pk_fp8_f32(R[3].z * sc_, R[3].w * sc_, w_, true); o_.w = (unsigned)w_; \
            *(u32x4*)((second_ ? dv : du) + ((size_t)s_ * 16384 + e_) * 128 + c_ * 16) = o_; } } while (0)
    f32x4 cvA[4], cvB[4];
    const int tid0 = threadIdx.x, wid = __builtin_amdgcn_readfirstlane(tid0 >> 6);
    float* ost = (float*)(lds + OFF_O + wid * 8192);
    int tid = tid0, lane = tid & 63, r32 = lane & 31, hi = lane >> 5;
    u32x4 kvn[3], vvn[3]; bf16x8 qn[4];
#define SWA_FETCH(un) do { const int qt_ = (un) & 255, g_ = ((un) >> 8) & 7, b_ = (un) >> 11, kb_ = ((qt_ >> 1) - 2) * 64; const size_t br_ = (size_t)b_ * 8192; \
        _Pragma("unroll") for (int i = 0; i < 3; ++i) { const int idx = tid + 512 * i, key = idx >> 3, ch = idx & 7; int kpos = kb_ + key; kpos = kpos < 0 ? 0 : kpos; \
            kvn[i] = *(const u32x4*)(ZSK + (br_ + kpos) * 512 + g_ * 64 + ch * 8); vvn[i] = *(const u32x4*)(ZSV + (br_ + kpos) * 512 + g_ * 64 + ch * 8); } \
        _Pragma("unroll") for (int d0 = 0; d0 < 4; ++d0) qn[d0] = *(const bf16x8*)(ZSQ + (br_ + qt_ * 32 + r32) * 4096 + (g_ * 8 + wid) * 64 + d0 * 16 + hi * 8); } while (0)
    if (vcu < 4096) SWA_FETCH(vcu);
    for (int unit = vcu; unit < 4096; unit += G) {
        tid = tid0; asm volatile("" : "+v"(tid)); lane = tid & 63; r32 = lane & 31; hi = lane >> 5;
        const int vb0 = (int)(uintptr_t)lds + OFF_V + v_rd_base(lane);
        const int qt = unit & 255, g = (unit >> 8) & 7, b = unit >> 11, q0 = qt * 32, kbase = ((qt >> 1) - 2) * 64, hq = g * 8 + wid;
        const size_t brow = (size_t)b * 8192;
#pragma unroll
        for (int i = 0; i < 3; ++i) { const int idx = tid + 512 * i, key = idx >> 3, ch = idx & 7;
            *(u32x4*)(lds + OFF_K + key * 128 + ((ch ^ ((key >> 1) & 7)) << 4)) = kvn[i];
            *(u32x4*)(lds + OFF_V + (key >> 6) * 8192 + v_st64(key & 63, ch * 8)) = vvn[i]; }
        bf16x8 qr[4];
#pragma unroll
        for (int d0 = 0; d0 < 4; ++d0) qr[d0] = qn[d0];
        __syncthreads();
        __builtin_amdgcn_sched_barrier(0);
        if (unit + G < 4096) SWA_FETCH(unit + G);
        CV_LOAD(cvA, cv_i); CV_LOAD(cvB, cv_i + cv_stride);
        __builtin_amdgcn_sched_barrier(0);
        f32x16 p[3][2];
#pragma unroll
        for (int t = 0; t < 3; ++t)
#pragma unroll
            for (int hf = 0; hf < 2; ++hf) { f32x16 acc = {}; const int key = t * 64 + hf * 32 + r32;
#pragma unroll
                for (int d0 = 0; d0 < 4; ++d0) { const bf16x8 a = *(const bf16x8*)(lds + OFF_K + key * 128 + (((2 * d0 + hi) ^ ((key >> 1) & 7)) << 4));
                    acc = __builtin_amdgcn_mfma_f32_32x32x16_bf16(a, qr[d0], acc, 0, 0, 0); }
                p[t][hf] = acc; }
        const float slope2 = exp2f(-(float)(hq + 1) * 0.125f) * 1.4426950408889634f;
        const float sink2 = sinks[hq] * 1.4426950408889634f;
        const int qpos = q0 + r32, D0 = qpos - kbase - 4 * hi; const unsigned lim = (unsigned)(qpos + 1 < 128 ? qpos + 1 : 128);
        const float Bl = slope2 * (float)(4 * hi), sinkp = sink2 + slope2 * (float)(qpos - kbase); float mx = sinkp - Bl;
#pragma unroll
        for (int t = 0; t < 3; ++t)
#pragma unroll
            for (int hf = 0; hf < 2; ++hf)
#pragma unroll
                for (int r = 0; r < 16; ++r) { const int cst = t * 64 + hf * 32 + (r & 3) + 8 * (r >> 2);
                    const bool valid = (unsigned)(D0 - cst) < lim;
                    const float s = valid ? fmaf(slope2, (float)cst, p[t][hf][r]) : -__builtin_inff();
                    p[t][hf][r] = s; mx = fmaxf(mx, s); }
        float mxr = mx + Bl;
        { auto rr = __builtin_amdgcn_permlane32_swap(__float_as_uint(mxr), __float_as_uint(mxr), false, false); mxr = fmaxf(__uint_as_float(rr[0]), __uint_as_float(rr[1])); }
        mx = mxr - Bl;
        float ps = 0.f;
#pragma unroll
        for (int t = 0; t < 3; ++t)
#pragma unroll
            for (int hf = 0; hf < 2; ++hf)
#pragma unroll
                for (int r = 0; r < 16; ++r) { const float e = __builtin_amdgcn_exp2f(p[t][hf][r] - mx); p[t][hf][r] = e; ps += e; }
        { auto rr = __builtin_amdgcn_permlane32_swap(__float_as_uint(ps), __float_as_uint(ps), false, false); ps = __uint_as_float(rr[0]) + __uint_as_float(rr[1]); }
        const float linv = __builtin_amdgcn_rcpf(ps + __builtin_amdgcn_exp2f(sinkp - mxr));
        __builtin_amdgcn_sched_barrier(0);
        CV_STORE(cvA, cv_i); CV_STORE(cvB, cv_i + cv_stride); cv_i += 2 * cv_stride;
        CV_LOAD(cvA, cv_i); CV_LOAD(cvB, cv_i + cv_stride);
        __builtin_amdgcn_sched_barrier(0);
        f32x16 o[2] = {};
#pragma unroll
        for (int t = 0; t < 3; ++t) { bf16x8 pa[4];
            SWA_PK4(p[t][0], 0, pa[0]); SWA_PK4(p[t][0], 8, pa[1]); SWA_PK4(p[t][1], 0, pa[2]); SWA_PK4(p[t][1], 8, pa[3]);
#pragma unroll
            for (int d0 = 0; d0 < 2; ++d0) { s16x4 lo[4], hh[4];
#pragma unroll
                for (int ks = 0; ks < 4; ++ks) {
                    asm volatile("ds_read_b64_tr_b16 %0, %1 offset:%2" : "=&v"(lo[ks]) : "v"(vb0), "i"(t * 8192 + d0 * 512 + ks * 2048) : "memory");
                    asm volatile("ds_read_b64_tr_b16 %0, %1 offset:%2" : "=&v"(hh[ks]) : "v"(vb0), "i"(t * 8192 + d0 * 512 + ks * 2048 + 1024) : "memory"); }
                asm volatile("s_waitcnt lgkmcnt(0)" ::: "memory"); __builtin_amdgcn_sched_barrier(0);
#pragma unroll
                for (int ks = 0; ks < 4; ++ks)
                    o[d0] = __builtin_amdgcn_mfma_f32_32x32x16_bf16(pa[ks], (bf16x8){lo[ks][0], lo[ks][1], lo[ks][2], lo[ks][3], hh[ks][0], hh[ks][1], hh[ks][2], hh[ks][3]}, o[d0], 0, 0, 0); } }
        __builtin_amdgcn_sched_barrier(0);
        u32x4 ea[4]; [[maybe_unused]] u32x4 eza[4], ezb[4]; [[maybe_unused]] unsigned long long gza[4], gzb[4];
#pragma unroll
        for (int i = 0; i < 4; ++i) { const int idx = lane + 64 * i, row = idx >> 3, c8 = idx & 7; const size_t off = (brow + q0 + row) * 4096 + hq * 64 + c8 * 8;
            ea[i] = *(const u32x4*)(OA + off);
            if (GATE_FP8) { gza[i] = *(const unsigned long long*)((const unsigned char*)ZA + off); gzb[i] = *(const unsigned long long*)((const unsigned char*)ZB + off); }
            else { eza[i] = *(const u32x4*)(ZA + off); ezb[i] = *(const u32x4*)(ZB + off); } }
        __builtin_amdgcn_sched_barrier(0);
        if (hi == 0) ost[r32] = linv;
        asm volatile("s_waitcnt lgkmcnt(0)" ::: "memory");
        float rl[16];
#pragma unroll
        for (int r = 0; r < 16; ++r) rl[r] = ost[crow(r, hi)];
        asm volatile("s_waitcnt lgkmcnt(0)" ::: "memory"); __builtin_amdgcn_sched_barrier(0);
#pragma unroll
        for (int r = 0; r < 16; ++r)
#pragma unroll
            for (int d0 = 0; d0 < 2; ++d0) ost[crow(r, hi) * 64 + d0 * 32 + r32] = o[d0][r] * rl[r];
        asm volatile("s_waitcnt lgkmcnt(0)" ::: "memory"); __builtin_amdgcn_sched_barrier(0);
#pragma unroll
        for (int i = 0; i < 4; ++i) { const int idx = lane + 64 * i, row = idx >> 3, c8 = idx & 7;
            const f32x4 oa_ = *(const f32x4*)(ost + row * 64 + c8 * 8), ob_ = *(const f32x4*)(ost + row * 64 + c8 * 8 + 4);
            const size_t off = (brow + q0 + row) * 4096 + hq * 64 + c8 * 8;
            const u32x4 a = ea[i];
            float m[8];
            if (GATE_FP8) { const unsigned a0 = (unsigned)gza[i], a1 = (unsigned)(gza[i] >> 32), b0 = (unsigned)gzb[i], b1 = (unsigned)(gzb[i] >> 32);
                const f32x2v ga0 = __builtin_amdgcn_cvt_pk_f32_fp8((int)a0, false), ga1 = __builtin_amdgcn_cvt_pk_f32_fp8((int)a0, true), ga2 = __builtin_amdgcn_cvt_pk_f32_fp8((int)a1, false), ga3 = __builtin_amdgcn_cvt_pk_f32_fp8((int)a1, true);
                const f32x2v gb0 = __builtin_amdgcn_cvt_pk_f32_fp8((int)b0, false), gb1 = __builtin_amdgcn_cvt_pk_f32_fp8((int)b0, true), gb2 = __builtin_amdgcn_cvt_pk_f32_fp8((int)b1, false), gb3 = __builtin_amdgcn_cvt_pk_f32_fp8((int)b1, true);
                m[0] = sigm8(ga0.x) * bflo(a.x) + sigm8(gb0.x) * oa_.x; m[1] = sigm8(ga0.y) * bfhi(a.x) + sigm8(gb0.y) * oa_.y;
                m[2] = sigm8(ga1.x) * bflo(a.y) + sigm8(gb1.x) * oa_.z; m[3] = sigm8(ga1.y) * bfhi(a.y) + sigm8(gb1.y) * oa_.w;
                m[4] = sigm8(ga2.x) * bflo(a.z) + sigm8(gb2.x) * ob_.x; m[5] = sigm8(ga2.y) * bfhi(a.z) + sigm8(gb2.y) * ob_.y;
                m[6] = sigm8(ga3.x) * bflo(a.w) + sigm8(gb3.x) * ob_.z; m[7] = sigm8(ga3.y) * bfhi(a.w) + sigm8(gb3.y) * ob_.w; }
            else { const u32x4 za = eza[i], zb = ezb[i];
            m[0] = sigm(bflo(za.x)) * bflo(a.x) + sigm(bflo(zb.x)) * oa_.x; m[1] = sigm(bfhi(za.x)) * bfhi(a.x) + sigm(bfhi(zb.x)) * oa_.y;
            m[2] = sigm(bflo(za.y)) * bflo(a.y) + sigm(bflo(zb.y)) * oa_.z; m[3] = sigm(bfhi(za.y)) * bfhi(a.y) + sigm(bfhi(zb.y)) * oa_.w;
            m[4] = sigm(bflo(za.z)) * bflo(a.z) + sigm(bflo(zb.z)) * ob_.x; m[5] = sigm(bfhi(za.z)) * bfhi(a.z) + sigm(bfhi(zb.z)) * ob_.y;
            m[6] = sigm(bflo(za.w)) * bflo(a.w) + sigm(bflo(zb.w)) * ob_.z; m[7] = sigm(bfhi(za.w)) * bfhi(a.w) + sigm(bfhi(zb.w)) * ob_.w; }
            if (MIX_FP8) { int t0_ = __builtin_amdgcn_cvt_pk_fp8_f32(m[0] * MIXS, m[1] * MIXS, 0, false); t0_ = __builtin_amdgcn_cvt_pk_fp8_f32(m[2] * MIXS, m[3] * MIXS, t0_, true);
                int t1_ = __builtin_amdgcn_cvt_pk_fp8_f32(m[4] * MIXS, m[5] * MIXS, 0, false); t1_ = __builtin_amdgcn_cvt_pk_fp8_f32(m[6] * MIXS, m[7] * MIXS, t1_, true);
                *(unsigned long long*)((unsigned char*)MIX + off) = (unsigned long long)(unsigned)t0_ | ((unsigned long long)(unsigned)t1_ << 32); }
            else { u32x4 w; w.x = cvtpk(m[0], m[1]); w.y = cvtpk(m[2], m[3]); w.z = cvtpk(m[4], m[5]); w.w = cvtpk(m[6], m[7]);
                *(u32x4*)(MIX + off) = w; } }
        CV_STORE(cvA, cv_i); CV_STORE(cvB, cv_i + cv_stride); cv_i += 2 * cv_stride;
        __syncthreads();
    }
    for (; cu != nullptr && cv_i < CV_N; cv_i += cv_stride) { CV_LOAD(cvA, cv_i); CV_STORE(cvA, cv_i); }
#undef CV_LOAD
#undef CV_STORE
#undef SWA_FETCH
}
}

namespace peer {
typedef short bf16x8 __attribute__((ext_vector_type(8)));
typedef float f32x16 __attribute__((ext_vector_type(16)));
typedef unsigned u32x4 __attribute__((ext_vector_type(4)));
typedef unsigned short bf16;
constexpr int OFF_E = 0, OFF_G = 16384, LDS_BYTES = 32768;
__device__ __forceinline__ int crow(int r, int hi) { return (r & 3) + 8 * (r >> 2) + 4 * hi; }
__device__ __forceinline__ unsigned mono(float f) { const unsigned u = __float_as_uint(f); return (u & 0x80000000u) ? ~u : (u | 0x80000000u); }
__device__ __forceinline__ float unmono(unsigned k) { return __uint_as_float((k & 0x80000000u) ? (k & 0x7fffffffu) : ~k); }
__device__ __forceinline__ unsigned umax(unsigned a, unsigned b) { return a > b ? a : b; }
__device__ __forceinline__ unsigned umin(unsigned a, unsigned b) { return a < b ? a : b; }
template <int N> __device__ __forceinline__ void bitonic_sort_desc(unsigned* v) {
#pragma unroll
    for (int k = 2; k <= N; k <<= 1)
#pragma unroll
        for (int j = k >> 1; j > 0; j >>= 1)
#pragma unroll
            for (int i = 0; i < N; ++i) { const int l = i ^ j;
                if (l > i) { const unsigned x = v[i], y = v[l]; const bool desc = ((i & k) == 0);
                    v[i] = desc ? umax(x, y) : umin(x, y); v[l] = desc ? umin(x, y) : umax(x, y); } }
}
template <int N> __device__ __forceinline__ void bitonic_merge_desc(unsigned* v) {
#pragma unroll
    for (int j = N >> 1; j > 0; j >>= 1)
#pragma unroll
        for (int i = 0; i < N; ++i) { const int l = i ^ j; if (l > i) { const unsigned x = v[i], y = v[l]; v[i] = umax(x, y); v[l] = umin(x, y); } }
}
__device__ __forceinline__ void merge_top16(unsigned* a, const unsigned* b) {
#pragma unroll
    for (int i = 0; i < 16; ++i) a[i] = umax(a[i], b[15 - i]);
    bitonic_merge_desc<16>(a);
}
__device__ __forceinline__ void top16_of_64(unsigned (&k)[64]) {
    bitonic_sort_desc<16>(k); bitonic_sort_desc<16>(k + 16); bitonic_sort_desc<16>(k + 32); bitonic_sort_desc<16>(k + 48);
    merge_top16(k, k + 16); merge_top16(k + 32, k + 48); merge_top16(k, k + 32);
}
__device__ __forceinline__ void top16_pair(unsigned (&k)[64], unsigned (&out)[16]) {
    top16_of_64(k);
    unsigned pb[16];
#pragma unroll
    for (int i = 0; i < 16; ++i) pb[i] = (unsigned)__shfl_xor((int)k[i], 32);
    merge_top16(k, pb);
#pragma unroll
    for (int i = 0; i < 16; ++i) out[i] = k[i];
}
__device__ __forceinline__ float gelu_erf(float v) { return 0.5f * v * (1.0f + erff(v * 0.70710678118654752f)); }


__device__ __forceinline__ void peer_topk(int vcu, int G, const bf16* PQ, const bf16* SUBK, int* EXP, float* GATE) {
    const int tid = threadIdx.x, wid = __builtin_amdgcn_readfirstlane(tid >> 6), lane0 = tid & 63;
    for (int tile = vcu; tile < 512; tile += G) {
        const int t0 = tile * 32;
        int lane = lane0; asm volatile("" : "+v"(lane));
        const int r32 = lane & 31, hi = lane >> 5;
        const int h = wid; unsigned la[16], lb[16];
        const int koff = r32 * 128 + hi * 8;
#pragma unroll
        for (int p = 0; p < 2; ++p) {
            bf16x8 q[8];
#pragma unroll
            for (int ks = 0; ks < 8; ++ks) q[ks] = *(const bf16x8*)(PQ + (size_t)(t0 + r32) * 2048 + (h * 2 + p) * 128 + ks * 16 + hi * 8);
            unsigned k[64];
#pragma unroll
            for (int blk = 0; blk < 4; ++blk) { f32x16 acc = {};
#pragma unroll
                for (int ks = 0; ks < 8; ++ks) { const bf16x8 a = *(const bf16x8*)(SUBK + ((h * 2 + p) * 128 + blk * 32) * 128 + ks * 16 + koff);
                    acc = __builtin_amdgcn_mfma_f32_32x32x16_bf16(a, q[ks], acc, 0, 0, 0); }
#pragma unroll
                for (int r = 0; r < 16; ++r) { const int n = blk * 32 + crow(r, hi); k[blk * 16 + r] = (mono(acc[r]) & ~0x7fu) | (unsigned)(127 - n); } }
            if (p == 0) top16_pair(k, la); else top16_pair(k, lb);
        }
        float va[16], vb[16];
#pragma unroll
        for (int i = 0; i < 16; ++i) { va[i] = unmono(la[i] & ~0x7fu); vb[i] = unmono(lb[i] & ~0x7fu); }
        unsigned c[64]; int nc = 0;
#pragma unroll
        for (int i = 0; i < 16; ++i)
#pragma unroll
            for (int j = 0; j < 16; ++j) if ((i + 1) * (j + 1) <= 16) { c[nc] = (mono(va[i] + vb[j]) & ~0xffu) | (unsigned)(255 - (i * 16 + j)); ++nc; }
#pragma unroll
        for (int i = 50; i < 64; ++i) c[i] = 0u;
        top16_of_64(c);
        unsigned ia[4], ib[4];
#pragma unroll
        for (int w = 0; w < 4; ++w) { ia[w] = 0u; ib[w] = 0u;
#pragma unroll
            for (int e = 0; e < 4; ++e) { ia[w] |= (127u - (la[4 * w + e] & 0x7fu)) << (8 * e); ib[w] |= (127u - (lb[4 * w + e] & 0x7fu)) << (8 * e); } }
        float bs[16]; int be[16];
#pragma unroll
        for (int kk = 0; kk < 16; ++kk) {
            const unsigned m = c[kk];
            const unsigned code = 255u - (m & 0xffu), ci = code >> 4, cj = code & 15u;
            const unsigned wa = (ci < 8u) ? ((ci < 4u) ? ia[0] : ia[1]) : ((ci < 12u) ? ia[2] : ia[3]);
            const unsigned wb = (cj < 8u) ? ((cj < 4u) ? ib[0] : ib[1]) : ((cj < 12u) ? ib[2] : ib[3]);
            const unsigned i1 = (wa >> ((ci & 3u) * 8u)) & 0xffu, i2 = (wb >> ((cj & 3u) * 8u)) & 0xffu;
            bs[kk] = unmono(m & ~0xffu);
            be[kk] = (int)(i1 * 128u + i2);
        }
        float mx = bs[0];
#pragma unroll
        for (int kk = 1; kk < 16; ++kk) mx = fmaxf(mx, bs[kk]);
        float sum = 0.f;
#pragma unroll
        for (int kk = 0; kk < 16; ++kk) { bs[kk] = __expf(bs[kk] - mx); sum += bs[kk]; }
        const float inv = 1.0f / sum;
        if (hi == 0) { int* ep = EXP + (size_t)(t0 + r32) * 128 + h * 16; float* gp = GATE + (size_t)(t0 + r32) * 128 + h * 16;
#pragma unroll
            for (int q4 = 0; q4 < 4; ++q4) { *(u32x4*)(ep + 4 * q4) = (u32x4){(unsigned)be[4 * q4], (unsigned)be[4 * q4 + 1], (unsigned)be[4 * q4 + 2], (unsigned)be[4 * q4 + 3]};
                *(f32x4*)(gp + 4 * q4) = (f32x4){bs[4 * q4] * inv, bs[4 * q4 + 1] * inv, bs[4 * q4 + 2] * inv, bs[4 * q4 + 3] * inv}; } }
    }
}
struct Census { int xi, nx, rank, nloc; };
__device__ __forceinline__ unsigned cen_ld(unsigned* p) { return __hip_atomic_load(p, __ATOMIC_RELAXED, __HIP_MEMORY_SCOPE_AGENT); }
__device__ __forceinline__ void census_post(unsigned* cen, volatile __attribute__((address_space(3))) unsigned* misc) {
    if (threadIdx.x == 0) { const unsigned x = (unsigned)__builtin_amdgcn_s_getreg((3 << 11) | 20) & 0xFu;
        misc[0] = x; misc[1] = __hip_atomic_fetch_add(cen + 64 * x, 1u, __ATOMIC_RELAXED, __HIP_MEMORY_SCOPE_AGENT); }
}
__device__ __forceinline__ Census census_complete(unsigned* cen, volatile __attribute__((address_space(3))) unsigned* misc) {
    if (threadIdx.x == 0) { const unsigned G = gridDim.x, x = misc[0]; unsigned sum = 0, cnt = 0, mine = 1, before = 0;
        for (unsigned sp = 0; sp < (1u << 20); ++sp) { sum = 0; cnt = 0; before = 0;
#pragma unroll
            for (unsigned j = 0; j < 16; ++j) { const unsigned c = cen_ld(cen + 64 * j); sum += c; cnt += c > 0u ? 1u : 0u; before += (j < x && c > 0u) ? 1u : 0u; mine = (j == x) ? c : mine; }
            if (sum == G) break; __builtin_amdgcn_s_sleep(2); }
        misc[2] = before; misc[3] = cnt > 0u ? cnt : 1u; misc[4] = mine > 0u ? mine : 1u; }
    __syncthreads();
    Census z; z.xi = (int)misc[2]; z.nx = (int)misc[3]; z.rank = (int)misc[1]; z.nloc = (int)misc[4];
    z.xi = __builtin_amdgcn_readfirstlane(z.xi); z.nx = __builtin_amdgcn_readfirstlane(z.nx); z.rank = __builtin_amdgcn_readfirstlane(z.rank); z.nloc = __builtin_amdgcn_readfirstlane(z.nloc);
    return z;
}
__device__ __forceinline__ float dpp_sum8(float v) {
    v += __builtin_bit_cast(float, __builtin_amdgcn_update_dpp(0, __builtin_bit_cast(int, v), 0xB1, 0xf, 0xf, true));
    v += __builtin_bit_cast(float, __builtin_amdgcn_update_dpp(0, __builtin_bit_cast(int, v), 0x4E, 0xf, 0xf, true));
    v += __builtin_bit_cast(float, __builtin_amdgcn_update_dpp(0, __builtin_bit_cast(int, v), 0x141, 0xf, 0xf, true));
    return v;
}
__device__ __forceinline__ void swap32(float& x, float& y) { auto r = __builtin_amdgcn_permlane32_swap(__float_as_uint(x), __float_as_uint(y), false, false); x = __uint_as_float(r[0]); y = __uint_as_float(r[1]); }
__device__ __forceinline__ void swap16(float& x, float& y) { auto r = __builtin_amdgcn_permlane16_swap(__float_as_uint(x), __float_as_uint(y), false, false); x = __uint_as_float(r[0]); y = __uint_as_float(r[1]); }
__device__ __forceinline__ float ror8_add(float v) { return v + __builtin_bit_cast(float, __builtin_amdgcn_update_dpp(0, __builtin_bit_cast(int, v), 0x128, 0xf, 0xf, true)); }
__device__ __forceinline__ void reduce_hi3(float (&v)[16]) {
#pragma unroll
    for (int k = 0; k < 8; ++k) { swap32(v[k], v[k + 8]); v[k] += v[k + 8]; }
#pragma unroll
    for (int k = 0; k < 4; ++k) { swap16(v[k], v[k + 4]); v[k] += v[k + 4]; }
#pragma unroll
    for (int k = 0; k < 4; ++k) v[k] = ror8_add(v[k]);
}
__device__ __forceinline__ void peer_u(const Census cz, const bf16* H2, const bf16* US, const int* EXP, float* PX) {
    const int tid = threadIdx.x, wid = __builtin_amdgcn_readfirstlane(tid >> 6), lane0 = tid & 63;
    const int wi = cz.rank * 8 + wid, NWV = cz.nloc * 8;
    float* PXx = PX + (size_t)cz.xi * (16384 * 128);
    int pass = 0;
    for (int s = cz.xi; s < 64; s += cz.nx, ++pass) {
        const unsigned char* Us = (const unsigned char*)US + (size_t)s * (16384 * 128);
        for (int t = wi; t < 16384; t += NWV) {
            int lane = lane0; asm volatile("" : "+v"(lane));
            const int e8 = lane >> 3, c = lane & 7;
            const u32x4* ip = (const u32x4*)(EXP + (size_t)t * 128 + e8 * 16);
            const u32x4 i0 = ip[0], i1 = ip[1], i2 = ip[2], i3 = ip[3];
            const u32x4 xv = *(const u32x4*)(H2 + (size_t)t * 4096 + s * 64 + c * 8);
            float* pp = PXx + (size_t)t * 128 + e8 * 16;
            f32x4 o0 = {0.f, 0.f, 0.f, 0.f}, o1 = o0, o2 = o0, o3 = o0;
            if (pass != 0 && c == 0) { o0 = *(const f32x4*)pp; o1 = *(const f32x4*)(pp + 4); o2 = *(const f32x4*)(pp + 8); o3 = *(const f32x4*)(pp + 12); }
            const unsigned ids[16] = {i0.x, i0.y, i0.z, i0.w, i1.x, i1.y, i1.z, i1.w, i2.x, i2.y, i2.z, i2.w, i3.x, i3.y, i3.z, i3.w};
            u32x4 uv[16];
#pragma unroll
            for (int i = 0; i < 16; ++i) uv[i] = *(const u32x4*)(Us + (ids[i] * 128u + (unsigned)c * 16u));
            float d[16];
#pragma unroll
            for (int i = 0; i < 16; ++i) { float a = dot2bf(uv[i].x, xv.x, 0.f); a = dot2bf(uv[i].y, xv.y, a); a = dot2bf(uv[i].z, xv.z, a); a = dot2bf(uv[i].w, xv.w, a); d[i] = dpp_sum8(a); }
            if (c == 0) {
                *(f32x4*)pp = (f32x4){o0.x + d[0], o0.y + d[1], o0.z + d[2], o0.w + d[3]}; *(f32x4*)(pp + 4) = (f32x4){o1.x + d[4], o1.y + d[5], o1.z + d[6], o1.w + d[7]};
                *(f32x4*)(pp + 8) = (f32x4){o2.x + d[8], o2.y + d[9], o2.z + d[10], o2.w + d[11]}; *(f32x4*)(pp + 12) = (f32x4){o3.x + d[12], o3.y + d[13], o3.z + d[14], o3.w + d[15]}; }
        }
    }
}
__device__ __forceinline__ void peer_act(int nx, const float* PX, const float* GATE, float* AV, float dscale, float ascale) {
    const size_t n4 = (size_t)16384 * 128 / 4, nthr = (size_t)gridDim.x * 512;
    for (size_t i = (size_t)blockIdx.x * 512 + threadIdx.x; i < n4; i += nthr) { f32x4 s = *(const f32x4*)(PX + 4 * i);
        for (int x = 1; x < nx; ++x) s += *(const f32x4*)(PX + (size_t)x * (16384 * 128) + 4 * i);
        const f32x4 g = *(const f32x4*)(GATE + 4 * i);
        s = s * dscale;
        *(f32x4*)(AV + 4 * i) = (f32x4){gelu_erf(s.x) * g.x * ascale, gelu_erf(s.y) * g.y * ascale, gelu_erf(s.z) * g.z * ascale, gelu_erf(s.w) * g.w * ascale}; }
}
__device__ __forceinline__ void peer_v(const Census cz, const bf16* VS, const int* EXP, const float* AV, bf16* Y, float* RS) {
    const int tid = threadIdx.x, wid = __builtin_amdgcn_readfirstlane(tid >> 6), lane0 = tid & 63;
    const int wi = cz.rank * 8 + wid, NWV = cz.nloc * 8;
    for (int s = cz.xi; s < 64; s += cz.nx) {
        const unsigned char* Vs = (const unsigned char*)VS + (size_t)s * (16384 * 128);
        for (int t = wi; t < 16384; t += NWV) {
            int lane = lane0; asm volatile("" : "+v"(lane));
            const int e8 = lane >> 3, c = lane & 7;
            const u32x4* ip = (const u32x4*)(EXP + (size_t)t * 128 + e8 * 16);
            const u32x4 i0 = ip[0], i1 = ip[1], i2 = ip[2], i3 = ip[3];
            const f32x4* ap = (const f32x4*)(AV + (size_t)t * 128 + e8 * 16);
            const f32x4 a0 = ap[0], a1 = ap[1], a2 = ap[2], a3 = ap[3];
            const unsigned ids[16] = {i0.x, i0.y, i0.z, i0.w, i1.x, i1.y, i1.z, i1.w, i2.x, i2.y, i2.z, i2.w, i3.x, i3.y, i3.z, i3.w};
            const float av[16] = {a0.x, a0.y, a0.z, a0.w, a1.x, a1.y, a1.z, a1.w, a2.x, a2.y, a2.z, a2.w, a3.x, a3.y, a3.z, a3.w};
            u32x4 vv[16];
#pragma unroll
            for (int i = 0; i < 16; ++i) vv[i] = *(const u32x4*)(Vs + (ids[i] * 128u + (unsigned)c * 16u));
            float acc[8] = {0.f, 0.f, 0.f, 0.f, 0.f, 0.f, 0.f, 0.f};
#pragma unroll
            for (int i = 0; i < 16; ++i) { const float a = av[i];
                acc[0] += a * bflo(vv[i].x); acc[1] += a * bfhi(vv[i].x); acc[2] += a * bflo(vv[i].y); acc[3] += a * bfhi(vv[i].y);
                acc[4] += a * bflo(vv[i].z); acc[5] += a * bfhi(vv[i].z); acc[6] += a * bflo(vv[i].w); acc[7] += a * bfhi(vv[i].w); }
#pragma unroll
            for (int e = 0; e < 8; ++e) { acc[e] += __shfl_xor(acc[e], 8); acc[e] += __shfl_xor(acc[e], 16); acc[e] += __shfl_xor(acc[e], 32); }
            float ss = 0.f;
#pragma unroll
            for (int e = 0; e < 8; ++e) ss += acc[e] * acc[e];
            ss = dpp_sum8(ss);
            if (e8 == 0) { u32x4 w; w.x = cvtpk(acc[0], acc[1]); w.y = cvtpk(acc[2], acc[3]); w.z = cvtpk(acc[4], acc[5]); w.w = cvtpk(acc[6], acc[7]);
                *(u32x4*)(Y + (size_t)t * 4096 + s * 64 + c * 8) = w;
                if (c == 0) RS[(size_t)t * 64 + s] = ss; }
        }
    }
}
__device__ __forceinline__ void peer_final(LAS unsigned char* lds, int vcu, int G, const float* x, const bf16* T, const float* RSQ, const bf16* Y, const float* RS, int nslices, const float* ada, const float* g_apost, const float* g_post, float* out) {
    const int tid = threadIdx.x, wid = __builtin_amdgcn_readfirstlane(tid >> 6), lane0 = tid & 63;
    LAS f32x4* L = (LAS f32x4*)lds;
    for (int k = tid; k < 2048; k += 512) { const int b = k >> 10, q = k & 1023, slot = ((q >> 7) * 2 + (q & 1)) * 64 + ((q >> 1) & 63);
        const f32x4 a = *(const f32x4*)(ada + b * 24576 + 2 * 4096 + 4 * q), h = *(const f32x4*)(g_apost + 4 * q), f = *(const f32x4*)(ada + b * 24576 + 5 * 4096 + 4 * q), g = *(const f32x4*)(g_post + 4 * q);
        L[b * 2048 + slot] = a * h; L[b * 2048 + 1024 + slot] = f * g; }
    __syncthreads();
    for (int tok = vcu * 8 + wid; tok < 16384; tok += G * 8) { const int b = tok >> 13;
        int lane = lane0; asm volatile("" : "+v"(lane));
        const float rs = lane < nslices ? RS[(size_t)tok * 64 + lane] : 0.f, rq = RSQ[(size_t)tok * 64 + lane];
        const u32x4* Yr = (const u32x4*)(Y + (size_t)tok * 4096) + lane; const u32x4* Tr = (const u32x4*)(T + (size_t)tok * 4096) + lane; const f32x4* xr = (const f32x4*)(x + (size_t)tok * 4096) + 2 * lane;
        u32x4 y[8], t[8]; f32x4 xx[16];
#pragma unroll
        for (int i = 0; i < 8; ++i) { y[i] = Yr[64 * i]; t[i] = Tr[64 * i]; }
#pragma unroll
        for (int i = 0; i < 8; ++i) { xx[2 * i] = xr[128 * i]; xx[2 * i + 1] = xr[128 * i + 1]; }
        __builtin_amdgcn_sched_barrier(0);
        const float rstd = 1.0f / sqrtf(wave_sum(rs) * (1.f / 4096.f) + 1e-6f);
        const float rstdT = 1.0f / sqrtf(wave_sum(rq) * (1.f / 4096.f) + 1e-6f);
        const LAS f32x4* Lb = L + b * 2048 + lane; f32x4* orow = (f32x4*)(out + (size_t)tok * 4096) + 2 * lane;
#pragma unroll
        for (int i = 0; i < 8; ++i) {
            f32x4 t0, t1, y0, y1; t0.x = bflo(t[i].x); t0.y = bfhi(t[i].x); t0.z = bflo(t[i].y); t0.w = bfhi(t[i].y); t1.x = bflo(t[i].z); t1.y = bfhi(t[i].z); t1.z = bflo(t[i].w); t1.w = bfhi(t[i].w);
            y0.x = bflo(y[i].x); y0.y = bfhi(y[i].x); y0.z = bflo(y[i].y); y0.w = bfhi(y[i].y); y1.x = bflo(y[i].z); y1.y = bfhi(y[i].z); y1.z = bflo(y[i].w); y1.w = bfhi(y[i].w);
            const f32x4 o0 = (xx[2 * i] + Lb[128 * i] * (t0 * rstdT)) + Lb[1024 + 128 * i] * (y0 * rstd);
            const f32x4 o1 = (xx[2 * i + 1] + Lb[128 * i + 64] * (t1 * rstdT)) + Lb[1024 + 128 * i + 64] * (y1 * rstd);
            orow[128 * i] = o0; orow[128 * i + 1] = o1; }
    }
}
typedef float f32x2v __attribute__((ext_vector_type(2)));
constexpr float U_SCALE = 1024.f, V_SCALE = 128.f;
__device__ __forceinline__ float dpp_x1(float v) { return __builtin_bit_cast(float, __builtin_amdgcn_update_dpp(0, __builtin_bit_cast(int, v), 0xB1, 0xf, 0xf, true)); }
__device__ __forceinline__ float dpp_x2(float v) { return __builtin_bit_cast(float, __builtin_amdgcn_update_dpp(0, __builtin_bit_cast(int, v), 0x4E, 0xf, 0xf, true)); }
__device__ __forceinline__ float dpp_x4(float v) { int t = __builtin_amdgcn_update_dpp(0, __builtin_bit_cast(int, v), 0x104, 0xf, 0x5, false);
    t = __builtin_amdgcn_update_dpp(t, __builtin_bit_cast(int, v), 0x114, 0xf, 0xa, false); return __builtin_bit_cast(float, t); }
__device__ __forceinline__ void reduce8_t(const float (&d)[16], int c, float& r0, float& r1) {
    const bool b0 = (c & 1) != 0, b1 = (c & 2) != 0, b2 = (c & 4) != 0;
    float a[8], b[4];
#pragma unroll
    for (int j = 0; j < 8; ++j) a[j] = (b0 ? d[2 * j + 1] : d[2 * j]) + dpp_x1(b0 ? d[2 * j] : d[2 * j + 1]);
#pragma unroll
    for (int k = 0; k < 4; ++k) b[k] = (b1 ? a[2 * k + 1] : a[2 * k]) + dpp_x2(b1 ? a[2 * k] : a[2 * k + 1]);
    r0 = (b2 ? b[1] : b[0]) + dpp_x4(b2 ? b[0] : b[1]);
    r1 = (b2 ? b[3] : b[2]) + dpp_x4(b2 ? b[2] : b[3]);
}
__device__ __forceinline__ void peer_u8(const Census cz, const bf16* H2, const unsigned char* US, const int* EXP, float* PX) {
    const int tid = threadIdx.x, wid = __builtin_amdgcn_readfirstlane(tid >> 6), lane0 = tid & 63;
    const int wi = cz.rank * 8 + wid, NWV = cz.nloc * 8;
    float* PXx = PX + (size_t)cz.xi * (16384 * 128);
    int pass = 0;
    for (int s = cz.xi; s < 32; s += cz.nx, ++pass) {
        const unsigned char* Us = US + (size_t)s * (16384 * 128);
        int lane = lane0; asm volatile("" : "+v"(lane));
        const int e8 = lane >> 3, c = lane & 7;
        u32x4 i0, i1, i2, i3, xa, xb; float q0 = 0.f, q1 = 0.f;
#define U8_FETCH(tt) do { const u32x4* ip_ = (const u32x4*)(EXP + (size_t)(tt) * 128 + e8 * 16); i0 = ip_[0]; i1 = ip_[1]; i2 = ip_[2]; i3 = ip_[3]; \
            const bf16* xp_ = H2 + (size_t)(tt) * 4096 + s * 128 + c * 16; xa = *(const u32x4*)xp_; xb = *(const u32x4*)(xp_ + 8); \
            if (pass != 0) { const float* pp_ = PXx + (size_t)(tt) * 128 + e8 * 16 + c; q0 = pp_[0]; q1 = pp_[8]; } } while (0)
        if (wi < 16384) U8_FETCH(wi);
        for (int t = wi; t < 16384; t += NWV) {
            const unsigned ids[16] = {i0.x, i0.y, i0.z, i0.w, i1.x, i1.y, i1.z, i1.w, i2.x, i2.y, i2.z, i2.w, i3.x, i3.y, i3.z, i3.w};
            u32x4 uv[16];
#pragma unroll
            for (int i = 0; i < 16; ++i) uv[i] = *(const u32x4*)(Us + (ids[i] * 128u + (unsigned)c * 16u));
            const f32x2v xp[8] = {{bflo(xa.x), bfhi(xa.x)}, {bflo(xa.y), bfhi(xa.y)}, {bflo(xa.z), bfhi(xa.z)}, {bflo(xa.w), bfhi(xa.w)},
                                  {bflo(xb.x), bfhi(xb.x)}, {bflo(xb.y), bfhi(xb.y)}, {bflo(xb.z), bfhi(xb.z)}, {bflo(xb.w), bfhi(xb.w)}};
            const float p0 = q0, p1 = q1;
            __builtin_amdgcn_sched_barrier(0);
            if (t + NWV < 16384) U8_FETCH(t + NWV);
            __builtin_amdgcn_sched_barrier(0);
            float d[16];
#pragma unroll
            for (int g = 0; g < 4; ++g) { f32x2v a2[4];
#pragma unroll
                for (int q = 0; q < 4; ++q) {
#pragma unroll
                    for (int k = 0; k < 4; ++k) { const int i = 4 * g + k; const unsigned w = q == 0 ? uv[i].x : q == 1 ? uv[i].y : q == 2 ? uv[i].z : uv[i].w;
                        const f32x2v lo = __builtin_amdgcn_cvt_pk_f32_fp8((int)w, false); a2[k] = q == 0 ? lo * xp[0] : __builtin_elementwise_fma(lo, xp[2 * q], a2[k]); }
                    __builtin_amdgcn_sched_barrier(0);
#pragma unroll
                    for (int k = 0; k < 4; ++k) { const int i = 4 * g + k; const unsigned w = q == 0 ? uv[i].x : q == 1 ? uv[i].y : q == 2 ? uv[i].z : uv[i].w;
                        const f32x2v hi = __builtin_amdgcn_cvt_pk_f32_fp8((int)w, true); a2[k] = __builtin_elementwise_fma(hi, xp[2 * q + 1], a2[k]); }
                    __builtin_amdgcn_sched_barrier(0); }
#pragma unroll
                for (int k = 0; k < 4; ++k) d[4 * g + k] = a2[k].x + a2[k].y; }
            float r0, r1; reduce8_t(d, c, r0, r1);
            { float* pp = PXx + (size_t)t * 128 + e8 * 16 + c; pp[0] = p0 + r0; pp[8] = p1 + r1; }
        }
#undef U8_FETCH
    }
}
__device__ __forceinline__ void peer_v8(const Census cz, const unsigned char* VS, const int* EXP, const float* AV, bf16* Y, float* RS) {
    const int tid = threadIdx.x, wid = __builtin_amdgcn_readfirstlane(tid >> 6), lane0 = tid & 63;
    const int wi = cz.rank * 8 + wid, NWV = cz.nloc * 8;
    for (int s = cz.xi; s < 32; s += cz.nx) {
        const unsigned char* Vs = VS + (size_t)s * (16384 * 128);
        int lane = lane0; asm volatile("" : "+v"(lane));
        const int e8 = lane >> 3, c = lane & 7;
        u32x4 i0, i1, i2, i3; f32x4 a0, a1, a2, a3;
#define V8_FETCH(tt) do { const u32x4* ip_ = (const u32x4*)(EXP + (size_t)(tt) * 128 + e8 * 16); i0 = ip_[0]; i1 = ip_[1]; i2 = ip_[2]; i3 = ip_[3]; \
            const f32x4* ap_ = (const f32x4*)(AV + (size_t)(tt) * 128 + e8 * 16); a0 = ap_[0]; a1 = ap_[1]; a2 = ap_[2]; a3 = ap_[3]; } while (0)
        if (wi < 16384) V8_FETCH(wi);
        for (int t = wi; t < 16384; t += NWV) {
            const unsigned ids[16] = {i0.x, i0.y, i0.z, i0.w, i1.x, i1.y, i1.z, i1.w, i2.x, i2.y, i2.z, i2.w, i3.x, i3.y, i3.z, i3.w};
            const float av[16] = {a0.x, a0.y, a0.z, a0.w, a1.x, a1.y, a1.z, a1.w, a2.x, a2.y, a2.z, a2.w, a3.x, a3.y, a3.z, a3.w};
            u32x4 vv[16];
#pragma unroll
            for (int i = 0; i < 16; ++i) vv[i] = *(const u32x4*)(Vs + (ids[i] * 128u + (unsigned)c * 16u));
            __builtin_amdgcn_sched_barrier(0);
            if (t + NWV < 16384) V8_FETCH(t + NWV);
            __builtin_amdgcn_sched_barrier(0);
            f32x2v ac2[8];
#pragma unroll
            for (int i = 0; i < 16; ++i) { const f32x2v a2 = {av[i], av[i]}; const unsigned w[4] = {vv[i].x, vv[i].y, vv[i].z, vv[i].w};
#pragma unroll
                for (int q = 0; q < 4; ++q) { const f32x2v lo = __builtin_amdgcn_cvt_pk_f32_fp8((int)w[q], false), hi = __builtin_amdgcn_cvt_pk_f32_fp8((int)w[q], true);
                    ac2[2 * q] = i == 0 ? a2 * lo : __builtin_elementwise_fma(a2, lo, ac2[2 * q]); ac2[2 * q + 1] = i == 0 ? a2 * hi : __builtin_elementwise_fma(a2, hi, ac2[2 * q + 1]); } }
            float acc[16];
#pragma unroll
            for (int e = 0; e < 8; ++e) { acc[2 * e] = ac2[e].x; acc[2 * e + 1] = ac2[e].y; }
            reduce_hi3(acc);
            float ss = (acc[0] * acc[0] + acc[1] * acc[1]) + (acc[2] * acc[2] + acc[3] * acc[3]);
            ss = dpp_sum8(ss);
            { float s2 = ss; swap16(ss, s2); ss += s2; s2 = ss; swap32(ss, s2); ss += s2; }
            if ((e8 & 1) == 0) { const int q4 = 4 * ((e8 >> 1) & 1) + 8 * (e8 >> 2);
                *(unsigned long long*)(Y + (size_t)t * 4096 + s * 128 + c * 16 + q4) = (unsigned long long)cvtpk(acc[0], acc[1]) | ((unsigned long long)cvtpk(acc[2], acc[3]) << 32);
                if (lane == 0) RS[(size_t)t * 64 + s] = ss; }
        }
#undef V8_FETCH
    }
}
}

#ifndef PEER_FP8
#define PEER_FP8 1
#endif
#ifndef MK_N_LAUNCHES
#define MK_N_LAUNCHES 1
#endif
constexpr int N_PHASES = 16;
constexpr int N_LAUNCHES = MK_N_LAUNCHES;
struct Args { const float* in[19]; float* out; unsigned char* ws; int ph_lo, ph_hi; };
#ifndef FP8_SAT
#define FP8_SAT 1
#endif
__global__ void __launch_bounds__(NWAVES * 64, 2) hybrid_fwd(Args args) {
    extern __shared__ __attribute__((aligned(16))) unsigned char lds[];
#if FP8_SAT
    asm volatile("s_setreg_imm32_b32 hwreg(HW_REG_MODE, 23, 1), 1");
#endif
    Frame F;
    F.lds = (LAS unsigned char*)lds;
    F.MISC = (volatile LAS unsigned*)(F.lds + MISC_OFF);
    F.tid = threadIdx.x; F.lane = F.tid & 63; F.wave = __builtin_amdgcn_readfirstlane(F.tid >> 6);
    F.G = gridDim.x; { const int bx = blockIdx.x; F.vcu = (F.G % 8 == 0) ? (bx % 8) * (F.G / 8) + bx / 8 : bx; }
    F.ctl = (gu32*)(args.ws + WS_CTL);
    for (int u = F.tid; u < (LDS_BYTES - LDSCTL_OFF) / 4; u += NWAVES * 64) ((LAS unsigned*)(F.lds + LDSCTL_OFF))[u] = 0u;
    __syncthreads();
    XcdBarrier bar; bar.bar = (unsigned*)(F.ctl + CW_BAR); bar.x = 0; bar.st = nullptr;
    if (N_LAUNCHES == 1) bar = xcd_barrier_post((unsigned*)(F.ctl + CW_BAR), F.MISC + 8);
    unsigned* const cen = (unsigned*)(F.ctl + CW_CEN) + (N_LAUNCHES == 1 ? 0 : args.ph_lo * 1024);
    peer::census_post(cen, F.MISC + 16);
#define GRID_BAR() do { if (N_LAUNCHES == 1) xcd_barrier(bar); } while (0)
#ifdef PROBE_A
    unsigned long long* stamps = (unsigned long long*)(args.ws + WS_ADA + 512 * 1024);
#define STAMP(k) do { if (blockIdx.x == 0 && F.tid == 0) stamps[k] = rt(); } while (0)
#else
#define STAMP(k) do { } while (0)
#endif
    STAMP(0);
    const int lo = args.ph_lo, hi = args.ph_hi;
#ifdef ONLY_PHASE
#define PH_ON(k) ((k) == ONLY_PHASE)
#else
#define PH_ON(k) true
#endif
#define IN(k) (PH_ON(k) && lo <= (k) && (k) < hi)
#ifndef REPEAT_PHASE
#define REPEAT_PHASE -1
#endif
#define REPS(k) for (int rep_ = 0; rep_ < ((k) == REPEAT_PHASE ? 2 : 1); ++rep_)
#define BOTH(k) (IN(k) && IN((k) + 1))
    typedef const __attribute__((address_space(4))) Args* kargs_t;
    const kargs_t kap0 = (kargs_t)__builtin_amdgcn_kernarg_segment_ptr();
#define INP(i) ({ kargs_t p_ = kap0; asm volatile("" : "+s"(p_)); p_->in[i]; })
#define OUTP() ({ kargs_t p_ = kap0; asm volatile("" : "+s"(p_)); p_->out; })
#define WSP() ({ kargs_t p_ = kap0; asm volatile("" : "+s"(p_)); p_->ws; })

    if (IN(0)) { unsigned char* ws = WSP(); REPS(0) p0_prologue(F, INP(1), INP(2), INP(6), INP(8), INP(10), INP(12), INP(15), INP(16), ws); if (BOTH(0)) GRID_BAR(); STAMP(1); }
    if (IN(1)) { unsigned char* ws = WSP(); REPS(1) p1_ada_reduce(F, INP(3), ws); if (BOTH(1)) GRID_BAR(); STAMP(2); }
    if (IN(2)) { unsigned char* ws = WSP(); REPS(2) p2_modnorm(F, INP(0), INP(4), ws); if (BOTH(2)) GRID_BAR(); STAMP(3); }
    if (IN(3)) {
        unsigned char* ws = WSP();
        pg8::Gemm8 g{ws + WS_H, ws + WS_WIN, M, NZ, DM}; pg8::StaticOrder S; S.init(M, NZ, F.G, (int)blockIdx.x);
        pg8::EpiZ E{(bf16*)(ws + WS_ZQ), (bf16*)(ws + WS_ZSQ), (bf16*)(ws + WS_ZA), (bf16*)(ws + WS_ZB), (bf16*)(ws + WS_ZSK), (bf16*)(ws + WS_ZSV), (bf16*)(ws + WS_ZKV), 0.125f * LOG2E, 1.f / (H_SCALE * WIN_SCALE)};
        REPS(3) { pg8::gemm_phase8<pg8::EpiZ, pg8::StaticOrder, true, true>(F.lds + RING_OFF, g, S, E); __syncthreads(); }
        if (BOTH(3)) GRID_BAR(); STAMP(4);
    }
    if (IN(4)) { unsigned char* ws = WSP(); REPS(4) p4_latent(F, INP(7), INP(9), ws); if (BOTH(4)) GRID_BAR(); STAMP(5); }
    if (IN(5)) {
        unsigned char* ws = WSP();
        if (P5_FP8) {
#ifndef P5_SKIP_Q
          { pg8::Gemm8 g{ws + WS_ZQN, ws + WS_WQB, M, 6144, 1024}; pg8::StaticOrder S; S.init(M, 6144, F.G, (int)blockIdx.x);
            pg8::EpiQ E{(bf16*)(ws + WS_QN), (bf16*)(ws + WS_QP), (const float*)(ws + WS_ROPE), (const float*)(ws + WS_ROPE) + SEQ * 32, 1.f / (LAT_SCALE * WQB_SCALE), MLA_FP8QK ? QK8_SCALE : 0.f};
            pg8::gemm_phase8<pg8::EpiQ, pg8::StaticOrder, true, true>(F.lds + RING_OFF, g, S, E); }
#endif
          __syncthreads();
#ifndef P5_SKIP_KV
          if (MLA_FP8PV) {
            { pg8::Gemm8 g{ws + WS_CKV, ws + WS_WKVB, M, 4096, 512}; pg8::StaticOrder S; S.init(M, 4096, F.G, (int)blockIdx.x);
              pg8::EpiKV E{(bf16*)(ws + WS_KN), (bf16*)(ws + WS_VM), 1.f / (LAT_SCALE * WKVB_SCALE), QK8_SCALE};
              pg8::gemm_phase8<pg8::EpiKV, pg8::StaticOrder, true, true>(F.lds + RING_OFF, g, S, E); }
            __syncthreads();
            { pg8::Gemm8 g{ws + WS_WKVB + (size_t)4096 * 512, ws + WS_CKV, 4096, M, 512}; pg8::StaticOrder S; S.init(4096, M, F.G, (int)blockIdx.x);
              pg8::EpiVT E{ws + WS_VM, V8_SCALE / (LAT_SCALE * WKVB_SCALE)};
              pg8::gemm_phase8<pg8::EpiVT, pg8::StaticOrder, true, true>(F.lds + RING_OFF, g, S, E); }
          } else
          { pg8::Gemm8 g{ws + WS_CKV, ws + WS_WKVB, M, 8192, 512}; pg8::StaticOrder S; S.init(M, 8192, F.G, (int)blockIdx.x);
            pg8::EpiKV E{(bf16*)(ws + WS_KN), (bf16*)(ws + WS_VM), 1.f / (LAT_SCALE * WKVB_SCALE), MLA_FP8QK ? QK8_SCALE : 0.f};
            pg8::gemm_phase8<pg8::EpiKV, pg8::StaticOrder, true, true>(F.lds + RING_OFF, g, S, E); }
#endif
        } else {
          { pg8::Gemm g{(const bf16*)(ws + WS_ZQN), (const bf16*)(ws + WS_WQB), M, 6144, 1024}; pg8::StaticOrder S; S.init(M, 6144, F.G, (int)blockIdx.x);
            pg8::EpiQ E{(bf16*)(ws + WS_QN), (bf16*)(ws + WS_QP), (const float*)(ws + WS_ROPE), (const float*)(ws + WS_ROPE) + SEQ * 32, 1.f, MLA_FP8QK ? QK8_SCALE : 0.f};
            pg8::gemm_phase<pg8::EpiQ, pg8::StaticOrder, true, true>(F.lds + RING_OFF, g, S, E); }
          __syncthreads();
          { pg8::Gemm g{(const bf16*)(ws + WS_CKV), (const bf16*)(ws + WS_WKVB), M, 8192, 512}; pg8::StaticOrder S; S.init(M, 8192, F.G, (int)blockIdx.x);
            pg8::EpiKV E{(bf16*)(ws + WS_KN), (bf16*)(ws + WS_VM), 1.f, MLA_FP8QK ? QK8_SCALE : 0.f};
            pg8::gemm_phase<pg8::EpiKV, pg8::StaticOrder, true, true>(F.lds + RING_OFF, g, S, E); }
        }
        if (BOTH(5)) GRID_BAR(); STAMP(6);
    }
    if (IN(6)) {
        unsigned char* ws = WSP();
        REPS(6) { mla::mla_phase((char*)lds + RING_OFF, F.vcu, F.G, ws); __syncthreads(); }
        if (BOTH(6)) GRID_BAR(); STAMP(7);
    }
    if (IN(7)) {
        unsigned char* ws = WSP(); const float* sinks = INP(11); const float* peer_u = INP(17); const float* peer_v = INP(18);
        REPS(7) swa::swa_phase<WOUT_FP8 != 0>(MIX_SCALE, (char*)lds + RING_OFF, F.vcu, F.G, (const bf16*)(ws + WS_ZSQ), (const bf16*)(ws + WS_ZSK), (const bf16*)(ws + WS_ZSV), sinks,
                       (const bf16*)(ws + WS_OA), (const bf16*)(ws + WS_ZA), (const bf16*)(ws + WS_ZB), (bf16*)(ws + WS_H),
                       PEER_FP8 ? peer_u : nullptr, peer_v, ws + WS_UB, ws + WS_VB, peer::U_SCALE, peer::V_SCALE);
        if (!PEER_FP8) { REPS(16) convert_slices(F, peer_u, (bf16*)(ws + WS_UB)); REPS(16) convert_slices(F, peer_v, (bf16*)(ws + WS_VB)); }
        if (BOTH(7)) GRID_BAR(); STAMP(8);
    }
    if (IN(8)) {
        unsigned char* ws = WSP();
        if (WOUT_FP8) { pg8::Gemm8 g{ws + WS_H, ws + WS_WOUT, M, DM, DM}; pg8::StaticOrder S; S.init(M, DM, F.G, (int)blockIdx.x);
            pg8::EpiT E{(bf16*)(ws + WS_T), (float*)(ws + WS_RSQ), 1.f / (MIX_SCALE * WOUT_SCALE)};
            REPS(8) { pg8::gemm_phase8<pg8::EpiT, pg8::StaticOrder, true, true>(F.lds + RING_OFF, g, S, E); __syncthreads(); } }
        else { pg8::Gemm g{(const bf16*)(ws + WS_H), (const bf16*)(ws + WS_WOUT), M, DM, DM}; pg8::StaticOrder S; S.init(M, DM, F.G, (int)blockIdx.x);
            pg8::EpiT E{(bf16*)(ws + WS_T), (float*)(ws + WS_RSQ), 1.f};
            REPS(8) { pg8::gemm_phase<pg8::EpiT, pg8::StaticOrder, true, true>(F.lds + RING_OFF, g, S, E); __syncthreads(); } }
        if (BOTH(8)) GRID_BAR(); STAMP(9);
    }
    if (IN(9)) { unsigned char* ws = WSP(); REPS(9) p9_post_attn(F, INP(0), INP(5), INP(13), OUTP(), ws); if (BOTH(9)) GRID_BAR(); STAMP(10); }
    if (IN(10)) {
        unsigned char* ws = WSP();
        pg8::Gemm g{(const bf16*)(ws + WS_H), (const bf16*)(ws + WS_WPQ), M, 2048, DM}; pg8::StaticOrder S; S.init(M, 2048, F.G, (int)blockIdx.x);
        pg8::EpiBf16<0> E{(bf16*)(ws + WS_PQ), 2048, nullptr, 0, 0, 1.f};
        REPS(10) { pg8::gemm_phase<pg8::EpiBf16<0>, pg8::StaticOrder, true, true>(F.lds + RING_OFF, g, S, E); __syncthreads(); }
        if (BOTH(10)) GRID_BAR(); STAMP(11);
    }
    if (IN(11)) {
        unsigned char* ws = WSP();
        REPS(11) peer::peer_topk(F.vcu, F.G, (const bf16*)(ws + WS_PQ), (const bf16*)(ws + WS_SUBK), (int*)(ws + WS_EXP), (float*)(ws + WS_GATE));
        if (BOTH(11)) GRID_BAR(); STAMP(12);
    }
    if (IN(12)) {
        unsigned char* ws = WSP(); const peer::Census cz = peer::census_complete(cen, F.MISC + 16);
        if (PEER_FP8) { REPS(12) peer::peer_u8(cz, (const bf16*)(ws + WS_H), ws + WS_UB, (const int*)(ws + WS_EXP), (float*)(ws + WS_PX)); }
        else { REPS(12) peer::peer_u(cz, (const bf16*)(ws + WS_H), (const bf16*)(ws + WS_UB), (const int*)(ws + WS_EXP), (float*)(ws + WS_PX)); }
        if (BOTH(12)) GRID_BAR(); STAMP(13);
    }
    if (IN(13)) {
        unsigned char* ws = WSP(); const peer::Census cz = peer::census_complete(cen, F.MISC + 16);
        peer::peer_act(cz.nx, (const float*)(ws + WS_PX), (const float*)(ws + WS_GATE), (float*)(ws + WS_AV), PEER_FP8 ? 1.f / peer::U_SCALE : 1.f, PEER_FP8 ? 1.f / peer::V_SCALE : 1.f);
        if (BOTH(13)) GRID_BAR(); STAMP(14);
    }
    if (IN(14)) {
        unsigned char* ws = WSP(); const peer::Census cz = peer::census_complete(cen, F.MISC + 16);
        if (PEER_FP8) { REPS(14) peer::peer_v8(cz, ws + WS_VB, (const int*)(ws + WS_EXP), (const float*)(ws + WS_AV), (bf16*)(ws + WS_Y), (float*)(ws + WS_RS)); }
        else { REPS(14) peer::peer_v(cz, (const bf16*)(ws + WS_VB), (const int*)(ws + WS_EXP), (const float*)(ws + WS_AV), (bf16*)(ws + WS_Y), (float*)(ws + WS_RS)); }
        if (BOTH(14)) GRID_BAR(); STAMP(15);
    }
    if (IN(15)) {
        unsigned char* ws = WSP();
        peer::peer_final(F.lds + RING_OFF, F.vcu, F.G, INP(0), (const bf16*)(ws + WS_T), (const float*)(ws + WS_RSQ), (const bf16*)(ws + WS_Y), (const float*)(ws + WS_RS), PEER_FP8 ? 32 : 64, (const float*)(ws + WS_ADA), INP(5), INP(14), OUTP());
    }
#undef IN
#undef BOTH
#undef GRID_BAR
}

extern "C" void kernel_launch(void* const* d_in, const int* in_sizes, int n_in, void* d_out, int out_size, void* d_ws, size_t ws_size, hipStream_t stream) {
    static int grid = 0;
    if (grid == 0) {
        if (n_in != 19 || out_size != M * DM || ws_size < WS_END) { fprintf(stderr, "kernel_launch: unexpected shapes (n_in %d out %d ws %zu)\n", n_in, out_size, ws_size); grid = -1; return; }
        int dev = 0, cus = 0, per_cu = 0;
        if (hipGetDevice(&dev) != hipSuccess || hipDeviceGetAttribute(&cus, hipDeviceAttributeMultiprocessorCount, dev) != hipSuccess) { grid = -1; return; }
        if (hipFuncSetAttribute((const void*)hybrid_fwd, hipFuncAttributeMaxDynamicSharedMemorySize, LDS_BYTES) != hipSuccess) { fprintf(stderr, "kernel_launch: hipFuncSetAttribute failed\n"); grid = -1; return; }
        if (hipOccupancyMaxActiveBlocksPerMultiprocessor(&per_cu, (const void*)hybrid_fwd, NWAVES * 64, LDS_BYTES) != hipSuccess || per_cu < 1)
            fprintf(stderr, "kernel_launch: note: occupancy query reports %d workgroups per CU\n", per_cu);
        (void)hipGetLastError();
        grid = cus;
    }
    if (grid < 0) return;
    if (hipMemsetAsync((char*)d_ws + WS_CTL, 0, CTL_ZERO_BYTES, stream) != hipSuccess) return;
    Args a{};
    for (int i = 0; i < 19; ++i) a.in[i] = (const float*)d_in[i];
    a.out = (float*)d_out; a.ws = (unsigned char*)d_ws;
    if (N_LAUNCHES == 1) { a.ph_lo = 0; a.ph_hi = N_PHASES; hipLaunchKernelGGL(hybrid_fwd, dim3(grid), dim3(NWAVES * 64), LDS_BYTES, stream, a); }
    else { for (int p = 0; p < N_PHASES; ++p) { a.ph_lo = p; a.ph_hi = p + 1; hipLaunchKernelGGL(hybrid_fwd, dim3(grid), dim3(NWAVES * 64), LDS_BYTES, stream, a); } }
}
```

```cpp
#include <hip/hip_runtime.h>
#include <cstdio>
#include <cstdint>
#include <cmath>
namespace pg8 {
#define PG8_LAS __attribute__((address_space(3)))
typedef unsigned short bf16_t;
typedef short bf16x8 __attribute__((ext_vector_type(8)));
typedef float f32x4 __attribute__((ext_vector_type(4)));
typedef unsigned u32x4 __attribute__((ext_vector_type(4)));
constexpr int BM = 256, BK = 64, HALF = 128, HTB = HALF * BK * 2  , STAGE_BYTES = 8 * HTB, NXCD = 8, WGM = 8;

__host__ __device__ __forceinline__ int lds_byte(int r, int c) { const int st = (r >> 4) * 2 + (c >> 5), rr = r & 15, cc = c & 31, ob = rr * 64 + cc * 2; return st * 1024 + (ob ^ (((ob >> 9) & 1) << 5)); }
__host__ __device__ __forceinline__ void stage_rc(int b, int& R, int& C) { const int st = b / 1024, sb = b % 1024, swz = sb ^ (((sb >> 9) & 1) << 5); R = (st >> 1) * 16 + swz / 64; C = (st & 1) * 32 + (swz % 64) / 2; }
__host__ __device__ __forceinline__ int perm32(int rho) { const int n = rho >> 4, i = rho & 15; return 8 * (i >> 2) + 4 * n + (i & 3); }

struct Unit { int pm, pn; };
struct Gemm { const bf16_t* A; const bf16_t* Bt; int M, N, K; };

struct StaticOrder {
    int nM, nN, nwg, G, c;
    __host__ __device__ void init(int M, int N, int G_, int c_) { nM = M / BM; nN = N / BM; nwg = nM * nN; G = G_; c = c_; }
    __host__ __device__ bool next(int i, Unit& u) const {
        const long L = (long)i * G + c; if (L >= nwg) return false;
        int wgid = (int)L; { const int q = nwg / NXCD, r = nwg % NXCD, xcd = wgid % NXCD, off = wgid / NXCD; wgid = (xcd < r ? xcd * (q + 1) : r * (q + 1) + (xcd - r) * q) + off; }
        const int nig = WGM * nN, gid = wgid / nig, fm = gid * WGM, gsz = (nM - fm) < WGM ? (nM - fm) : WGM;
        u.pm = fm + ((wgid % nig) % gsz); u.pn = (wgid % nig) / gsz; return true;
    }
    __device__ __forceinline__ void a_ready(const Unit&) const {}
    __device__ __forceinline__ void done(const Unit&) const {}
};

__device__ __forceinline__ unsigned cvt_pk_bf16(float lo, float hi) { unsigned r; asm volatile("v_cvt_pk_bf16_f32 %0, %1, %2" : "=v"(r) : "v"(lo), "v"(hi)); return r; }
typedef float f32x2 __attribute__((ext_vector_type(2)));
__device__ __forceinline__ f32x2 gelu_pk(f32x2 v) {
    const f32x2 av = __builtin_elementwise_abs(v), d = av * 0.2316418882f + 1.0f;
    f32x2 t; t.x = __builtin_amdgcn_rcpf(d.x); t.y = __builtin_amdgcn_rcpf(d.y);
    f32x2 q = t * 0.5307027145f + (-0.7265760135f); q = q * t + 0.7107068705f; q = q * t + (-0.142248368f); q = q * t + 0.127414796f; q = q * t;
    const f32x2 s = (v * v) * (-0.72134752044f);
    f32x2 e; e.x = __builtin_amdgcn_exp2f(s.x); e.y = __builtin_amdgcn_exp2f(s.y);
    const f32x2 m = v * (q * e), r = v - m;
    f32x2 o; o.x = v.x < 0.f ? m.x : r.x; o.y = v.y < 0.f ? m.y : r.y; return o;
}

template <int ACT  > struct EpiBf16 {
    static constexpr bool PERM = true, AFTER_DRAIN = false; static_assert(ACT == 0 || ACT == 1, "EpiBf16: ACT is 0 (none) or 1 (gelu_pk)");
    bf16_t* O; int ldc; const float* bias; int split_cols; size_t split_stride; float scale0;
    __device__ __forceinline__ void operator()(const f32x4 (&acc)[2][2][4][2], const Unit& u, int wr, int wc, int fr, int fq) const {
        const int row0 = u.pm * BM + wr * 64 + fr; int colt = u.pn * BM; bf16_t* base = O;
        float sc = 1.f; if (split_cols) { const int t = colt / split_cols; base += (size_t)t * split_stride; colt -= t * split_cols; if (t == 0) sc = scale0; }
        const int col0 = colt + wc * 32 + 8 * fq, bcol0 = u.pn * BM + wc * 32 + 8 * fq;
        f32x4 bv[2][2];
#pragma unroll
        for (int bj = 0; bj < 2; ++bj)
#pragma unroll
            for (int n = 0; n < 2; ++n) bv[bj][n] = bias ? *(const f32x4*)(bias + bcol0 + bj * HALF + 4 * n) : (f32x4){0.f, 0.f, 0.f, 0.f};
#pragma unroll
        for (int ai = 0; ai < 2; ++ai)
#pragma unroll
            for (int m = 0; m < 4; ++m) { bf16_t* rowp = base + (size_t)(row0 + ai * HALF + m * 16) * ldc + col0;
#pragma unroll
                for (int bj = 0; bj < 2; ++bj) { f32x4 v0 = acc[ai][bj][m][0] + bv[bj][0], v1 = acc[ai][bj][m][1] + bv[bj][1];
                    if (ACT == 1) { f32x2 a = gelu_pk((f32x2){v0[0], v0[1]}), b = gelu_pk((f32x2){v0[2], v0[3]}), c = gelu_pk((f32x2){v1[0], v1[1]}), d = gelu_pk((f32x2){v1[2], v1[3]});
                        v0 = (f32x4){a.x, a.y, b.x, b.y}; v1 = (f32x4){c.x, c.y, d.x, d.y}; }
                    v0 = v0 * sc; v1 = v1 * sc; u32x4 w; w.x = cvt_pk_bf16(v0[0], v0[1]); w.y = cvt_pk_bf16(v0[2], v0[3]); w.z = cvt_pk_bf16(v1[0], v1[1]); w.w = cvt_pk_bf16(v1[2], v1[3]);
                    *(u32x4*)(rowp + bj * HALF) = w; } }
    }
};
#ifndef GATE_FP8
#define GATE_FP8 1
#endif
constexpr float GATE_SCALE = 8.f;
struct EpiZ {
    static constexpr bool PERM = true, AFTER_DRAIN = false;
    bf16_t *zq, *zsq, *za, *zb, *zsk, *zsv, *zkv; float sq_scale, oscale;
    __device__ __forceinline__ void operator()(const f32x4 (&acc)[2][2][4][2], const Unit& u, int wr, int wc, int fr, int fq) const {
        const int pn = u.pn; bf16_t* base; int ld, ct; float sc = oscale; const bool gate8 = GATE_FP8 && pn >= 20 && pn < 52;
        if (pn < 4) { base = zq; ld = 1024; ct = pn; }
        else if (pn < 20) { base = zsq; ld = 4096; ct = pn - 4; sc = sq_scale * oscale; }
        else if (pn < 36) { base = za; ld = 4096; ct = pn - 20; }
        else if (pn < 52) { base = zb; ld = 4096; ct = pn - 36; }
        else if (pn < 54) { base = zsk; ld = 512; ct = pn - 52; }
        else if (pn < 56) { base = zsv; ld = 512; ct = pn - 54; }
        else { base = zkv; ld = 768; ct = pn - 56; }
        const int row0 = u.pm * BM + wr * 64 + fr, col0 = ct * BM + wc * 32 + 8 * fq;
#pragma unroll
        for (int ai = 0; ai < 2; ++ai)
#pragma unroll
            for (int m = 0; m < 4; ++m) { bf16_t* rowp = base + (size_t)(row0 + ai * HALF + m * 16) * ld + col0;
#pragma unroll
                for (int bj = 0; bj < 2; ++bj) { const f32x4 v0 = acc[ai][bj][m][0] * sc, v1 = acc[ai][bj][m][1] * sc;
                    if (gate8) {
                        int t0 = __builtin_amdgcn_cvt_pk_fp8_f32(v0[0] * GATE_SCALE, v0[1] * GATE_SCALE, 0, false); t0 = __builtin_amdgcn_cvt_pk_fp8_f32(v0[2] * GATE_SCALE, v0[3] * GATE_SCALE, t0, true);
                        int t1 = __builtin_amdgcn_cvt_pk_fp8_f32(v1[0] * GATE_SCALE, v1[1] * GATE_SCALE, 0, false); t1 = __builtin_amdgcn_cvt_pk_fp8_f32(v1[2] * GATE_SCALE, v1[3] * GATE_SCALE, t1, true);
                        *(unsigned long long*)((unsigned char*)base + (size_t)(row0 + ai * HALF + m * 16) * ld + col0 + bj * HALF) = (unsigned long long)(unsigned)t0 | ((unsigned long long)(unsigned)t1 << 32); }
                    else {
                    u32x4 w; w.x = cvt_pk_bf16(v0[0], v0[1]); w.y = cvt_pk_bf16(v0[2], v0[3]); w.z = cvt_pk_bf16(v1[0], v1[1]); w.w = cvt_pk_bf16(v1[2], v1[3]);
                    *(u32x4*)(rowp + bj * HALF) = w; } } }
    }
};
struct EpiQ {
    static constexpr bool PERM = true, AFTER_DRAIN = false;
    bf16_t *qn, *qp; const float* rc; const float* rs; float oscale; float q8;
    __device__ __forceinline__ void operator()(const f32x4 (&acc)[2][2][4][2], const Unit& u, int wr, int wc, int fr, int fq) const {
        const int pn = u.pn; const bool rope = pn >= 16;
        bf16_t* base = rope ? qp : qn; const int ld = rope ? 2048 : 4096, ct = rope ? pn - 16 : pn;
        const int row0 = u.pm * BM + wr * 64 + fr, col0 = ct * BM + wc * 32 + 8 * fq;
#pragma unroll
        for (int ai = 0; ai < 2; ++ai)
#pragma unroll
            for (int m = 0; m < 4; ++m) { const int row = row0 + ai * HALF + m * 16; bf16_t* rowp = base + (size_t)row * ld + col0;
#pragma unroll
                for (int bj = 0; bj < 2; ++bj) { f32x4 v0 = acc[ai][bj][m][0] * oscale, v1 = acc[ai][bj][m][1] * oscale;
                    if (rope) { const int i0 = ((col0 + bj * HALF) & 63) >> 1; const int pos = row & 8191;
                        const f32x4 c = *(const f32x4*)(rc + pos * 32 + i0), s = *(const f32x4*)(rs + pos * 32 + i0);
                        const f32x4 a = v0, b = v1;
                        v0[0] = a[0] * c[0] - a[1] * s[0]; v0[1] = a[1] * c[0] + a[0] * s[0]; v0[2] = a[2] * c[1] - a[3] * s[1]; v0[3] = a[3] * c[1] + a[2] * s[1];
                        v1[0] = b[0] * c[2] - b[1] * s[2]; v1[1] = b[1] * c[2] + b[0] * s[2]; v1[2] = b[2] * c[3] - b[3] * s[3]; v1[3] = b[3] * c[3] + b[2] * s[3]; }
                    if (q8 > 0.f) { int t0 = __builtin_amdgcn_cvt_pk_fp8_f32(v0[0] * q8, v0[1] * q8, 0, false); t0 = __builtin_amdgcn_cvt_pk_fp8_f32(v0[2] * q8, v0[3] * q8, t0, true);
                        int t1 = __builtin_amdgcn_cvt_pk_fp8_f32(v1[0] * q8, v1[1] * q8, 0, false); t1 = __builtin_amdgcn_cvt_pk_fp8_f32(v1[2] * q8, v1[3] * q8, t1, true);
                        *(unsigned long long*)((unsigned char*)base + (size_t)row * ld + col0 + bj * HALF) = (unsigned long long)(unsigned)t0 | ((unsigned long long)(unsigned)t1 << 32); }
                    else { u32x4 w; w.x = cvt_pk_bf16(v0[0], v0[1]); w.y = cvt_pk_bf16(v0[2], v0[3]); w.z = cvt_pk_bf16(v1[0], v1[1]); w.w = cvt_pk_bf16(v1[2], v1[3]);
                    *(u32x4*)(rowp + bj * HALF) = w; } } }
    }
};
struct EpiT {
    static constexpr bool PERM = true, AFTER_DRAIN = false;
    bf16_t* T; float* rsq; float oscale;
    __device__ __forceinline__ void operator()(const f32x4 (&acc)[2][2][4][2], const Unit& u, int wr, int wc, int fr, int fq) const {
        const int row0 = u.pm * BM + wr * 64 + fr, col0 = u.pn * BM + wc * 32 + 8 * fq;
#pragma unroll
        for (int ai = 0; ai < 2; ++ai)
#pragma unroll
            for (int m = 0; m < 4; ++m) { const int row = row0 + ai * HALF + m * 16; bf16_t* rowp = T + (size_t)row * 4096 + col0; float s = 0.f;
#pragma unroll
                for (int bj = 0; bj < 2; ++bj) { const f32x4 v0 = acc[ai][bj][m][0] * oscale, v1 = acc[ai][bj][m][1] * oscale;
                    s += (v0[0] * v0[0] + v0[1] * v0[1]) + (v0[2] * v0[2] + v0[3] * v0[3]) + (v1[0] * v1[0] + v1[1] * v1[1]) + (v1[2] * v1[2] + v1[3] * v1[3]);
                    u32x4 w; w.x = cvt_pk_bf16(v0[0], v0[1]); w.y = cvt_pk_bf16(v0[2], v0[3]); w.z = cvt_pk_bf16(v1[0], v1[1]); w.w = cvt_pk_bf16(v1[2], v1[3]);
                    *(u32x4*)(rowp + bj * HALF) = w; }
                s += __shfl_xor(s, 16); s += __shfl_xor(s, 32);
                if (fq == 0) rsq[(size_t)row * 64 + u.pn * 4 + wc] = s; }
    }
};
struct EpiKV {
    static constexpr bool PERM = true, AFTER_DRAIN = false;
    bf16_t *kn, *vm; float oscale; float k8;
    __device__ __forceinline__ void operator()(const f32x4 (&acc)[2][2][4][2], const Unit& u, int wr, int wc, int fr, int fq) const {
        const int pn = u.pn; bf16_t* base = pn < 16 ? kn : vm; const int ct = pn & 15; const bool f8 = pn < 16 && k8 > 0.f;
        const int row0 = u.pm * BM + wr * 64 + fr, col0 = ct * BM + wc * 32 + 8 * fq;
#pragma unroll
        for (int ai = 0; ai < 2; ++ai)
#pragma unroll
            for (int m = 0; m < 4; ++m) { bf16_t* rowp = base + (size_t)(row0 + ai * HALF + m * 16) * 4096 + col0;
#pragma unroll
                for (int bj = 0; bj < 2; ++bj) { const f32x4 v0 = acc[ai][bj][m][0] * oscale, v1 = acc[ai][bj][m][1] * oscale;
                    if (f8) { int t0 = __builtin_amdgcn_cvt_pk_fp8_f32(v0[0] * k8, v0[1] * k8, 0, false); t0 = __builtin_amdgcn_cvt_pk_fp8_f32(v0[2] * k8, v0[3] * k8, t0, true);
                        int t1 = __builtin_amdgcn_cvt_pk_fp8_f32(v1[0] * k8, v1[1] * k8, 0, false); t1 = __builtin_amdgcn_cvt_pk_fp8_f32(v1[2] * k8, v1[3] * k8, t1, true);
                        *(unsigned long long*)((unsigned char*)base + (size_t)(row0 + ai * HALF + m * 16) * 4096 + col0 + bj * HALF) = (unsigned long long)(unsigned)t0 | ((unsigned long long)(unsigned)t1 << 32); continue; }
                    u32x4 w; w.x = cvt_pk_bf16(v0[0], v0[1]); w.y = cvt_pk_bf16(v0[2], v0[3]); w.z = cvt_pk_bf16(v1[0], v1[1]); w.w = cvt_pk_bf16(v1[2], v1[3]);
                    *(u32x4*)(rowp + bj * HALF) = w; } }
    }
};
struct EpiVT {
    static constexpr bool PERM = true, AFTER_DRAIN = false;
    unsigned char* vt; float oscale;
    __device__ __forceinline__ void operator()(const f32x4 (&acc)[2][2][4][2], const Unit& u, int wr, int wc, int fr, int fq) const {
        const int row0 = u.pm * BM + wr * 64 + fr, col0 = u.pn * BM + wc * 32 + 8 * fq;
#pragma unroll
        for (int ai = 0; ai < 2; ++ai)
#pragma unroll
            for (int m = 0; m < 4; ++m) { unsigned char* rowp = vt + (size_t)(row0 + ai * HALF + m * 16) * 16384 + col0;
#pragma unroll
                for (int bj = 0; bj < 2; ++bj) { const f32x4 v0 = acc[ai][bj][m][0] * oscale, v1 = acc[ai][bj][m][1] * oscale;
                    int t0 = __builtin_amdgcn_cvt_pk_fp8_f32(v0[0], v0[1], 0, false); t0 = __builtin_amdgcn_cvt_pk_fp8_f32(v0[2], v0[3], t0, true);
                    int t1 = __builtin_amdgcn_cvt_pk_fp8_f32(v1[0], v1[1], 0, false); t1 = __builtin_amdgcn_cvt_pk_fp8_f32(v1[2], v1[3], t1, true);
                    *(unsigned long long*)(rowp + bj * HALF) = (unsigned long long)(unsigned)t0 | ((unsigned long long)(unsigned)t1 << 32); } }
    }
};

#ifndef G8_BAL
#define G8_BAL 1
#endif
template <class Epi, class Sched, bool ALIGN_EPI = false, bool SP2 = false>
__device__ __forceinline__ void gemm_phase(PG8_LAS unsigned char* lds, const Gemm g, const Sched& S, const Epi& E) {
    const int tid = threadIdx.x, wid = __builtin_amdgcn_readfirstlane(tid >> 6), lane = tid & 63, wr = wid >> 2, wc = wid & 3, fr = lane & 15, fq = lane >> 4;
    const int K = g.K, nt = K / BK;
    unsigned voffA[2], voffB[2];
#pragma unroll
    for (int i = 0; i < 2; ++i) { int R, C; stage_rc(tid * 16 + i * 8192, R, C); const int Rb = Epi::PERM ? ((R & ~31) + perm32(R & 31)) : R;
        voffA[i] = (unsigned)(R * K + C) * 2u; voffB[i] = (unsigned)(Rb * K + C) * 2u; }
    const size_t kstep = (size_t)(BK * 2);
    const size_t hstep = (size_t)HALF * K * 2;
    const size_t tstep = 2 * hstep;
    const unsigned ldsw = (unsigned)wid * 1024u;
    const int aoff = lds_byte(wr * 64 + fr, fq * 8), boff = lds_byte(wc * 32 + fr, fq * 8);
#define PG8_SA(b, h) (((b) * 2 + (h)) * HTB)
#define PG8_SB(b, h) ((4 + (b) * 2 + (h)) * HTB)
#define PG8_STAGE(bufoff, gbase, voff) do { _Pragma("unroll") for (int _i = 0; _i < 2; ++_i) \
        __builtin_amdgcn_global_load_lds((const unsigned*)((const char*)(gbase) + (voff)[_i]), (PG8_LAS unsigned*)(lds + (bufoff) + ldsw + _i * 8192), 16, 0, 0); } while (0)
#define PG8_LDA(dst, b, h) do { _Pragma("unroll") for (int m = 0; m < 4; ++m) _Pragma("unroll") for (int k = 0; k < 2; ++k) dst[m][k] = *(const PG8_LAS bf16x8*)(lds + PG8_SA(b, h) + aoff + m * 2048 + k * 1024); } while (0)
#define PG8_LDB(dst, b, h) do { _Pragma("unroll") for (int n = 0; n < 2; ++n) _Pragma("unroll") for (int k = 0; k < 2; ++k) dst[n][k] = *(const PG8_LAS bf16x8*)(lds + PG8_SB(b, h) + boff + n * 2048 + k * 1024); } while (0)
#define PG8_MMA(ai, bj, At, Bt) do { __builtin_amdgcn_s_setprio(1); _Pragma("unroll") for (int m = 0; m < 4; ++m) _Pragma("unroll") for (int n = 0; n < 2; ++n) _Pragma("unroll") for (int k = 0; k < 2; ++k) \
        acc[ai][bj][m][n] = __builtin_amdgcn_mfma_f32_16x16x32_bf16(Bt[n][k], At[m][k], acc[ai][bj][m][n], 0, 0, 0); __builtin_amdgcn_s_setprio(0); } while (0)
#define PG8_WAIT_V(n) asm volatile("s_waitcnt vmcnt(" #n ")" ::: "memory")
#define PG8_WAIT_L(n) asm volatile("s_waitcnt lgkmcnt(" #n ")" ::: "memory")
#define PG8_BAR __builtin_amdgcn_s_barrier()
#define PG8_SCHED __builtin_amdgcn_sched_barrier(0)
    Unit cur, nxt; int ui = 0;
    if (!S.next(0, cur)) return;
    f32x4 acc[2][2][4][2];
#pragma unroll
    for (int a = 0; a < 2; ++a)
#pragma unroll
        for (int b = 0; b < 2; ++b)
#pragma unroll
            for (int m = 0; m < 4; ++m)
#pragma unroll
                for (int n = 0; n < 2; ++n) acc[a][b][m][n] = (f32x4){0.f, 0.f, 0.f, 0.f};
    bf16x8 At[4][2], B0[2][2], B1[2][2];
    const char* cA = (const char*)g.A + (size_t)cur.pm * tstep; const char* cB = (const char*)g.Bt + (size_t)cur.pn * tstep;
    S.a_ready(cur);
    if constexpr (SP2) {
        PG8_STAGE(PG8_SB(0, 0), cB, voffB); PG8_STAGE(PG8_SB(0, 1), cB + hstep, voffB); PG8_STAGE(PG8_SA(0, 0), cA, voffA); PG8_STAGE(PG8_SA(0, 1), cA + hstep, voffA);
        if (wr == 1) PG8_BAR;
        PG8_WAIT_V(2); PG8_BAR;
        if (G8_BAL) { PG8_STAGE(PG8_SB(1, 0), cB + kstep, voffB); PG8_STAGE(PG8_SB(1, 1), cB + hstep + kstep, voffB); PG8_WAIT_V(4); PG8_BAR; }
        else {
        PG8_STAGE(PG8_SB(1, 0), cB + kstep, voffB); PG8_STAGE(PG8_SA(1, 0), cA + kstep, voffA); PG8_STAGE(PG8_SB(1, 1), cB + hstep + kstep, voffB);
        PG8_WAIT_V(6); PG8_BAR; }
    } else {
        PG8_STAGE(PG8_SB(0, 0), cB, voffB); PG8_STAGE(PG8_SA(0, 0), cA, voffA); PG8_STAGE(PG8_SB(0, 1), cB + hstep, voffB); PG8_STAGE(PG8_SA(0, 1), cA + hstep, voffA);
        if (wr == 1) PG8_BAR;
        PG8_WAIT_V(4); PG8_BAR;
        PG8_STAGE(PG8_SB(1, 0), cB + kstep, voffB); PG8_STAGE(PG8_SA(1, 0), cA + kstep, voffA); PG8_STAGE(PG8_SB(1, 1), cB + hstep + kstep, voffB);
        PG8_WAIT_V(6); PG8_BAR;
    }
    for (;;) {
        const bool has_next = S.next(ui + 1, nxt);
        const char* nA = has_next ? (const char*)g.A + (size_t)nxt.pm * tstep : cA; const char* nB = has_next ? (const char*)g.Bt + (size_t)nxt.pn * tstep : cB;
        for (int t = 0; t < nt; t += 2) {
            const bool last = (t == nt - 2);
            const char* a1 = cA + (size_t)(t + 1) * kstep;
            const char* a2 = last ? nA : cA + (size_t)(t + 2) * kstep; const char* b2 = last ? nB : cB + (size_t)(t + 2) * kstep;
            const char* a3 = a2 + kstep; const char* b3 = b2 + kstep;
            if (last && has_next) S.a_ready(nxt);
            if constexpr (SP2) {
            if constexpr (G8_BAL != 0) {
            PG8_LDB(B0, 0, 0); PG8_LDB(B1, 0, 1); PG8_SCHED; PG8_LDA(At, 0, 0); PG8_STAGE(PG8_SA(1, 0), a1, voffA); PG8_STAGE(PG8_SA(1, 1), a1 + hstep, voffA);
            PG8_WAIT_V(8); PG8_WAIT_L(0); PG8_BAR; PG8_MMA(0, 0, At, B0); PG8_MMA(0, 1, At, B1); PG8_BAR; PG8_SCHED;
            PG8_LDA(At, 0, 1); PG8_STAGE(PG8_SB(0, 0), b2, voffB); PG8_STAGE(PG8_SB(0, 1), b2 + hstep, voffB);
            PG8_WAIT_V(6); PG8_WAIT_L(0); PG8_BAR; PG8_MMA(1, 0, At, B0); PG8_MMA(1, 1, At, B1); PG8_BAR; PG8_SCHED;
            PG8_LDB(B0, 1, 0); PG8_LDB(B1, 1, 1); PG8_SCHED; PG8_LDA(At, 1, 0); PG8_STAGE(PG8_SA(0, 0), a2, voffA); PG8_STAGE(PG8_SA(0, 1), a2 + hstep, voffA);
            PG8_WAIT_V(8); PG8_WAIT_L(0); PG8_BAR; PG8_MMA(0, 0, At, B0); PG8_MMA(0, 1, At, B1); PG8_BAR; PG8_SCHED;
            PG8_LDA(At, 1, 1); PG8_STAGE(PG8_SB(1, 0), b3, voffB); PG8_STAGE(PG8_SB(1, 1), b3 + hstep, voffB);
            PG8_WAIT_V(6); PG8_WAIT_L(0); PG8_BAR; PG8_MMA(1, 0, At, B0); PG8_MMA(1, 1, At, B1); PG8_BAR; PG8_SCHED;
            } else {
            PG8_LDB(B0, 0, 0); PG8_LDB(B1, 0, 1); PG8_SCHED; PG8_LDA(At, 0, 0); PG8_STAGE(PG8_SA(1, 1), a1 + hstep, voffA);
            PG8_WAIT_V(8); PG8_WAIT_L(0); PG8_BAR; PG8_MMA(0, 0, At, B0); PG8_MMA(0, 1, At, B1); PG8_BAR; PG8_SCHED;
            PG8_LDA(At, 0, 1); PG8_STAGE(PG8_SB(0, 0), b2, voffB); PG8_STAGE(PG8_SB(0, 1), b2 + hstep, voffB); PG8_STAGE(PG8_SA(0, 0), a2, voffA);
            PG8_WAIT_V(8); PG8_WAIT_L(0); PG8_BAR; PG8_MMA(1, 0, At, B0); PG8_MMA(1, 1, At, B1); PG8_BAR; PG8_SCHED;
            PG8_LDB(B0, 1, 0); PG8_LDB(B1, 1, 1); PG8_SCHED; PG8_LDA(At, 1, 0); PG8_STAGE(PG8_SA(0, 1), a2 + hstep, voffA);
            PG8_WAIT_V(8); PG8_WAIT_L(0); PG8_BAR; PG8_MMA(0, 0, At, B0); PG8_MMA(0, 1, At, B1); PG8_BAR; PG8_SCHED;
            PG8_LDA(At, 1, 1); PG8_STAGE(PG8_SB(1, 0), b3, voffB); PG8_STAGE(PG8_SB(1, 1), b3 + hstep, voffB); PG8_STAGE(PG8_SA(1, 0), a3, voffA);
            PG8_WAIT_V(8); PG8_WAIT_L(0); PG8_BAR; PG8_MMA(1, 0, At, B0); PG8_MMA(1, 1, At, B1); PG8_BAR; PG8_SCHED;
            }
            } else {
            PG8_LDB(B0, 0, 0); PG8_SCHED; PG8_LDA(At, 0, 0); PG8_STAGE(PG8_SA(1, 1), a1 + hstep, voffA);
            PG8_WAIT_L(8); PG8_BAR; PG8_WAIT_L(0); PG8_MMA(0, 0, At, B0); PG8_BAR; PG8_SCHED;
            PG8_LDB(B1, 0, 1); PG8_STAGE(PG8_SB(0, 0), b2, voffB);
            PG8_BAR; PG8_WAIT_L(0); PG8_MMA(0, 1, At, B1); PG8_BAR;
            PG8_LDA(At, 0, 1); PG8_STAGE(PG8_SA(0, 0), a2, voffA);
            PG8_BAR; PG8_WAIT_L(0); PG8_MMA(1, 0, At, B0); PG8_BAR; PG8_SCHED;
            PG8_STAGE(PG8_SB(0, 1), b2 + hstep, voffB);
            PG8_WAIT_V(6); PG8_BAR; PG8_MMA(1, 1, At, B1); PG8_BAR;
            PG8_LDB(B0, 1, 0); PG8_SCHED; PG8_LDA(At, 1, 0); PG8_STAGE(PG8_SA(0, 1), a2 + hstep, voffA);
            PG8_WAIT_L(8); PG8_BAR; PG8_WAIT_L(0); PG8_MMA(0, 0, At, B0); PG8_BAR; PG8_SCHED;
            PG8_LDB(B1, 1, 1); PG8_STAGE(PG8_SB(1, 0), b3, voffB);
            PG8_BAR; PG8_WAIT_L(0); PG8_MMA(0, 1, At, B1); PG8_BAR;
            PG8_LDA(At, 1, 1); PG8_STAGE(PG8_SA(1, 0), a3, voffA);
            PG8_BAR; PG8_WAIT_L(0); PG8_MMA(1, 0, At, B0); PG8_BAR; PG8_SCHED;
            PG8_STAGE(PG8_SB(1, 1), b3 + hstep, voffB);
            PG8_WAIT_V(6); PG8_BAR; PG8_MMA(1, 1, At, B1); PG8_BAR;
            }
        }
        if constexpr (ALIGN_EPI) { if (wr == 0) PG8_BAR; }
        if constexpr (!Epi::AFTER_DRAIN) { E(acc, cur, wr, wc, fr, fq); S.done(cur); }
        if (!has_next) break;
#pragma unroll
        for (int a = 0; a < 2; ++a)
#pragma unroll
            for (int b = 0; b < 2; ++b)
#pragma unroll
                for (int m = 0; m < 4; ++m)
#pragma unroll
                    for (int n = 0; n < 2; ++n) acc[a][b][m][n] = (f32x4){0.f, 0.f, 0.f, 0.f};
        cur = nxt; cA = nA; cB = nB; ++ui;
        if constexpr (ALIGN_EPI) { if (wr == 1) PG8_BAR; }
    }
    PG8_WAIT_V(0);
    if constexpr (!ALIGN_EPI) { if (wr == 0) PG8_BAR; }
    PG8_BAR;
    if constexpr (Epi::AFTER_DRAIN) { E.fused(acc, cur, wr, wc, fr, fq, lds, wid, lane); S.done(cur); }
#undef PG8_SA
#undef PG8_SB
#undef PG8_STAGE
#undef PG8_LDA
#undef PG8_LDB
#undef PG8_MMA
#undef PG8_WAIT_V
#undef PG8_WAIT_L
#undef PG8_BAR
#undef PG8_SCHED
}

typedef int v8i __attribute__((ext_vector_type(8)));
struct Gemm8 { const unsigned char* A; const unsigned char* Bt; int M, N, K; };
template <class Epi, class Sched, bool ALIGN_EPI = false, bool SP2 = false>
__device__ __forceinline__ void gemm_phase8(PG8_LAS unsigned char* lds, const Gemm8 g, const Sched& S, const Epi& E) {
    constexpr bool BAL = G8_BAL != 0;
    int tid_ = threadIdx.x; asm volatile("" : "+v"(tid_));
    const int tid = tid_, wid = __builtin_amdgcn_readfirstlane(tid >> 6), lane = tid & 63, wr = wid >> 2, wc = wid & 3, fr = lane & 15, fq = lane >> 4;
    const int K = g.K, nt = K / 128;
    unsigned voffA[2], voffB[2];
#pragma unroll
    for (int i = 0; i < 2; ++i) { int R, C; stage_rc(tid * 16 + i * 8192, R, C); const int Rb = Epi::PERM ? ((R & ~31) + perm32(R & 31)) : R;
        const int Cs = C ^ (((R >> 3) & 1) << 3);
        voffA[i] = (unsigned)(R * K + Cs * 2); voffB[i] = (unsigned)(Rb * K + Cs * 2); }
    const size_t kstep = (size_t)128;
    const size_t hstep = (size_t)HALF * K;
    const size_t tstep = 2 * hstep;
    const unsigned ldsw = (unsigned)wid * 1024u;
    const int hp = (fr >> 3) & 1, aoff = lds_byte(wr * 64 + fr, fq * 16) | (hp << 4), boff = lds_byte(wc * 32 + fr, fq * 16) | (hp << 4);
#define PG8_SA(b, h) (((b) * 2 + (h)) * HTB)
#define PG8_SB(b, h) ((4 + (b) * 2 + (h)) * HTB)
#define PG8_STAGE(bufoff, gbase, voff) do { _Pragma("unroll") for (int _i = 0; _i < 2; ++_i) { unsigned vo_ = (voff)[_i]; asm volatile("" : "+v"(vo_)); \
        __builtin_amdgcn_global_load_lds((const unsigned*)((const char*)(gbase) + vo_), (PG8_LAS unsigned*)(lds + (bufoff) + ldsw + _i * 8192), 16, 0, 0); } } while (0)
#define PG8_LDA(dst, b, h) do { int ah_ = aoff ^ 16; asm volatile("" : "+v"(ah_)); _Pragma("unroll") for (int m = 0; m < 4; ++m) { const u32x4 lo_ = *(const PG8_LAS u32x4*)(lds + PG8_SA(b, h) + aoff + m * 2048), hi_ = *(const PG8_LAS u32x4*)(lds + PG8_SA(b, h) + ah_ + m * 2048); dst[m] = (v8i){(int)lo_.x, (int)lo_.y, (int)lo_.z, (int)lo_.w, (int)hi_.x, (int)hi_.y, (int)hi_.z, (int)hi_.w}; } } while (0)
#define PG8_LDB(dst, b, h) do { int bh_ = boff ^ 16; asm volatile("" : "+v"(bh_)); _Pragma("unroll") for (int n = 0; n < 2; ++n) { const u32x4 lo_ = *(const PG8_LAS u32x4*)(lds + PG8_SB(b, h) + boff + n * 2048), hi_ = *(const PG8_LAS u32x4*)(lds + PG8_SB(b, h) + bh_ + n * 2048); dst[n] = (v8i){(int)lo_.x, (int)lo_.y, (int)lo_.z, (int)lo_.w, (int)hi_.x, (int)hi_.y, (int)hi_.z, (int)hi_.w}; } } while (0)
#define PG8_MMA(ai, bj, At, Bt) do { __builtin_amdgcn_s_setprio(1); _Pragma("unroll") for (int m = 0; m < 4; ++m) _Pragma("unroll") for (int n = 0; n < 2; ++n) \
        acc[ai][bj][m][n] = __builtin_amdgcn_mfma_scale_f32_16x16x128_f8f6f4(Bt[n], At[m], acc[ai][bj][m][n], 0, 0, 0, 0, 0, 0); __builtin_amdgcn_s_setprio(0); } while (0)
#define PG8_WAIT_V(n) asm volatile("s_waitcnt vmcnt(" #n ")" ::: "memory")
#define PG8_WAIT_L(n) asm volatile("s_waitcnt lgkmcnt(" #n ")" ::: "memory")
#define PG8_BAR __builtin_amdgcn_s_barrier()
#define PG8_SCHED __builtin_amdgcn_sched_barrier(0)
    Unit cur, nxt; int ui = 0;
    if (!S.next(0, cur)) return;
    f32x4 acc[2][2][4][2];
#pragma unroll
    for (int a = 0; a < 2; ++a)
#pragma unroll
        for (int b = 0; b < 2; ++b)
#pragma unroll
            for (int m = 0; m < 4; ++m)
#pragma unroll
                for (int n = 0; n < 2; ++n) acc[a][b][m][n] = (f32x4){0.f, 0.f, 0.f, 0.f};
    v8i At[4], B0[2], B1[2];
    const char* cA = (const char*)g.A + (size_t)cur.pm * tstep; const char* cB = (const char*)g.Bt + (size_t)cur.pn * tstep;
    S.a_ready(cur);
    if constexpr (SP2) {
        PG8_STAGE(PG8_SB(0, 0), cB, voffB); PG8_STAGE(PG8_SB(0, 1), cB + hstep, voffB); PG8_STAGE(PG8_SA(0, 0), cA, voffA); PG8_STAGE(PG8_SA(0, 1), cA + hstep, voffA);
        if (wr == 1) PG8_BAR;
        PG8_WAIT_V(2); PG8_BAR;
        if (BAL) { PG8_STAGE(PG8_SB(1, 0), cB + kstep, voffB); PG8_STAGE(PG8_SB(1, 1), cB + hstep + kstep, voffB); PG8_WAIT_V(4); PG8_BAR; }
        else {
        PG8_STAGE(PG8_SB(1, 0), cB + kstep, voffB); PG8_STAGE(PG8_SA(1, 0), cA + kstep, voffA); PG8_STAGE(PG8_SB(1, 1), cB + hstep + kstep, voffB);
        PG8_WAIT_V(6); PG8_BAR; }
    } else {
        PG8_STAGE(PG8_SB(0, 0), cB, voffB); PG8_STAGE(PG8_SA(0, 0), cA, voffA); PG8_STAGE(PG8_SB(0, 1), cB + hstep, voffB); PG8_STAGE(PG8_SA(0, 1), cA + hstep, voffA);
        if (wr == 1) PG8_BAR;
        PG8_WAIT_V(4); PG8_BAR;
        PG8_STAGE(PG8_SB(1, 0), cB + kstep, voffB); PG8_STAGE(PG8_SA(1, 0), cA + kstep, voffA); PG8_STAGE(PG8_SB(1, 1), cB + hstep + kstep, voffB);
        PG8_WAIT_V(6); PG8_BAR;
    }
    for (;;) {
        const bool has_next = S.next(ui + 1, nxt);
        const char* nA = has_next ? (const char*)g.A + (size_t)nxt.pm * tstep : cA; const char* nB = has_next ? (const char*)g.Bt + (size_t)nxt.pn * tstep : cB;
#pragma clang loop unroll(disable)
        for (int t = 0; t < nt; t += 2) {
            const bool last = (t == nt - 2);
            const char* a1 = cA + (size_t)(t + 1) * kstep;
            const char* a2 = last ? nA : cA + (size_t)(t + 2) * kstep; const char* b2 = last ? nB : cB + (size_t)(t + 2) * kstep;
            const char* a3 = a2 + kstep; const char* b3 = b2 + kstep;
            if (last && has_next) S.a_ready(nxt);
            if constexpr (SP2) {
            if constexpr (BAL) {
            PG8_LDB(B0, 0, 0); PG8_LDB(B1, 0, 1); PG8_SCHED; PG8_LDA(At, 0, 0); PG8_STAGE(PG8_SA(1, 0), a1, voffA); PG8_STAGE(PG8_SA(1, 1), a1 + hstep, voffA);
            PG8_WAIT_V(8); PG8_WAIT_L(0); PG8_BAR; PG8_MMA(0, 0, At, B0); PG8_MMA(0, 1, At, B1); PG8_BAR; PG8_SCHED;
            PG8_LDA(At, 0, 1); PG8_STAGE(PG8_SB(0, 0), b2, voffB); PG8_STAGE(PG8_SB(0, 1), b2 + hstep, voffB);
            PG8_WAIT_V(6); PG8_WAIT_L(0); PG8_BAR; PG8_MMA(1, 0, At, B0); PG8_MMA(1, 1, At, B1); PG8_BAR; PG8_SCHED;
            PG8_LDB(B0, 1, 0); PG8_LDB(B1, 1, 1); PG8_SCHED; PG8_LDA(At, 1, 0); PG8_STAGE(PG8_SA(0, 0), a2, voffA); PG8_STAGE(PG8_SA(0, 1), a2 + hstep, voffA);
            PG8_WAIT_V(8); PG8_WAIT_L(0); PG8_BAR; PG8_MMA(0, 0, At, B0); PG8_MMA(0, 1, At, B1); PG8_BAR; PG8_SCHED;
            PG8_LDA(At, 1, 1); PG8_STAGE(PG8_SB(1, 0), b3, voffB); PG8_STAGE(PG8_SB(1, 1), b3 + hstep, voffB);
            PG8_WAIT_V(6); PG8_WAIT_L(0); PG8_BAR; PG8_MMA(1, 0, At, B0); PG8_MMA(1, 1, At, B1); PG8_BAR; PG8_SCHED;
            } else {
            PG8_LDB(B0, 0, 0); PG8_LDB(B1, 0, 1); PG8_SCHED; PG8_LDA(At, 0, 0); PG8_STAGE(PG8_SA(1, 1), a1 + hstep, voffA);
            PG8_WAIT_V(8); PG8_WAIT_L(0); PG8_BAR; PG8_MMA(0, 0, At, B0); PG8_MMA(0, 1, At, B1); PG8_BAR; PG8_SCHED;
            PG8_LDA(At, 0, 1); PG8_STAGE(PG8_SB(0, 0), b2, voffB); PG8_STAGE(PG8_SB(0, 1), b2 + hstep, voffB); PG8_STAGE(PG8_SA(0, 0), a2, voffA);
            PG8_WAIT_V(8); PG8_WAIT_L(0); PG8_BAR; PG8_MMA(1, 0, At, B0); PG8_MMA(1, 1, At, B1); PG8_BAR; PG8_SCHED;
            PG8_LDB(B0, 1, 0); PG8_LDB(B1, 1, 1); PG8_SCHED; PG8_LDA(At, 1, 0); PG8_STAGE(PG8_SA(0, 1), a2 + hstep, voffA);
            PG8_WAIT_V(8); PG8_WAIT_L(0); PG8_BAR; PG8_MMA(0, 0, At, B0); PG8_MMA(0, 1, At, B1); PG8_BAR; PG8_SCHED;
            PG8_LDA(At, 1, 1); PG8_STAGE(PG8_SB(1, 0), b3, voffB); PG8_STAGE(PG8_SB(1, 1), b3 + hstep, voffB); PG8_STAGE(PG8_SA(1, 0), a3, voffA);
            PG8_WAIT_V(8); PG8_WAIT_L(0); PG8_BAR; PG8_MMA(1, 0, At, B0); PG8_MMA(1, 1, At, B1); PG8_BAR; PG8_SCHED;
            }
            } else {
            PG8_LDB(B0, 0, 0); PG8_SCHED; PG8_LDA(At, 0, 0); PG8_STAGE(PG8_SA(1, 1), a1 + hstep, voffA);
            PG8_WAIT_L(8); PG8_BAR; PG8_WAIT_L(0); PG8_MMA(0, 0, At, B0); PG8_BAR; PG8_SCHED;
            PG8_LDB(B1, 0, 1); PG8_STAGE(PG8_SB(0, 0), b2, voffB);
            PG8_BAR; PG8_WAIT_L(0); PG8_MMA(0, 1, At, B1); PG8_BAR;
            PG8_LDA(At, 0, 1); PG8_STAGE(PG8_SA(0, 0), a2, voffA);
            PG8_BAR; PG8_WAIT_L(0); PG8_MMA(1, 0, At, B0); PG8_BAR; PG8_SCHED;
            PG8_STAGE(PG8_SB(0, 1), b2 + hstep, voffB);
            PG8_WAIT_V(6); PG8_BAR; PG8_MMA(1, 1, At, B1); PG8_BAR;
            PG8_LDB(B0, 1, 0); PG8_SCHED; PG8_LDA(At, 1, 0); PG8_STAGE(PG8_SA(0, 1), a2 + hstep, voffA);
            PG8_WAIT_L(8); PG8_BAR; PG8_WAIT_L(0); PG8_MMA(0, 0, At, B0); PG8_BAR; PG8_SCHED;
            PG8_LDB(B1, 1, 1); PG8_STAGE(PG8_SB(1, 0), b3, voffB);
            PG8_BAR; PG8_WAIT_L(0); PG8_MMA(0, 1, At, B1); PG8_BAR;
            PG8_LDA(At, 1, 1); PG8_STAGE(PG8_SA(1, 0), a3, voffA);
            PG8_BAR; PG8_WAIT_L(0); PG8_MMA(1, 0, At, B0); PG8_BAR; PG8_SCHED;
            PG8_STAGE(PG8_SB(1, 1), b3 + hstep, voffB);
            PG8_WAIT_V(6); PG8_BAR; PG8_MMA(1, 1, At, B1); PG8_BAR;
            }
        }
        if constexpr (ALIGN_EPI) { if (wr == 0) PG8_BAR; }
        if constexpr (!Epi::AFTER_DRAIN) { int t2_ = threadIdx.x; asm volatile("" : "+v"(t2_)); const int fr_ = t2_ & 15, fq_ = (t2_ >> 4) & 3; E(acc, cur, wr, wc, fr_, fq_); S.done(cur); }
        if (!has_next) break;
#pragma unroll
        for (int a = 0; a < 2; ++a)
#pragma unroll
            for (int b = 0; b < 2; ++b)
#pragma unroll
                for (int m = 0; m < 4; ++m)
#pragma unroll
                    for (int n = 0; n < 2; ++n) acc[a][b][m][n] = (f32x4){0.f, 0.f, 0.f, 0.f};
        cur = nxt; cA = nA; cB = nB; ++ui;
        if constexpr (ALIGN_EPI) { if (wr == 1) PG8_BAR; }
    }
    PG8_WAIT_V(0);
    if constexpr (!ALIGN_EPI) { if (wr == 0) PG8_BAR; }
    PG8_BAR;
    if constexpr (Epi::AFTER_DRAIN) { E.fused(acc, cur, wr, wc, fr, fq, lds, wid, lane); S.done(cur); }
#undef PG8_SA
#undef PG8_SB
#undef PG8_STAGE
#undef PG8_LDA
#undef PG8_LDB
#undef PG8_MMA
#undef PG8_WAIT_V
#undef PG8_WAIT_L
#undef PG8_BAR
#undef PG8_SCHED
}
}
#define GAS __attribute__((address_space(1)))
#define LAS __attribute__((address_space(3)))
typedef unsigned short bf16;
typedef unsigned v4u __attribute__((ext_vector_type(4)));
typedef float f32x4 __attribute__((ext_vector_type(4)));
typedef short bf16x8 __attribute__((ext_vector_type(8)));
typedef GAS unsigned gu32;
typedef GAS unsigned long long gu64;
#define RLX_AGENT __ATOMIC_RELAXED, __HIP_MEMORY_SCOPE_AGENT
#define LDS_WAIT() asm volatile("s_waitcnt lgkmcnt(0)" ::: "memory")
#define VM_WAIT() asm volatile("s_waitcnt vmcnt(0)" ::: "memory")
__device__ __forceinline__ unsigned long long rt() { return __builtin_amdgcn_s_memrealtime(); }
__device__ __forceinline__ unsigned f2bf(float f) { unsigned u = __builtin_bit_cast(unsigned, f); return (u + 0x7fffu + ((u >> 16) & 1u)) >> 16; }
__device__ __forceinline__ unsigned pk2(float lo, float hi) { return f2bf(lo) | (f2bf(hi) << 16); }

#define XB_TMO      128
#define XB_XCNT(j)  (256  + 64 * (j))
#define XB_XSUB(j)  (1280 + 64 * (j))
#define XB_XGEN(j)  (2304 + 64 * (j))
#define XB_TOP      3328
#define XB_TOPGEN   3392
#define XCD_BAR_WORDS 3456
#define XB_SPIN_CAP (1u << 18)

__device__ __forceinline__ unsigned xb_ld(unsigned* p)              { return __hip_atomic_load(p, __ATOMIC_RELAXED, __HIP_MEMORY_SCOPE_AGENT); }
__device__ __forceinline__ unsigned xb_add(unsigned* p, unsigned v) { return __hip_atomic_fetch_add(p, v, __ATOMIC_RELAXED, __HIP_MEMORY_SCOPE_AGENT); }
__device__ __forceinline__ unsigned xb_xcc_id() { return (unsigned)__builtin_amdgcn_s_getreg((3 << 11) | 20) & 0xFu; }
#define XB_SPIN(cond, bar) do { unsigned _sp = 0; while (cond) { __builtin_amdgcn_s_sleep(1); \
    if ((++_sp & 255u) == 0u) { if (xb_ld(&(bar)[XB_TMO])) break; if (_sp > XB_SPIN_CAP) { atomicAdd(&(bar)[XB_TMO], 1u); break; } } } } while (0)

struct XcdBarrier {
    unsigned* bar; unsigned x;
    volatile LAS unsigned* st;
};

__device__ __forceinline__ XcdBarrier xcd_barrier_post(unsigned* bar, volatile LAS unsigned* st) {
    XcdBarrier b; b.bar = bar; b.x = xb_xcc_id(); b.st = st;
    if (threadIdx.x == 0) (void)xb_add(&bar[XB_XCNT(b.x)], 1u);
    return b;
}
__device__ __forceinline__ void xcd_barrier_complete(unsigned* bar, unsigned x, unsigned& nloc, unsigned& nx) {
    const unsigned G = gridDim.x * gridDim.y * gridDim.z;
    unsigned sum, cnt, mine, sp = 0u;
    for (;;) {
        sum = 0u; cnt = 0u; mine = 0u;
#pragma unroll
        for (unsigned j = 0; j < 16; ++j) { const unsigned c = xb_ld(&bar[XB_XCNT(j)]); sum += c; cnt += (c > 0u) ? 1u : 0u; mine = (j == x) ? c : mine; }
        if (sum == G) break;
        __builtin_amdgcn_s_sleep(1);
        if ((++sp & 255u) == 0u) { if (xb_ld(&bar[XB_TMO])) break; if (sp > XB_SPIN_CAP) { atomicAdd(&bar[XB_TMO], 1u); break; } }
    }
    nloc = mine > 0u ? mine : 1u; nx = cnt > 0u ? cnt : 1u;
}

__device__ __forceinline__ void xcd_barrier(const XcdBarrier& b) {
    asm volatile("s_waitcnt vmcnt(0)" ::: "memory");
    __syncthreads();
    if (threadIdx.x == 0) {
        unsigned* bar = b.bar;
        __builtin_amdgcn_s_waitcnt(0);
        unsigned nloc = b.st[0], nx = b.st[1];
        if (nloc == 0u) { xcd_barrier_complete(bar, b.x, nloc, nx); b.st[0] = nloc; b.st[1] = nx; }
        const unsigned old = xb_add(&bar[XB_XSUB(b.x)], 1u);
        const unsigned gen = old / nloc;
        if (old + 1u == (gen + 1u) * nloc) {
            __builtin_amdgcn_fence(__ATOMIC_RELEASE, "agent");
            asm volatile("s_waitcnt vmcnt(0)" ::: "memory");
            const unsigned og = xb_add(&bar[XB_TOP], 1u);
            const unsigned tg = og / nx;
            if (og + 1u == (tg + 1u) * nx) xb_add(&bar[XB_TOPGEN], 1u);
            else XB_SPIN(xb_ld(&bar[XB_TOPGEN]) == tg, bar);
            __builtin_amdgcn_fence(__ATOMIC_ACQUIRE, "agent");
            xb_add(&bar[XB_XGEN(b.x)], 1u);
            asm volatile("s_waitcnt vmcnt(0)" ::: "memory");
        } else {
            XB_SPIN(xb_ld(&bar[XB_XGEN(b.x)]) == gen, bar);
            __builtin_amdgcn_fence(__ATOMIC_ACQUIRE, "agent");
            asm volatile("s_waitcnt vmcnt(0)" ::: "memory");
        }
    }
    __syncthreads();
}

constexpr int NWAVES = 8;
constexpr int BATCH = 2, SEQ = 8192, DM = 4096, M = BATCH * SEQ;
constexpr int NZ = 15104;
constexpr int NADA = 6 * DM;
constexpr int IN_W = 14912;
constexpr float NORM_EPS = 1e-6f;
constexpr float LOG2E = 1.4426950408889634f;
#ifndef X1_BF16
#define X1_BF16 1
#endif
constexpr float H_SCALE = 16.f, WIN_SCALE = 512.f, MIX_SCALE = 64.f, WOUT_SCALE = 512.f, LAT_SCALE = 16.f, WQB_SCALE = 256.f, WKVB_SCALE = 256.f, QK8_SCALE = 16.f, V8_SCALE = 16.f, P8_SCALE = 256.f;

constexpr size_t MiB = 1u << 20;
constexpr size_t WS_CTL = 0, CTL_ZERO_BYTES = 1 * MiB;
constexpr size_t WS_ADA = 1 * MiB;
constexpr size_t WS_ROPE = 2 * MiB;
constexpr size_t WS_SUBK = 4 * MiB;
constexpr size_t WS_RSQ = 5 * MiB;
constexpr size_t WS_ADAP = 9 * MiB;
constexpr size_t WS_WIN = 22 * MiB;
constexpr size_t WS_WQB = 140 * MiB;
constexpr size_t WS_WKVB = 152 * MiB;
constexpr size_t WS_WOUT = 160 * MiB;
constexpr size_t WS_WPQ = 192 * MiB;
constexpr size_t WS_H = 208 * MiB;
constexpr size_t WS_ZQ = 336 * MiB;
constexpr size_t WS_ZSQ = 368 * MiB;
constexpr size_t WS_ZA = 496 * MiB;
constexpr size_t WS_ZB = 624 * MiB;
constexpr size_t WS_ZSK = 752 * MiB;
constexpr size_t WS_ZSV = 768 * MiB;
constexpr size_t WS_ZKV = 784 * MiB;
constexpr size_t WS_ZQN = 808 * MiB;
constexpr size_t WS_CKV = 840 * MiB;
constexpr size_t WS_KPE = 856 * MiB;
constexpr size_t WS_QN = 860 * MiB;
constexpr size_t WS_QP = 988 * MiB;
constexpr size_t WS_KN = 1052 * MiB;
constexpr size_t WS_VM = 1180 * MiB;
constexpr size_t WS_OA = 1308 * MiB;
constexpr size_t WS_END = 1436 * MiB;
constexpr size_t WS_T = WS_ZSQ;
constexpr size_t WS_PQ = WS_ZA;
constexpr size_t WS_EXP = WS_ZA + 64 * MiB;
constexpr size_t WS_GATE = WS_ZA + 72 * MiB;
constexpr size_t WS_UB = WS_QN;
constexpr size_t WS_VB = WS_KN;
constexpr size_t WS_PX = WS_ZB;
constexpr size_t WS_AV = WS_ZB + 64 * MiB;
constexpr size_t WS_Y = WS_OA;
constexpr size_t WS_X1 = WS_VM;
constexpr size_t WS_RS = WS_ADAP;
constexpr int CW_TMO = 0, CW_CODE = 1;
constexpr int CW_CEN = 8192;
constexpr int CW_BAR = 4096;

constexpr int RING_OFF = 0, RING_BYTES = 131072;
constexpr int LDSCTL_OFF = RING_BYTES, MISC_OFF = LDSCTL_OFF + 320;
constexpr int LDS_BYTES = 147456;


#ifndef MLA_FP8QK
#define MLA_FP8QK 1
#endif
#ifndef MLA_FP8PV
#define MLA_FP8PV 1
#endif
#ifndef P5_FP8
#define P5_FP8 1
#endif
#ifndef WOUT_FP8
#define WOUT_FP8 1
#endif
typedef __bf16 bf16x2_t __attribute__((ext_vector_type(2)));
struct Frame {
    LAS unsigned char* lds;
    volatile LAS unsigned* MISC;
    gu32* ctl;
    int tid, lane, wave;
    int vcu, G;
};
__device__ __forceinline__ float dpp_add_(float v, int dummy) { return v; }
#define WS_DPP(v, ctrl) ((v) + __builtin_bit_cast(float, __builtin_amdgcn_update_dpp(0, __builtin_bit_cast(int, (v)), (ctrl), 0xf, 0xf, true)))
__device__ __forceinline__ float wave_sum(float v) {
    v = WS_DPP(v, 0xB1); v = WS_DPP(v, 0x4E); v = WS_DPP(v, 0x141); v = WS_DPP(v, 0x140);
    { auto r = __builtin_amdgcn_permlane16_swap(__float_as_uint(v), __float_as_uint(v), false, false); v = __uint_as_float(r[0]) + __uint_as_float(r[1]); }
    { auto r = __builtin_amdgcn_permlane32_swap(__float_as_uint(v), __float_as_uint(v), false, false); v = __uint_as_float(r[0]) + __uint_as_float(r[1]); }
    return v;
}
__device__ __forceinline__ float bflo(unsigned w) { return __uint_as_float(w << 16); }
__device__ __forceinline__ float bfhi(unsigned w) { return __uint_as_float(w & 0xffff0000u); }
__device__ __forceinline__ unsigned cvtpk(float lo, float hi) { unsigned r; asm volatile("v_cvt_pk_bf16_f32 %0, %1, %2" : "=v"(r) : "v"(lo), "v"(hi)); return r; }
__device__ __forceinline__ float dot2bf(unsigned a, unsigned b, float acc) { return __builtin_amdgcn_fdot2_f32_bf16(__builtin_bit_cast(bf16x2_t, a), __builtin_bit_cast(bf16x2_t, b), acc, false); }

struct MapId { __device__ __forceinline__ int operator()(int n) const { return n; } };
struct MapWin { __device__ __forceinline__ int operator()(int n) const {
    if (n < 1024) return n;
    if (n < 5120) return 1600 + (n - 1024);
    if (n < 9216) return 6720 + (n - 5120);
    if (n < 13312) return 10816 + (n - 9216);
    if (n < 13824) return 5696 + (n - 13312);
    if (n < 14336) return 6208 + (n - 13824);
    if (n < 14912) return 1024 + (n - 14336);
    return -1; } };
struct MapWqb { __device__ __forceinline__ int operator()(int n) const {
    if (n < 4096) return (n >> 7) * 192 + (n & 127);
    const int m = n - 4096, h = m >> 6, p = m & 63, dim = (p >> 1) + ((p & 1) << 5);
    return h * 192 + 128 + dim; } };
struct MapWkvb { __device__ __forceinline__ int operator()(int n) const {
    if (n < 4096) return (n >> 7) * 256 + (n & 127);
    const int m = n - 4096; return (m >> 7) * 256 + 128 + (m & 127); } };
template <class Map>
__device__ __forceinline__ void transpose_item(const float* W, int K, int N, bf16* WT, LAS float* scr, int item, int nblk, int lane, const Map& map) {
    const int kb = item / nblk, nb = item % nblk, k0 = 64 * kb, n0 = 32 * nb;
    const int sc = map(n0 + (lane & 31));
#pragma unroll 8
    for (int i = 0; i < 32; ++i) { const int kk = 2 * i + (lane >> 5); scr[kk * 33 + (lane & 31)] = sc >= 0 ? W[(size_t)(k0 + kk) * N + sc] : 0.f; }
    LDS_WAIT(); asm volatile("" ::: "memory");
    const int c = lane & 7;
#pragma unroll
    for (int j = 0; j < 4; ++j) { const int n = (lane >> 3) + 8 * j; const LAS float* s = scr + (8 * c) * 33 + n;
        v4u o; o.x = pk2(s[0 * 33], s[1 * 33]); o.y = pk2(s[2 * 33], s[3 * 33]); o.z = pk2(s[4 * 33], s[5 * 33]); o.w = pk2(s[6 * 33], s[7 * 33]);
        *(GAS v4u*)(WT + (size_t)(n0 + n) * K + k0 + 8 * c) = o; }
    LDS_WAIT(); asm volatile("" ::: "memory");
}
template <class Map, int FP8, bool VEC4>
__device__ __forceinline__ void transpose_item64(const float* W, int K, int N, unsigned char* WT, float scale, LAS float* scr, int item, int nblk, int lane, const Map& map) {
    const int kb = item / nblk, nb = item % nblk, k0 = 64 * kb, n0 = 64 * nb, j4 = (lane & 15) * 4, kr = lane >> 4;
    int sc[4];
#pragma unroll
    for (int e = 0; e < 4; ++e) sc[e] = map(n0 + j4 + e);
    f32x4 ld[16];
#pragma unroll
    for (int i = 0; i < 16; ++i) { const int kk = 4 * i + kr; const float* wr = W + (size_t)(k0 + kk) * N;
        if (VEC4) { ld[i] = sc[0] >= 0 ? *(const GAS f32x4*)(wr + sc[0]) : (f32x4){0.f, 0.f, 0.f, 0.f}; }
        else { ld[i].x = sc[0] >= 0 ? wr[sc[0]] : 0.f; ld[i].y = sc[1] >= 0 ? wr[sc[1]] : 0.f; ld[i].z = sc[2] >= 0 ? wr[sc[2]] : 0.f; ld[i].w = sc[3] >= 0 ? wr[sc[3]] : 0.f; } }
#pragma unroll
    for (int i = 0; i < 16; ++i) { const int kk = 4 * i + kr; LAS float* row = scr + kk * 64;
        row[(j4 + 0 + kk) & 63] = ld[i].x; row[(j4 + 1 + kk) & 63] = ld[i].y; row[(j4 + 2 + kk) & 63] = ld[i].z; row[(j4 + 3 + kk) & 63] = ld[i].w; }
    LDS_WAIT(); asm volatile("" ::: "memory");
    float v[64];
#pragma unroll
    for (int k = 0; k < 64; ++k) v[k] = scr[k * 64 + ((lane + k) & 63)] * scale;
    if (FP8) { GAS v4u* o = (GAS v4u*)(WT + (size_t)(n0 + lane) * K + k0);
#pragma unroll
        for (int q = 0; q < 4; ++q) { v4u w; int t;
            t = __builtin_amdgcn_cvt_pk_fp8_f32(v[16 * q + 0], v[16 * q + 1], 0, false); t = __builtin_amdgcn_cvt_pk_fp8_f32(v[16 * q + 2], v[16 * q + 3], t, true); w.x = (unsigned)t;
            t = __builtin_amdgcn_cvt_pk_fp8_f32(v[16 * q + 4], v[16 * q + 5], 0, false); t = __builtin_amdgcn_cvt_pk_fp8_f32(v[16 * q + 6], v[16 * q + 7], t, true); w.y = (unsigned)t;
            t = __builtin_amdgcn_cvt_pk_fp8_f32(v[16 * q + 8], v[16 * q + 9], 0, false); t = __builtin_amdgcn_cvt_pk_fp8_f32(v[16 * q + 10], v[16 * q + 11], t, true); w.z = (unsigned)t;
            t = __builtin_amdgcn_cvt_pk_fp8_f32(v[16 * q + 12], v[16 * q + 13], 0, false); t = __builtin_amdgcn_cvt_pk_fp8_f32(v[16 * q + 14], v[16 * q + 15], t, true); w.w = (unsigned)t;
            o[q] = w; } }
    else { GAS v4u* o = (GAS v4u*)(WT + ((size_t)(n0 + lane) * K + k0) * 2);
#pragma unroll
        for (int q = 0; q < 8; ++q) { v4u w; w.x = cvtpk(v[8 * q + 0], v[8 * q + 1]); w.y = cvtpk(v[8 * q + 2], v[8 * q + 3]); w.z = cvtpk(v[8 * q + 4], v[8 * q + 5]); w.w = cvtpk(v[8 * q + 6], v[8 * q + 7]); o[q] = w; } }
    LDS_WAIT(); asm volatile("" ::: "memory");
}
__device__ __forceinline__ void convert_bf16(Frame& F, const float* src, bf16* dst, size_t n8) {
    const size_t nthr = (size_t)F.G * 512, t0 = (size_t)blockIdx.x * 512 + F.tid;
    for (size_t i = t0; i < n8; i += nthr) { const f32x4 a = *(const GAS f32x4*)(src + i * 8), b = *(const GAS f32x4*)(src + i * 8 + 4);
        v4u o; o.x = cvtpk(a.x, a.y); o.y = cvtpk(a.z, a.w); o.z = cvtpk(b.x, b.y); o.w = cvtpk(b.z, b.w); *(GAS v4u*)(dst + i * 8) = o; }
}

__device__ __forceinline__ void convert_slices(Frame& F, const float* src, bf16* dst) {
    const size_t n8 = (size_t)16384 * 512, nthr = (size_t)F.G * 512, t0 = (size_t)blockIdx.x * 512 + F.tid;
    for (size_t i = t0; i < n8; i += nthr) { const f32x4 a = *(const GAS f32x4*)(src + i * 8), b = *(const GAS f32x4*)(src + i * 8 + 4);
        const size_t e = i >> 9; const int g = (int)(i & 511), s = g >> 3, c = g & 7;
        v4u o; o.x = cvtpk(a.x, a.y); o.y = cvtpk(a.z, a.w); o.z = cvtpk(b.x, b.y); o.w = cvtpk(b.z, b.w); *(GAS v4u*)(dst + ((size_t)s * 16384 + e) * 64 + c * 8) = o; }
}
__device__ __forceinline__ void convert_slices_fp8(Frame& F, const float* src, unsigned char* dst, float scale) {
    const size_t n16 = (size_t)16384 * 256, nthr = (size_t)F.G * 512, t0 = (size_t)blockIdx.x * 512 + F.tid;
    for (size_t i = t0; i < n16; i += nthr) { const GAS f32x4* p = (const GAS f32x4*)(src + i * 16); const f32x4 a = p[0] * scale, b = p[1] * scale, c4 = p[2] * scale, d = p[3] * scale;
        const size_t e = i >> 8; const int g = (int)(i & 255), s = g >> 3, c = g & 7;
        v4u o; int w;
        w = __builtin_amdgcn_cvt_pk_fp8_f32(a.x, a.y, 0, false); w = __builtin_amdgcn_cvt_pk_fp8_f32(a.z, a.w, w, true); o.x = (unsigned)w;
        w = __builtin_amdgcn_cvt_pk_fp8_f32(b.x, b.y, 0, false); w = __builtin_amdgcn_cvt_pk_fp8_f32(b.z, b.w, w, true); o.y = (unsigned)w;
        w = __builtin_amdgcn_cvt_pk_fp8_f32(c4.x, c4.y, 0, false); w = __builtin_amdgcn_cvt_pk_fp8_f32(c4.z, c4.w, w, true); o.z = (unsigned)w;
        w = __builtin_amdgcn_cvt_pk_fp8_f32(d.x, d.y, 0, false); w = __builtin_amdgcn_cvt_pk_fp8_f32(d.z, d.w, w, true); o.w = (unsigned)w;
        *(GAS v4u*)(dst + ((size_t)s * 16384 + e) * 128 + c * 16) = o; }
}
__device__ __forceinline__ void p0_prologue(Frame& F, const float* c, const float* w_ada, const float* w_in, const float* w_q_b, const float* w_kv_b, const float* w_out,
                                            const float* w_peer_q, const float* sub_keys, unsigned char* ws) {
    { LAS float* sl = (LAS float*)(F.lds);
      float* adap = (float*)(ws + WS_ADAP);
      for (int w = blockIdx.x; w < 256; w += F.G) {
          const int kc = w >> 2, cq = w & 3;
          __syncthreads();
          if (F.tid < 128) { const int b = F.tid >> 6, kk = F.tid & 63; const float v = c[b * DM + kc * 64 + kk]; sl[F.tid] = v / (1.f + __expf(-v)); }
          __syncthreads();
          for (int cg = F.tid; cg < 1536; cg += 512) {
              const int col = cq * 6144 + 4 * cg; f32x4 a0 = {0.f, 0.f, 0.f, 0.f}, a1 = {0.f, 0.f, 0.f, 0.f};
              const float* wp = w_ada + (size_t)(kc * 64) * NADA + col;
#pragma unroll 8
              for (int kk = 0; kk < 64; ++kk) { const f32x4 w4 = *(const GAS f32x4*)(wp + (size_t)kk * NADA); a0 += w4 * sl[kk]; a1 += w4 * sl[64 + kk]; }
              *(GAS f32x4*)(adap + (size_t)(kc * 2 + 0) * NADA + col) = a0;
              *(GAS f32x4*)(adap + (size_t)(kc * 2 + 1) * NADA + col) = a1;
          }
      }
      __syncthreads(); }
    { float* rc = (float*)(ws + WS_ROPE); float* rs = rc + SEQ * 32;
      for (int e = blockIdx.x * 512 + F.tid; e < SEQ * 32; e += F.G * 512) { const int pos = e >> 5, i = e & 31;
          const float invf = exp2f(-(float)(2 * i) * (13.287712379549449f / 64.f));
          const float ang = (float)pos * invf;
          double t = (double)ang * 0.15915494309189535; t -= floor(t);
          const float r = (float)(t * 6.283185307179586);
          rc[e] = cosf(r); rs[e] = sinf(r); } }
    convert_bf16(F, sub_keys, (bf16*)(ws + WS_SUBK), (size_t)16 * 128 * 128 / 8);
    { LAS float* scr = (LAS float*)(F.lds + RING_OFF + F.wave * 16384);
      const int gw = F.vcu * NWAVES + F.wave, NGW = F.G * NWAVES;
      constexpr int I_IN = 64 * (NZ / 64), I_QB = 16 * (6144 / 64), I_KVB = 8 * (8192 / 64), I_OUT = 64 * (4096 / 64), I_PQ = 64 * (2048 / 64);
      constexpr int NITEMS = I_IN + I_QB + I_KVB + I_OUT + I_PQ;
      for (int it = gw; it < NITEMS; it += NGW) {
          int r = it;
          if (r < I_IN) { transpose_item64<MapWin, 1, true>(w_in, DM, IN_W, ws + WS_WIN, WIN_SCALE, scr, r, NZ / 64, F.lane, MapWin()); continue; } r -= I_IN;
          if (r < I_QB) { transpose_item64<MapWqb, P5_FP8, false>(w_q_b, 1024, 6144, ws + WS_WQB, P5_FP8 ? WQB_SCALE : 1.f, scr, r, 6144 / 64, F.lane, MapWqb()); continue; } r -= I_QB;
          if (r < I_KVB) { transpose_item64<MapWkvb, P5_FP8, true>(w_kv_b, 512, 8192, ws + WS_WKVB, P5_FP8 ? WKVB_SCALE : 1.f, scr, r, 8192 / 64, F.lane, MapWkvb()); continue; } r -= I_KVB;
          if (r < I_OUT) { transpose_item64<MapId, WOUT_FP8, true>(w_out, DM, DM, ws + WS_WOUT, WOUT_FP8 ? WOUT_SCALE : 1.f, scr, r, 4096 / 64, F.lane, MapId()); continue; } r -= I_OUT;
          transpose_item64<MapId, 0, true>(w_peer_q, DM, 2048, ws + WS_WPQ, 1.f, scr, r, 2048 / 64, F.lane, MapId());
      } }
}
__device__ __forceinline__ void p1_ada_reduce(Frame& F, const float* b_ada, unsigned char* ws) {
    const float* adap = (const float*)(ws + WS_ADAP); float* ada = (float*)(ws + WS_ADA);
    for (int o = blockIdx.x * 512 + F.tid; o < 2 * NADA; o += F.G * 512) { const int b = o / NADA, j = o - b * NADA; float s = b_ada[j];
#pragma unroll 8
        for (int kc = 0; kc < 64; ++kc) s += adap[(size_t)(kc * 2 + b) * NADA + j];
        ada[o] = s; }
}
__device__ __forceinline__ void p2_modnorm(Frame& F, const float* x, const float* g, unsigned char* ws) {
    const int gw = F.vcu * NWAVES + F.wave, NGW = F.G * NWAVES; const float* ada = (const float*)(ws + WS_ADA); unsigned char* H = ws + WS_H;
    LAS f32x4* L = (LAS f32x4*)(F.lds + RING_OFF);
    for (int i = F.tid; i < 2048; i += 512) { const int b = i >> 10, q = i & 1023;
        const f32x4 g4 = *(const f32x4*)(g + 4 * q), s4 = *(const f32x4*)(ada + b * NADA + DM + 4 * q), h4 = *(const f32x4*)(ada + b * NADA + 4 * q);
        L[b * 2048 + q] = g4 * (s4 + 1.0f) * H_SCALE; L[b * 2048 + 1024 + q] = h4 * H_SCALE; }
    __syncthreads();
    for (int m = gw; m < M; m += NGW) { const int b = m >> 13;
        int lane = F.lane; asm volatile("" : "+v"(lane));
        const GAS f32x4* xr = (const GAS f32x4*)(x + (size_t)m * DM) + lane; f32x4 v[16]; float s = 0.f;
#pragma unroll
        for (int j = 0; j < 16; ++j) v[j] = xr[64 * j];
        __builtin_amdgcn_sched_barrier(0);
#pragma unroll
        for (int j = 0; j < 16; ++j) s += (v[j].x * v[j].x + v[j].y * v[j].y) + (v[j].z * v[j].z + v[j].w * v[j].w);
        const float rstd = 1.0f / sqrtf(wave_sum(s) * (1.f / DM) + NORM_EPS);
        const LAS f32x4* Lb = L + b * 2048 + lane;
        GAS unsigned* o4 = (GAS unsigned*)(H + (size_t)m * DM) + lane;
#pragma unroll
        for (int j = 0; j < 16; ++j) {
            const f32x4 o = v[j] * rstd * Lb[64 * j] + Lb[1024 + 64 * j];
            int t = __builtin_amdgcn_cvt_pk_fp8_f32(o.x, o.y, 0, false); t = __builtin_amdgcn_cvt_pk_fp8_f32(o.z, o.w, t, true); o4[64 * j] = (unsigned)t; }
    }
    __syncthreads();
}
__device__ __forceinline__ void p4_latent(Frame& F, const float* g_q, const float* g_kv, unsigned char* ws) {
    const int gw = F.vcu * NWAVES + F.wave, NGW = F.G * NWAVES;
    const bf16* ZQ = (const bf16*)(ws + WS_ZQ); const bf16* ZKV = (const bf16*)(ws + WS_ZKV);
    bf16* ZQN = (bf16*)(ws + WS_ZQN); bf16* CKV = (bf16*)(ws + WS_CKV); bf16* KPE = (bf16*)(ws + WS_KPE);
    const float* rc = (const float*)(ws + WS_ROPE); const float* rs = rc + SEQ * 32;
    for (int m = gw; m < M; m += NGW) {
        { v4u a[2]; float f[16]; float s = 0.f;
#pragma unroll
          for (int j = 0; j < 2; ++j) { a[j] = *(const GAS v4u*)(ZQ + (size_t)m * 1024 + 512 * j + 8 * F.lane);
              f[8 * j + 0] = bflo(a[j].x); f[8 * j + 1] = bfhi(a[j].x); f[8 * j + 2] = bflo(a[j].y); f[8 * j + 3] = bfhi(a[j].y);
              f[8 * j + 4] = bflo(a[j].z); f[8 * j + 5] = bfhi(a[j].z); f[8 * j + 6] = bflo(a[j].w); f[8 * j + 7] = bfhi(a[j].w); }
#pragma unroll
          for (int e = 0; e < 16; ++e) s += f[e] * f[e];
          const float rstd = 1.0f / sqrtf(wave_sum(s) * (1.f / 1024.f) + NORM_EPS);
#pragma unroll
          for (int j = 0; j < 2; ++j) { const int col = 512 * j + 8 * F.lane; const f32x4 g0 = *(const f32x4*)(g_q + col), g1 = *(const f32x4*)(g_q + col + 4);
              const float o0 = f[8 * j + 0] * rstd * g0.x, o1 = f[8 * j + 1] * rstd * g0.y, o2 = f[8 * j + 2] * rstd * g0.z, o3 = f[8 * j + 3] * rstd * g0.w,
                          o4 = f[8 * j + 4] * rstd * g1.x, o5 = f[8 * j + 5] * rstd * g1.y, o6 = f[8 * j + 6] * rstd * g1.z, o7 = f[8 * j + 7] * rstd * g1.w;
              if (P5_FP8) { int t0 = __builtin_amdgcn_cvt_pk_fp8_f32(o0 * LAT_SCALE, o1 * LAT_SCALE, 0, false); t0 = __builtin_amdgcn_cvt_pk_fp8_f32(o2 * LAT_SCALE, o3 * LAT_SCALE, t0, true);
                  int t1 = __builtin_amdgcn_cvt_pk_fp8_f32(o4 * LAT_SCALE, o5 * LAT_SCALE, 0, false); t1 = __builtin_amdgcn_cvt_pk_fp8_f32(o6 * LAT_SCALE, o7 * LAT_SCALE, t1, true);
                  *(GAS unsigned long long*)((unsigned char*)ZQN + (size_t)m * 1024 + col) = (unsigned long long)(unsigned)t0 | ((unsigned long long)(unsigned)t1 << 32); }
              else { v4u o; o.x = cvtpk(o0, o1); o.y = cvtpk(o2, o3); o.z = cvtpk(o4, o5); o.w = cvtpk(o6, o7); *(GAS v4u*)(ZQN + (size_t)m * 1024 + col) = o; } } }
        { const v4u a = *(const GAS v4u*)(ZKV + (size_t)m * 768 + 8 * F.lane); float f[8];
          f[0] = bflo(a.x); f[1] = bfhi(a.x); f[2] = bflo(a.y); f[3] = bfhi(a.y); f[4] = bflo(a.z); f[5] = bfhi(a.z); f[6] = bflo(a.w); f[7] = bfhi(a.w);
          float s = 0.f;
#pragma unroll
          for (int e = 0; e < 8; ++e) s += f[e] * f[e];
          const float rstd = 1.0f / sqrtf(wave_sum(s) * (1.f / 512.f) + NORM_EPS);
          const int col = 8 * F.lane; const f32x4 g0 = *(const f32x4*)(g_kv + col), g1 = *(const f32x4*)(g_kv + col + 4);
          const float o0 = f[0] * rstd * g0.x, o1 = f[1] * rstd * g0.y, o2 = f[2] * rstd * g0.z, o3 = f[3] * rstd * g0.w, o4 = f[4] * rstd * g1.x, o5 = f[5] * rstd * g1.y, o6 = f[6] * rstd * g1.z, o7 = f[7] * rstd * g1.w;
          if (P5_FP8) { int t0 = __builtin_amdgcn_cvt_pk_fp8_f32(o0 * LAT_SCALE, o1 * LAT_SCALE, 0, false); t0 = __builtin_amdgcn_cvt_pk_fp8_f32(o2 * LAT_SCALE, o3 * LAT_SCALE, t0, true);
              int t1 = __builtin_amdgcn_cvt_pk_fp8_f32(o4 * LAT_SCALE, o5 * LAT_SCALE, 0, false); t1 = __builtin_amdgcn_cvt_pk_fp8_f32(o6 * LAT_SCALE, o7 * LAT_SCALE, t1, true);
              *(GAS unsigned long long*)((unsigned char*)CKV + (size_t)m * 512 + col) = (unsigned long long)(unsigned)t0 | ((unsigned long long)(unsigned)t1 << 32); }
          else { v4u o; o.x = cvtpk(o0, o1); o.y = cvtpk(o2, o3); o.z = cvtpk(o4, o5); o.w = cvtpk(o6, o7); *(GAS v4u*)(CKV + (size_t)m * 512 + col) = o; } }
        if (F.lane < 32) { const int pos = m & (SEQ - 1);
          const float x1 = __uint_as_float((unsigned)ZKV[(size_t)m * 768 + 512 + F.lane] << 16), x2 = __uint_as_float((unsigned)ZKV[(size_t)m * 768 + 544 + F.lane] << 16);
          const float cc = rc[pos * 32 + F.lane], ss = rs[pos * 32 + F.lane];
          if (MLA_FP8QK) { const int t8 = __builtin_amdgcn_cvt_pk_fp8_f32((x1 * cc - x2 * ss) * QK8_SCALE, (x2 * cc + x1 * ss) * QK8_SCALE, 0, false);
              *(GAS unsigned short*)((unsigned char*)KPE + (size_t)m * 64 + 2 * F.lane) = (unsigned short)t8; }
          else *(GAS unsigned*)(KPE + (size_t)m * 64 + 2 * F.lane) = cvtpk(x1 * cc - x2 * ss, x2 * cc + x1 * ss); }
    }
}
__device__ __forceinline__ void p9_post_attn(Frame& F, const float* x, const float* g_post, const float* g_ffn_pre, float* out, unsigned char* ws) {
    const int gw = F.vcu * NWAVES + F.wave, NGW = F.G * NWAVES; const float* ada = (const float*)(ws + WS_ADA);
    const bf16* T = (const bf16*)(ws + WS_T); const float* rsq = (const float*)(ws + WS_RSQ); bf16* H2 = (bf16*)(ws + WS_H);
    LAS f32x4* L = (LAS f32x4*)(F.lds + RING_OFF);
    for (int i = F.tid; i < 2048; i += 512) { const int b = i >> 10, q = i & 1023, slot = ((q >> 7) * 2 + (q & 1)) * 64 + ((q >> 1) & 63);
        const f32x4 gp = *(const f32x4*)(g_post + 4 * q), ga = *(const f32x4*)(ada + b * NADA + 2 * DM + 4 * q), gf = *(const f32x4*)(g_ffn_pre + 4 * q),
                    sc = *(const f32x4*)(ada + b * NADA + 4 * DM + 4 * q), sh = *(const f32x4*)(ada + b * NADA + 3 * DM + 4 * q);
        L[b * 3072 + slot] = ga * gp; L[b * 3072 + 1024 + slot] = gf * (sc + 1.0f); L[b * 3072 + 2048 + slot] = sh; }
    __syncthreads();
    for (int m = gw; m < M; m += NGW) { const int b = m >> 13;
        int lane = F.lane; asm volatile("" : "+v"(lane));
        const float rq = rsq[(size_t)m * 64 + lane];
        const GAS v4u* Tr = (const GAS v4u*)(T + (size_t)m * DM) + lane; const GAS f32x4* xr = (const GAS f32x4*)(x + (size_t)m * DM) + 2 * lane;
        v4u t[8]; f32x4 xa[16];
#pragma unroll
        for (int j = 0; j < 8; ++j) t[j] = Tr[64 * j];
#pragma unroll
        for (int j = 0; j < 8; ++j) { xa[2 * j] = xr[128 * j]; xa[2 * j + 1] = xr[128 * j + 1]; }
        __builtin_amdgcn_sched_barrier(0);
        const float rstd = 1.0f / sqrtf(wave_sum(rq) * (1.f / DM) + NORM_EPS);
        const LAS f32x4* Lb = L + b * 3072 + lane; float s2 = 0.f;
#pragma unroll
        for (int j = 0; j < 8; ++j) { const f32x4 a0 = Lb[128 * j], a1 = Lb[128 * j + 64];
            f32x4 u0, u1; u0.x = bflo(t[j].x); u0.y = bfhi(t[j].x); u0.z = bflo(t[j].y); u0.w = bfhi(t[j].y); u1.x = bflo(t[j].z); u1.y = bfhi(t[j].z); u1.z = bflo(t[j].w); u1.w = bfhi(t[j].w);
            xa[2 * j] = xa[2 * j] + a0 * (u0 * rstd); xa[2 * j + 1] = xa[2 * j + 1] + a1 * (u1 * rstd);
            const f32x4 p = xa[2 * j] * xa[2 * j] + xa[2 * j + 1] * xa[2 * j + 1]; s2 += (p.x + p.y) + (p.z + p.w); }
        const float rstd2 = 1.0f / sqrtf(wave_sum(s2) * (1.f / DM) + NORM_EPS);
        GAS v4u* Hr = (GAS v4u*)(H2 + (size_t)m * DM) + lane;
#pragma unroll
        for (int j = 0; j < 8; ++j) {
            const f32x4 o0 = xa[2 * j] * rstd2 * Lb[1024 + 128 * j] + Lb[2048 + 128 * j], o1 = xa[2 * j + 1] * rstd2 * Lb[1024 + 128 * j + 64] + Lb[2048 + 128 * j + 64];
            v4u w; w.x = cvtpk(o0.x, o0.y); w.y = cvtpk(o0.z, o0.w); w.z = cvtpk(o1.x, o1.y); w.w = cvtpk(o1.z, o1.w); Hr[64 * j] = w;
            if (X1_BF16) { v4u r; r.x = cvtpk(xa[2 * j].x, xa[2 * j].y); r.y = cvtpk(xa[2 * j].z, xa[2 * j].w); r.z = cvtpk(xa[2 * j + 1].x, xa[2 * j + 1].y); r.w = cvtpk(xa[2 * j + 1].z, xa[2 * j + 1].w);
                ((GAS v4u*)(ws + WS_X1 + (size_t)m * DM * 2) + lane)[64 * j] = r; } }
    }
    __syncthreads();
}

namespace mla {
typedef short bf16x8 __attribute__((ext_vector_type(8)));
typedef short s16x4 __attribute__((ext_vector_type(4)));
typedef float f32x16 __attribute__((ext_vector_type(16)));
typedef unsigned u32x4 __attribute__((ext_vector_type(4)));
typedef unsigned short bf16;
#ifndef MLA_STAGGER
#define MLA_STAGGER 0
#endif
#ifndef MLA_BUFDMA
#define MLA_BUFDMA 1
#endif
#ifndef MLA_QP_LDS
#define MLA_QP_LDS 0
#endif
constexpr int NW = 8, QBLK = 32, KVBLK = 64, QB = NW * QBLK;
constexpr int PQN = 4096, PQP = 2048, PKN = 4096, PKP = 64, PVV = 4096, PO = 4096;
#if MLA_FP8QK
constexpr int SLOT_K = 8192, SLOT_V = MLA_FP8PV ? 8192 : 16384, SLOT_P = 4096;
#else
constexpr int SLOT_K = 16384, SLOT_V = 16384, SLOT_P = 8192;
#endif
typedef int v8i __attribute__((ext_vector_type(8)));
constexpr int OFF_K = 0, OFF_V = 3 * SLOT_K, OFF_KP = OFF_V + 3 * SLOT_V, OFF_QP = OFF_KP + 3 * SLOT_P, OFF_WS = OFF_QP + (MLA_QP_LDS ? NW * 4096 : 0), LDS_BYTES = OFF_WS + NW * 64 * 4;
constexpr float SCALE = MLA_FP8QK ? 0.07216878364870322f / (QK8_SCALE * QK8_SCALE) : 0.07216878364870322f;
constexpr float THR = MLA_FP8PV ? 0.5f : 8.f;
#define SBAR() __builtin_amdgcn_sched_barrier(0)
__device__ __forceinline__ int crow(int r, int hi) { return (r & 3) + 8 * (r >> 2) + 4 * hi; }
__device__ __forceinline__ unsigned cvtpk(float lo, float hi) { unsigned r; asm volatile("v_cvt_pk_bf16_f32 %0, %1, %2" : "=v"(r) : "v"(lo), "v"(hi)); return r; }
__device__ __forceinline__ bf16x8 load8(const bf16* p) { return *reinterpret_cast<const bf16x8*>(p); }
__device__ __forceinline__ void mask_tile(f32x16& p0, f32x16& p1, int dq) {
    const float NEG = -__builtin_inff();
#pragma unroll
    for (int r = 0; r < 16; ++r) { const int c = (r & 3) + 8 * (r >> 2);
        if (dq - c < 0) p0[r] = NEG;
        if (dq - c - 32 < 0) p1[r] = NEG; }
}
__device__ __forceinline__ void partialSM(f32x16& p0, f32x16& p1, float& m_reg, float& mn, float& alpha) {
    float pmax = p0[0];
#pragma unroll
    for (int r = 1; r < 16; ++r) pmax = fmaxf(pmax, p0[r]);
#pragma unroll
    for (int r = 0; r < 16; ++r) pmax = fmaxf(pmax, p1[r]);
    { auto rr = __builtin_amdgcn_permlane32_swap(__float_as_uint(pmax), __float_as_uint(pmax), false, false);
      pmax = fmaxf(__uint_as_float(rr[0]), __uint_as_float(rr[1])); }
    constexpr float C2 = 1.4426950408889634f * SCALE;
    { const bool keep = __all((pmax - m_reg) * SCALE <= THR);
      const float mx = fmaxf(m_reg, pmax); mn = keep ? m_reg : mx; alpha = __builtin_amdgcn_exp2f((m_reg - mn) * C2); m_reg = mn; }
    const float mnL = -mn * C2 + (MLA_FP8PV ? 8.0f : 0.0f);
#pragma unroll
    for (int r = 0; r < 16; ++r) p0[r] = fmaf(p0[r], C2, mnL);
#pragma unroll
    for (int r = 0; r < 16; ++r) p1[r] = fmaf(p1[r], C2, mnL);
#pragma unroll
    for (int r = 0; r < 16; ++r) p0[r] = __builtin_amdgcn_exp2f(p0[r]);
}
#define MLA_PK4(P, B_, OUT) do { unsigned a0 = cvtpk(P[B_+0], P[B_+1]), a1 = cvtpk(P[B_+2], P[B_+3]);                          \
        unsigned b0 = cvtpk(P[B_+4], P[B_+5]), b1 = cvtpk(P[B_+6], P[B_+7]);                                             \
        auto r0 = __builtin_amdgcn_permlane32_swap(a0, b0, false, false); auto r1 = __builtin_amdgcn_permlane32_swap(a1, b1, false, false); \
        u32x4 w = {r0[0], r1[0], r0[1], r1[1]}; OUT = *reinterpret_cast<bf16x8*>(&w); } while (0)
__device__ __forceinline__ void finishSM(f32x16& p0, f32x16& p1, float alpha, float& l_reg, bf16x8& pa0, bf16x8& pa1, bf16x8& pa2, bf16x8& pa3) {
#pragma unroll
    for (int r = 0; r < 16; ++r) p1[r] = __builtin_amdgcn_exp2f(p1[r]);
    float ps = 0;
#pragma unroll
    for (int r = 0; r < 16; ++r) ps += p0[r];
#pragma unroll
    for (int r = 0; r < 16; ++r) ps += p1[r];
    { auto rr = __builtin_amdgcn_permlane32_swap(__float_as_uint(ps), __float_as_uint(ps), false, false);
      ps = __uint_as_float(rr[0]) + __uint_as_float(rr[1]); }
    l_reg = l_reg * alpha + ps;
    MLA_PK4(p0, 0, pa0); MLA_PK4(p0, 8, pa1); MLA_PK4(p1, 0, pa2); MLA_PK4(p1, 8, pa3);
}
__device__ __forceinline__ void finishSM8(f32x16& p0, f32x16& p1, v8i& pf) {
#pragma unroll
    for (int r = 0; r < 16; ++r) p1[r] = __builtin_amdgcn_exp2f(p1[r]);
    int f[8];
#pragma unroll
    for (int m = 0; m < 4; ++m) {
        int a = __builtin_amdgcn_cvt_pk_fp8_f32(p0[4 * m], p0[4 * m + 1], __float_as_int(p0[4 * m]), false); a = __builtin_amdgcn_cvt_pk_fp8_f32(p0[4 * m + 2], p0[4 * m + 3], a, true);
        int b = __builtin_amdgcn_cvt_pk_fp8_f32(p1[4 * m], p1[4 * m + 1], __float_as_int(p1[4 * m]), false); b = __builtin_amdgcn_cvt_pk_fp8_f32(p1[4 * m + 2], p1[4 * m + 3], b, true);
        auto r = __builtin_amdgcn_permlane32_swap((unsigned)a, (unsigned)b, false, false);
        f[2 * m] = (int)r[0]; f[2 * m + 1] = (int)r[1]; }
    pf = (v8i){f[0], f[1], f[2], f[3], f[4], f[5], f[6], f[7]};
}
#define MLA_GLDS(gp, ldsoff) __builtin_amdgcn_global_load_lds((const unsigned*)(gp), (__attribute__((address_space(3))) unsigned*)(lds3 + (ldsoff)), 16, 0, 0)
#if MLA_FP8PV
#ifndef MLA_PRIO
#define MLA_PRIO 0
#endif
#ifndef MLA_ILV_ON
#define MLA_ILV_ON 1
#endif
#define MLA_ILV() do { if (!MLA_ILV_ON) break; __builtin_amdgcn_sched_group_barrier(0x100, 8, 0); \
        _Pragma("unroll") for (int g_ = 0; g_ < 5; ++g_) { __builtin_amdgcn_sched_group_barrier(0x008, 1, 0); __builtin_amdgcn_sched_group_barrier(0x002, 14, 0); __builtin_amdgcn_sched_group_barrier(0x400, 4, 0); } } while (0)
#else
#define MLA_ILV() do { } while (0)
#endif
#define MLA_WAITBAR(N) asm volatile("s_waitcnt vmcnt(" #N ") lgkmcnt(0)\n\ts_barrier" ::: "memory")
#define MLA_WAITBAR_KV() do { if (MLA_FP8QK && MLA_FP8PV) MLA_WAITBAR(3); else if (MLA_FP8QK) MLA_WAITBAR(4); else MLA_WAITBAR(5); } while (0)
#define MLA_WAITBAR_V() do { if (MLA_FP8PV) MLA_WAITBAR(1); else MLA_WAITBAR(2); } while (0)
__device__ __forceinline__ void mla_block(const unsigned char* wsb, int b, int h, int qb, char* lds) {
    typedef __attribute__((address_space(3))) unsigned char* lds3_t;
    const lds3_t lds3 = (lds3_t)lds;
    const int tid = threadIdx.x, wid = __builtin_amdgcn_readfirstlane(tid >> 6), lane = tid & 63, r32 = lane & 31, hi = lane >> 5;
    const int P0 = qb * QB; const int NT = (P0 + QB) / KVBLK;
    const int qlo = P0 + wid * QBLK, qm = qlo + r32 - 4 * hi;
    float* ws = (float*)(lds + OFF_WS) + wid * 64; float* li_l = ws, * al_l = ws + 32;
    unsigned offK, offV, offP;
#if MLA_FP8QK
    { const int row = 8 * wid + (lane >> 3), sl = lane & 7, ch = sl ^ (((row >> 1) & 3) << 1) ^ ((row >> 3) & 1); offK = (unsigned)(row * 4096 + ch * 16); }
#else
    { const int row = 4 * wid + (lane >> 4), sl = lane & 15, ch = sl ^ (row & 7); offK = (unsigned)(row * PKN + ch * 8); }
#endif
#if MLA_FP8PV
    { const int row = 16 * wid + (lane >> 2), sl = lane & 3, ch = sl ^ (((row >> 2) & 1) << 1) ^ ((row >> 3) & 1); offV = (unsigned)(row * 16384 + ch * 16); }
#else
    { const int st = 2 * wid + (lane >> 5), kg = st >> 2, cblk = st & 3, kk = kg * 8 + ((lane & 31) >> 2), k = (kk & ~0xC) | ((kk & 4) << 1) | ((kk & 8) >> 1), c = cblk * 32 + (lane & 3) * 8;
      offV = (unsigned)(k * PVV + c); }
#endif
#if MLA_FP8QK
    { const int row = 16 * (wid & 3) + (lane >> 2), sl = lane & 3, ch = sl ^ (((row >> 2) & 1) << 1) ^ ((row >> 3) & 1); offP = (unsigned)(row * 64 + ch * 16); }
#else
    { const int row = 8 * wid + (lane >> 3), sl = lane & 7, ch = sl ^ ((row >> 1) & 7); offP = (unsigned)(row * PKP + ch * 8); }
#endif
    #if MLA_FP8QK
    [[maybe_unused]] const unsigned char* kn = wsb + WS_KN + (size_t)b * 8192 * 4096 + h * 128; [[maybe_unused]] const unsigned char* kp = wsb + WS_KPE + (size_t)b * 8192 * 64;
    [[maybe_unused]] const int knoff = (int)(WS_KN + (size_t)b * 8192 * 4096 + h * 128), kpoff = (int)(WS_KPE + (size_t)b * 8192 * 64);
    [[maybe_unused]] const __amdgpu_buffer_rsrc_t wsrs = __builtin_amdgcn_make_buffer_rsrc((void*)wsb, 0, 0x7fffffff, 0x00020000);
#else
    const bf16* kn = (const bf16*)(wsb + WS_KN) + (size_t)b * 8192 * PKN + h * 128; const bf16* kp = (const bf16*)(wsb + WS_KPE) + (size_t)b * 8192 * PKP;
#endif
    #if MLA_FP8PV
    [[maybe_unused]] const unsigned char* vv = wsb + WS_VM + (size_t)h * 128 * 16384 + (size_t)b * 8192;
    [[maybe_unused]] const int vvoff = (int)(WS_VM + (size_t)h * 128 * 16384 + (size_t)b * 8192);
#else
    const bf16* vv = (const bf16*)(wsb + WS_VM) + (size_t)b * 8192 * PVV + h * 128;
#endif
    const size_t row0 = (size_t)b * 8192 + (size_t)P0 + wid * QBLK;
#if MLA_FP8QK
#if MLA_BUFDMA
#define MLA_BLDS(soff, voff, ldsoff) __builtin_amdgcn_raw_ptr_buffer_load_lds(wsrs, (__attribute__((address_space(3))) void*)(lds3 + (ldsoff)), 16, (int)(voff), (int)(soff), 0, 0)
#define DMA_K(t, slot) do { MLA_BLDS(knoff + (t) * (KVBLK * 4096), offK, __builtin_amdgcn_readfirstlane(OFF_K + (slot) * SLOT_K + wid * 1024));                  \
        MLA_BLDS(kpoff + (t) * (KVBLK * 64), offP, __builtin_amdgcn_readfirstlane(OFF_KP + (slot) * SLOT_P + (wid & 3) * 1024)); } while (0)
#else
#define DMA_K(t, slot) do { const unsigned char* b_ = (const unsigned char*)kn + (size_t)(t) * (KVBLK * 4096); unsigned ok_ = offK, op_ = offP; asm volatile("" : "+v"(ok_), "+v"(op_));   \
        MLA_GLDS(b_ + ok_, __builtin_amdgcn_readfirstlane(OFF_K + (slot) * SLOT_K + wid * 1024));                                                              \
        const unsigned char* bp_ = (const unsigned char*)kp + (size_t)(t) * (KVBLK * 64); MLA_GLDS(bp_ + op_, __builtin_amdgcn_readfirstlane(OFF_KP + (slot) * SLOT_P + (wid & 3) * 1024)); } while (0)
#endif
#define MLA_NK 2
#else
#define DMA_K(t, slot) do { const bf16* b_ = kn + (size_t)(t) * (KVBLK * PKN); const int d_ = __builtin_amdgcn_readfirstlane(OFF_K + (slot) * SLOT_K + wid * 1024);   \
        unsigned ok_ = offK, op_ = offP; asm volatile("" : "+v"(ok_), "+v"(op_));   \
        MLA_GLDS(b_ + ok_, d_); MLA_GLDS(b_ + 32 * PKN + ok_, d_ + 8192);                                                                                      \
        const bf16* bp_ = kp + (size_t)(t) * (KVBLK * PKP); MLA_GLDS(bp_ + op_, __builtin_amdgcn_readfirstlane(OFF_KP + (slot) * SLOT_P + wid * 1024)); } while (0)
#define MLA_NK 3
#endif
#if MLA_FP8PV
#if MLA_BUFDMA
#define DMA_V(t, slot) do { MLA_BLDS(vvoff + (t) * KVBLK, offV, __builtin_amdgcn_readfirstlane(OFF_V + (slot) * SLOT_V + wid * 1024)); } while (0)
#else
#define DMA_V(t, slot) do { const unsigned char* b_ = vv + (size_t)(t) * KVBLK; unsigned ov_ = offV; asm volatile("" : "+v"(ov_));   \
        MLA_GLDS(b_ + ov_, __builtin_amdgcn_readfirstlane(OFF_V + (slot) * SLOT_V + wid * 1024)); } while (0)
#endif
#define MLA_NV 1
#else
#define DMA_V(t, slot) do { const bf16* b_ = vv + (size_t)(t) * (KVBLK * PVV); const int d_ = __builtin_amdgcn_readfirstlane(OFF_V + (slot) * SLOT_V + wid * 1024);   \
        unsigned ov_ = offV; asm volatile("" : "+v"(ov_));   \
        MLA_GLDS(b_ + ov_, d_); MLA_GLDS(b_ + 32 * PVV + ov_, d_ + 8192); } while (0)
#define MLA_NV 2
#endif
#if MLA_FP8QK
    int kbo8[2];
#pragma unroll
    for (int e = 0; e < 2; ++e) kbo8[e] = OFF_K + r32 * 128 + (((4 * e + 2 * hi) ^ (((r32 >> 1) & 3) << 1) ^ ((r32 >> 3) & 1)) << 4);
    const int kpo8 = OFF_KP + r32 * 64 + (((2 * hi) ^ (((r32 >> 2) & 1) << 1) ^ ((r32 >> 3) & 1)) << 4);
#else
    int kbo[4];
#pragma unroll
    for (int dd = 0; dd < 4; ++dd) kbo[dd] = OFF_K + r32 * 256 + (((dd * 16 + hi * 8) * 2) ^ ((r32 & 7) << 4));
    int kpo[4];
#pragma unroll
    for (int e = 0; e < 4; ++e) kpo[e] = OFF_KP + r32 * 128 + (((2 * e + hi) ^ ((r32 >> 1) & 7)) << 4);
#endif
    [[maybe_unused]] const int vb0 = (int)(uintptr_t)lds + OFF_V + (((lane & 3) << 3) | (((lane >> 2) & 3) << 6) | (((lane >> 4) & 1) << 5) | (((lane >> 5) & 1) << 8));
    DMA_K(0, 0); DMA_V(0, 0); DMA_K(1, 1);
#if MLA_FP8QK
    v8i q8[3];
    { unsigned qon = (unsigned)(r32 * 4096 + hi * 32), qop = (unsigned)(r32 * 2048 + hi * 32); asm volatile("" : "+v"(qon), "+v"(qop));
      const unsigned char* qn_ = wsb + WS_QN + row0 * 4096 + h * 128; const unsigned char* qp_ = wsb + WS_QP + row0 * 2048 + h * 64;
#pragma unroll
      for (int e = 0; e < 2; ++e) { const u32x4 lo_ = *(const u32x4*)(qn_ + 64 * e + qon), hi_ = *(const u32x4*)(qn_ + 64 * e + 16 + qon);
          q8[e] = (v8i){(int)lo_.x, (int)lo_.y, (int)lo_.z, (int)lo_.w, (int)hi_.x, (int)hi_.y, (int)hi_.z, (int)hi_.w}; }
      { const u32x4 lo_ = *(const u32x4*)(qp_ + qop), hi_ = *(const u32x4*)(qp_ + 16 + qop);
          q8[2] = (v8i){(int)lo_.x, (int)lo_.y, (int)lo_.z, (int)lo_.w, (int)hi_.x, (int)hi_.y, (int)hi_.z, (int)hi_.w}; } }
#define QPF(e) 0
#else
    bf16x8 qr[8];
    unsigned qon = (unsigned)(r32 * PQN + hi * 8), qop = (unsigned)(r32 * PQP + hi * 8); asm volatile("" : "+v"(qon), "+v"(qop));
#pragma unroll
    for (int d0 = 0; d0 < 8; ++d0) qr[d0] = load8((const bf16*)(wsb + WS_QN) + row0 * PQN + h * 128 + d0 * 16 + qon);
#if MLA_QP_LDS
    { char* qpl = lds + OFF_QP + wid * 4096 + lane * 16;
#pragma unroll
      for (int e = 0; e < 4; ++e) *(bf16x8*)(qpl + e * 1024) = load8((const bf16*)(wsb + WS_QP) + row0 * PQP + h * 64 + e * 16 + qop); }
    const char* qpl_r = lds + OFF_QP + wid * 4096 + lane * 16;
#define QPF(e) (*(const bf16x8*)(qpl_r + (e) * 1024))
#else
    bf16x8 qp[4];
#pragma unroll
    for (int e = 0; e < 4; ++e) qp[e] = load8((const bf16*)(wsb + WS_QP) + row0 * PQP + h * 64 + e * 16 + qop);
#define QPF(e) qp[e]
#endif
#endif
#if MLA_FP8PV
    float m_reg = -1e30f; f32x16 o[5] = {};
    v8i ones8;
    { int o0_, o1_, o2_, o3_, o4_, o5_, o6_, o7_; asm volatile("v_mov_b32 %0, 0x38383838\n\tv_mov_b32 %1, 0x38383838\n\tv_mov_b32 %2, 0x38383838\n\tv_mov_b32 %3, 0x38383838\n\tv_mov_b32 %4, 0x38383838\n\tv_mov_b32 %5, 0x38383838\n\tv_mov_b32 %6, 0x38383838\n\tv_mov_b32 %7, 0x38383838" : "=v"(o0_), "=v"(o1_), "=v"(o2_), "=v"(o3_), "=v"(o4_), "=v"(o5_), "=v"(o6_), "=v"(o7_));
      ones8 = (v8i){o0_, o1_, o2_, o3_, o4_, o5_, o6_, o7_}; }
#else
    float m_reg = -1e30f, l_reg = 0; f32x16 o[4] = {};
#endif
#if MLA_FP8QK
#define K8F(b_, o_) ({ const u32x4 lo_ = *reinterpret_cast<const u32x4*>((b_) + (o_)), hi_ = *reinterpret_cast<const u32x4*>((b_) + ((o_) ^ 16)); (v8i){(int)lo_.x, (int)lo_.y, (int)lo_.z, (int)lo_.w, (int)hi_.x, (int)hi_.y, (int)hi_.z, (int)hi_.w}; })
#define QKT(P0_, P1_, slot) do { P0_ = f32x16{}; P1_ = f32x16{}; const char* kb_ = lds + (slot) * SLOT_K; const char* kq_ = lds + (slot) * SLOT_P;   \
        _Pragma("unroll") for (int e = 0; e < 2; ++e) { const v8i b0 = K8F(kb_, kbo8[e]); const v8i b1 = K8F(kb_ + 32 * 128, kbo8[e]);       \
            P0_ = __builtin_amdgcn_mfma_scale_f32_32x32x64_f8f6f4(b0, q8[e], P0_, 0, 0, 0, 0, 0, 0); P1_ = __builtin_amdgcn_mfma_scale_f32_32x32x64_f8f6f4(b1, q8[e], P1_, 0, 0, 0, 0, 0, 0); }  \
        { const v8i b0 = K8F(kq_, kpo8); const v8i b1 = K8F(kq_ + 32 * 64, kpo8);                                                         \
            P0_ = __builtin_amdgcn_mfma_scale_f32_32x32x64_f8f6f4(b0, q8[2], P0_, 0, 0, 0, 0, 0, 0); P1_ = __builtin_amdgcn_mfma_scale_f32_32x32x64_f8f6f4(b1, q8[2], P1_, 0, 0, 0, 0, 0, 0); } } while (0)
#else
#define QKT(P0_, P1_, slot) do { P0_ = f32x16{}; P1_ = f32x16{}; const char* kb_ = lds + (slot) * SLOT_K; const char* kq_ = lds + (slot) * SLOT_P;   \
        _Pragma("unroll") for (int d0 = 0; d0 < 8; ++d0) { const char* a_ = kb_ + kbo[d0 & 3] + (d0 >> 2) * 128;                                         \
            const bf16x8 b0 = *reinterpret_cast<const bf16x8*>(a_); const bf16x8 b1 = *reinterpret_cast<const bf16x8*>(a_ + 32 * 256);                    \
            P0_ = __builtin_amdgcn_mfma_f32_32x32x16_bf16(b0, qr[d0], P0_, 0, 0, 0); P1_ = __builtin_amdgcn_mfma_f32_32x32x16_bf16(b1, qr[d0], P1_, 0, 0, 0); }  \
        _Pragma("unroll") for (int e = 0; e < 4; ++e) { const char* a_ = kq_ + kpo[e];                                                                  \
            const bf16x8 b0 = *reinterpret_cast<const bf16x8*>(a_); const bf16x8 b1 = *reinterpret_cast<const bf16x8*>(a_ + 32 * 128); const bf16x8 q_ = QPF(e);   \
            P0_ = __builtin_amdgcn_mfma_f32_32x32x16_bf16(b0, q_, P0_, 0, 0, 0); P1_ = __builtin_amdgcn_mfma_f32_32x32x16_bf16(b1, q_, P1_, 0, 0, 0); } } while (0)
#endif
#if MLA_FP8PV
    const int vbo8 = OFF_V + r32 * 64 + (((2 * hi) ^ (((r32 >> 2) & 1) << 1) ^ ((r32 >> 3) & 1)) << 4);
#define PV(slot) do { const char* vb_ = lds + (slot) * SLOT_V; const int vh_ = vbo8 ^ 16; if (MLA_PRIO) __builtin_amdgcn_s_setprio(1);                                                  \
        _Pragma("unroll") for (int blk = 0; blk < 4; ++blk) { const u32x4 lo_ = *reinterpret_cast<const u32x4*>(vb_ + vbo8 + blk * 2048), hi_ = *reinterpret_cast<const u32x4*>(vb_ + vh_ + blk * 2048); \
            o[blk] = __builtin_amdgcn_mfma_scale_f32_32x32x64_f8f6f4(pf8, (v8i){(int)lo_.x, (int)lo_.y, (int)lo_.z, (int)lo_.w, (int)hi_.x, (int)hi_.y, (int)hi_.z, (int)hi_.w}, o[blk], 0, 0, 0, 0, 0, 0); } \
        o[4] = __builtin_amdgcn_mfma_scale_f32_32x32x64_f8f6f4(pf8, ones8, o[4], 0, 0, 0, 0, 0, 0); if (MLA_PRIO) __builtin_amdgcn_s_setprio(0); } while (0)
#define FINISH(P0_, P1_, al_) finishSM8(P0_, P1_, pf8)
#else
#define TRRD(dst, off) asm volatile("ds_read_b64_tr_b16 %0, %1 offset:%2" : "=&v"(dst) : "v"(vbs_), "i"(off) : "memory")
#define PV_D0(d0) do { s16x4 l0, l1, l2, l3, h0, h1, h2, h3; constexpr int b_ = (d0) * 512;   \
        TRRD(l0, b_); TRRD(h0, b_ + 2048); TRRD(l1, b_ + 4096); TRRD(h1, b_ + 6144); TRRD(l2, b_ + 8192); TRRD(h2, b_ + 10240); TRRD(l3, b_ + 12288); TRRD(h3, b_ + 14336); \
        asm volatile("s_waitcnt lgkmcnt(0)" ::: "memory"); SBAR();   \
        o[d0] = __builtin_amdgcn_mfma_f32_32x32x16_bf16(pa0, (bf16x8){l0[0], l0[1], l0[2], l0[3], h0[0], h0[1], h0[2], h0[3]}, o[d0], 0, 0, 0);   \
        o[d0] = __builtin_amdgcn_mfma_f32_32x32x16_bf16(pa1, (bf16x8){l1[0], l1[1], l1[2], l1[3], h1[0], h1[1], h1[2], h1[3]}, o[d0], 0, 0, 0);   \
        o[d0] = __builtin_amdgcn_mfma_f32_32x32x16_bf16(pa2, (bf16x8){l2[0], l2[1], l2[2], l2[3], h2[0], h2[1], h2[2], h2[3]}, o[d0], 0, 0, 0);   \
        o[d0] = __builtin_amdgcn_mfma_f32_32x32x16_bf16(pa3, (bf16x8){l3[0], l3[1], l3[2], l3[3], h3[0], h3[1], h3[2], h3[3]}, o[d0], 0, 0, 0); } while (0)
#define PV(slot) do { const int vbs_ = vb0 + (slot) * SLOT_V; PV_D0(0); PV_D0(1); PV_D0(2); PV_D0(3); } while (0)
#define FINISH(P0_, P1_, al_) finishSM(P0_, P1_, al_, l_reg, pa0, pa1, pa2, pa3)
#endif
#define RESC(a) do { if (__any((a) < 1.f)) { if (hi == 0) al_l[r32] = (a); asm volatile("s_waitcnt lgkmcnt(0)" ::: "memory");              \
                     _Pragma("unroll") for (int d_ = 0; d_ < (MLA_FP8PV ? 5 : 4); ++d_) _Pragma("unroll") for (int r = 0; r < 16; ++r) o[d_][r] *= al_l[crow(r, hi)]; } } while (0)
#define MASKT(P0_, P1_, t) do { const int kb_ = (t) * KVBLK; if (kb_ + KVBLK - 1 > qlo) mask_tile(P0_, P1_, qm - kb_); } while (0)
    f32x16 pA0, pA1, pB0, pB1; float mnA, mnB, alA, alB; [[maybe_unused]] bf16x8 pa0, pa1, pa2, pa3; [[maybe_unused]] v8i pf8;
    MLA_WAITBAR(0);
    DMA_K(2, 2); DMA_V(1, 1);
    const bool late = MLA_STAGGER == 2 || (MLA_STAGGER == 1 && wid >= 4);
    SBAR(); QKT(pA0, pA1, 0); if (!late) { MASKT(pA0, pA1, 0); partialSM(pA0, pA1, m_reg, mnA, alA); }
    MLA_WAITBAR_KV();
    int s0 = 0, s1 = 1, s2 = 2;
#define HALF_STEP(PX0, PX1, mnX, alX, PY0, PY1, mnY, alY, t) do {                                                                 \
        if (late) { MASKT(PY0, PY1, (t) - 1); partialSM(PY0, PY1, m_reg, mnY, alY); RESC(alY); }                              \
        SBAR(); QKT(PX0, PX1, s1);                                                                                           \
        FINISH(PY0, PY1, alY); SBAR();                                                           \
        if ((t) + 2 < NT) DMA_K((t) + 2, s0);         \
        if ((t) + 1 < NT) DMA_V((t) + 1, s2);                                                                                 \
        SBAR();                                                                                                              \
        if (!late) { MASKT(PX0, PX1, (t)); SBAR(); PV(s0); partialSM(PX0, PX1, m_reg, mnX, alX); MLA_ILV(); SBAR();           \
        RESC(alX); } else { PV(s0); }                                                                                         \
        if ((t) + 2 < NT) MLA_WAITBAR_KV(); else if ((t) + 1 < NT) MLA_WAITBAR_V(); else MLA_WAITBAR(0);                         \
        { const int r_ = s0; s0 = s1; s1 = s2; s2 = r_; } } while (0)
    int t = 1;
    for (; t + 1 < NT; t += 2) {
        HALF_STEP(pB0, pB1, mnB, alB, pA0, pA1, mnA, alA, t);
        HALF_STEP(pA0, pA1, mnA, alA, pB0, pB1, mnB, alB, t + 1);
    }
    HALF_STEP(pB0, pB1, mnB, alB, pA0, pA1, mnA, alA, t);
    if (late) { MASKT(pB0, pB1, NT - 1); partialSM(pB0, pB1, m_reg, mnB, alB); RESC(alB); }
    FINISH(pB0, pB1, alB); SBAR(); PV(s0);
    float rli[16];
#if MLA_FP8PV
#pragma unroll
    for (int r = 0; r < 16; ++r) rli[r] = __builtin_amdgcn_rcpf(o[4][r] * V8_SCALE);
#else
    if (hi == 0) li_l[r32] = l_reg; asm volatile("s_waitcnt lgkmcnt(0)" ::: "memory");
#pragma unroll
    for (int r = 0; r < 16; ++r) rli[r] = __builtin_amdgcn_rcpf(li_l[crow(r, hi)]);
#endif
    bf16* Ow = (bf16*)(const_cast<unsigned char*>(wsb) + WS_OA) + row0 * PO + h * 128;
    unsigned oo = (unsigned)r32; asm volatile("" : "+v"(oo));
#pragma unroll
    for (int r = 0; r < 16; ++r) { const int orow = crow(r, hi);
#pragma unroll
        for (int d0 = 0; d0 < 4; ++d0) { const float v = o[d0][r] * rli[r];
            const float vn = __shfl_xor(v, 1);
            if ((r32 & 1) == 0) *(unsigned*)(Ow + orow * PO + d0 * 32 + oo) = cvtpk(v, vn); } }
    MLA_WAITBAR(0);
#undef DMA_K
#undef DMA_V
#undef QPF
#undef QKT
#undef K8F
#undef MLA_NK
#undef TRRD
#undef PV_D0
#undef PV
#undef FINISH
#undef MLA_NV
#undef RESC
#undef MASKT
#undef HALF_STEP
}
__device__ __forceinline__ void mla_phase(char* lds, int vcu, int G, const unsigned char* wsb) {
    for (int L = vcu; L < 1024; L += G) { const int bh = L >> 4, y = L & 15;
        for (int pass = 0; pass < 2; ++pass) mla_block(wsb, bh >> 5, bh & 31, pass ? 31 - y : y, lds); }
}
#undef MLA_GLDS
#undef MLA_BLDS
#undef MLA_WAITBAR
#undef SBAR
}

namespace swa {
typedef short bf16x8 __attribute__((ext_vector_type(8)));
typedef short s16x4 __attribute__((ext_vector_type(4)));
typedef float f32x16 __attribute__((ext_vector_type(16)));
typedef unsigned u32x4 __attribute__((ext_vector_type(4)));
typedef unsigned short bf16;
constexpr int OFF_K = 0, OFF_V = 24576, OFF_O = 49152, LDS_BYTES = 49152 + 8 * 8192;
__device__ __forceinline__ int v_st64(int k, int c) { const int kk = (k & ~0xC) | ((k & 4) << 1) | ((k & 8) >> 1); return ((kk >> 3) * 2 + (c >> 5)) * 512 + ((kk & 7) * 32 + (c & 31)) * 2; }
__device__ __forceinline__ int v_rd_base(int lane) { return ((lane & 3) << 3) | (((lane >> 2) & 3) << 6) | (((lane >> 4) & 1) << 5) | (((lane >> 5) & 1) << 8); }
__device__ __forceinline__ int crow(int r, int hi) { return (r & 3) + 8 * (r >> 2) + 4 * hi; }
__device__ __forceinline__ unsigned cvtpk(float lo, float hi) { unsigned r; asm volatile("v_cvt_pk_bf16_f32 %0, %1, %2" : "=v"(r) : "v"(lo), "v"(hi)); return r; }
__device__ __forceinline__ float sigm(float v) { return __builtin_amdgcn_rcpf(1.f + __builtin_amdgcn_exp2f(-v * 1.4426950408889634f)); }
typedef float f32x2v __attribute__((ext_vector_type(2)));
__device__ __forceinline__ float sigm8(float v) { return __builtin_amdgcn_rcpf(1.f + __builtin_amdgcn_exp2f(-v * (1.4426950408889634f / pg8::GATE_SCALE))); }
#define SWA_PK4(P, B_, OUT) do { unsigned a0 = cvtpk(P[B_+0], P[B_+1]), a1 = cvtpk(P[B_+2], P[B_+3]);                          \
        unsigned b0 = cvtpk(P[B_+4], P[B_+5]), b1 = cvtpk(P[B_+6], P[B_+7]);                                             \
        auto r0 = __builtin_amdgcn_permlane32_swap(a0, b0, false, false); auto r1 = __builtin_amdgcn_permlane32_swap(a1, b1, false, false); \
        u32x4 w = {r0[0], r1[0], r0[1], r1[1]}; OUT = *reinterpret_cast<bf16x8*>(&w); } while (0)
template <bool MIX_FP8>
__device__ __forceinline__ void swa_phase(float MIXS, char* lds, int vcu, int G, const bf16* ZSQ, const bf16* ZSK, const bf16* ZSV, const float* sinks,
                                          const bf16* OA, const bf16* ZA, const bf16* ZB, bf16* MIX,
                                          const float* cu, const float* cv, unsigned char* du, unsigned char* dv, float su, float sv) {
    const size_t CV_N = (size_t)2 * 16384 * 256, cv_stride = (size_t)G * 512; size_t cv_i = (size_t)blockIdx.x * 512 + threadIdx.x;
#define CV_LOAD(R, idx) do { const size_t i_ = (idx); if (cu != nullptr && i_ < CV_N) { const bool second_ = i_ >= CV_N / 2; const size_t j_ = second_ ? i_ - CV_N / 2 : i_; \
            const f32x4* p_ = (const f32x4*)((second_ ? cv : cu) + j_ * 16); R[0] = p_[0]; R[1] = p_[1]; R[2] = p_[2]; R[3] = p_[3]; } } while (0)
#define CV_STORE(R, idx) do { const size_t i_ = (idx); if (cu != nullptr && i_ < CV_N) { const bool second_ = i_ >= CV_N / 2; const size_t j_ = second_ ? i_ - CV_N / 2 : i_; const float sc_ = second_ ? sv : su; \
            const size_t e_ = j_ >> 8; const int g_ = (int)(j_ & 255), s_ = g_ >> 3, c_ = g_ & 7; u32x4 o_; int w_; \
            w_ = __builtin_amdgcn_cvt_pk_fp8_f32(R[0].x * sc_, R[0].y * sc_, 0, false); w_ = __builtin_amdgcn_cvt_pk_fp8_f32(R[0].z * sc_, R[0].w * sc_, w_, true); o_.x = (unsigned)w_; \
            w_ = __builtin_amdgcn_cvt_pk_fp8_f32(R[1].x * sc_, R[1].y * sc_, 0, false); w_ = __builtin_amdgcn_cvt_pk_fp8_f32(R[1].z * sc_, R[1].w * sc_, w_, true); o_.y = (unsigned)w_; \
            w_ = __builtin_amdgcn_cvt_pk_fp8_f32(R[2].x * sc_, R[2].y * sc_, 0, false); w_ = __builtin_amdgcn_cvt_pk_fp8_f32(R[2].z * sc_, R[2].w * sc_, w_, true); o_.z = (unsigned)w_; \
            w_ = __builtin_amdgcn_cvt_pk_fp8_f32(R[3].x * sc_, R[3].y * sc_, 0, false); w_ = __builtin_amdgcn_cvt_pk_fp8_f32(R[3].z * sc_, R[3].w * sc_, w_, true); o_.w = (unsigned)w_; \
            *(u32x4*)((second_ ? dv : du) + ((size_t)s_ * 16384 + e_) * 128 + c_ * 16) = o_; } } while (0)
    f32x4 cvA[4], cvB[4];
    const int tid0 = threadIdx.x, wid = __builtin_amdgcn_readfirstlane(tid0 >> 6);
    float* ost = (float*)(lds + OFF_O + wid * 8192);
    int tid = tid0, lane = tid & 63, r32 = lane & 31, hi = lane >> 5;
    u32x4 kvn[3], vvn[3]; bf16x8 qn[4];
#define SWA_FETCH(un) do { const int qt_ = (un) & 255, g_ = ((un) >> 8) & 7, b_ = (un) >> 11, kb_ = ((qt_ >> 1) - 2) * 64; const size_t br_ = (size_t)b_ * 8192; \
        _Pragma("unroll") for (int i = 0; i < 3; ++i) { const int idx = tid + 512 * i, key = idx >> 3, ch = idx & 7; int kpos = kb_ + key; kpos = kpos < 0 ? 0 : kpos; \
            kvn[i] = *(const u32x4*)(ZSK + (br_ + kpos) * 512 + g_ * 64 + ch * 8); vvn[i] = *(const u32x4*)(ZSV + (br_ + kpos) * 512 + g_ * 64 + ch * 8); } \
        _Pragma("unroll") for (int d0 = 0; d0 < 4; ++d0) qn[d0] = *(const bf16x8*)(ZSQ + (br_ + qt_ * 32 + r32) * 4096 + (g_ * 8 + wid) * 64 + d0 * 16 + hi * 8); } while (0)
    if (vcu < 4096) SWA_FETCH(vcu);
    for (int unit = vcu; unit < 4096; unit += G) {
        tid = tid0; asm volatile("" : "+v"(tid)); lane = tid & 63; r32 = lane & 31; hi = lane >> 5;
        const int vb0 = (int)(uintptr_t)lds + OFF_V + v_rd_base(lane);
        const int qt = unit & 255, g = (unit >> 8) & 7, b = unit >> 11, q0 = qt * 32, kbase = ((qt >> 1) - 2) * 64, hq = g * 8 + wid;
        const size_t brow = (size_t)b * 8192;
#pragma unroll
        for (int i = 0; i < 3; ++i) { const int idx = tid + 512 * i, key = idx >> 3, ch = idx & 7;
            *(u32x4*)(lds + OFF_K + key * 128 + ((ch ^ ((key >> 1) & 7)) << 4)) = kvn[i];
            *(u32x4*)(lds + OFF_V + (key >> 6) * 8192 + v_st64(key & 63, ch * 8)) = vvn[i]; }
        bf16x8 qr[4];
#pragma unroll
        for (int d0 = 0; d0 < 4; ++d0) qr[d0] = qn[d0];
        __syncthreads();
        __builtin_amdgcn_sched_barrier(0);
        if (unit + G < 4096) SWA_FETCH(unit + G);
        CV_LOAD(cvA, cv_i); CV_LOAD(cvB, cv_i + cv_stride);
        __builtin_amdgcn_sched_barrier(0);
        f32x16 p[3][2];
#pragma unroll
        for (int t = 0; t < 3; ++t)
#pragma unroll
            for (int hf = 0; hf < 2; ++hf) { f32x16 acc = {}; const int key = t * 64 + hf * 32 + r32;
#pragma unroll
                for (int d0 = 0; d0 < 4; ++d0) { const bf16x8 a = *(const bf16x8*)(lds + OFF_K + key * 128 + (((2 * d0 + hi) ^ ((key >> 1) & 7)) << 4));
                    acc = __builtin_amdgcn_mfma_f32_32x32x16_bf16(a, qr[d0], acc, 0, 0, 0); }
                p[t][hf] = acc; }
        const float slope2 = exp2f(-(float)(hq + 1) * 0.125f) * 1.4426950408889634f;
        const float sink2 = sinks[hq] * 1.4426950408889634f;
        const int qpos = q0 + r32, D0 = qpos - kbase - 4 * hi; const unsigned lim = (unsigned)(qpos + 1 < 128 ? qpos + 1 : 128);
        const float Bl = slope2 * (float)(4 * hi), sinkp = sink2 + slope2 * (float)(qpos - kbase); float mx = sinkp - Bl;
#pragma unroll
        for (int t = 0; t < 3; ++t)
#pragma unroll
            for (int hf = 0; hf < 2; ++hf)
#pragma unroll
                for (int r = 0; r < 16; ++r) { const int cst = t * 64 + hf * 32 + (r & 3) + 8 * (r >> 2);
                    const bool valid = (unsigned)(D0 - cst) < lim;
                    const float s = valid ? fmaf(slope2, (float)cst, p[t][hf][r]) : -__builtin_inff();
                    p[t][hf][r] = s; mx = fmaxf(mx, s); }
        float mxr = mx + Bl;
        { auto rr = __builtin_amdgcn_permlane32_swap(__float_as_uint(mxr), __float_as_uint(mxr), false, false); mxr = fmaxf(__uint_as_float(rr[0]), __uint_as_float(rr[1])); }
        mx = mxr - Bl;
        float ps = 0.f;
#pragma unroll
        for (int t = 0; t < 3; ++t)
#pragma unroll
            for (int hf = 0; hf < 2; ++hf)
#pragma unroll
                for (int r = 0; r < 16; ++r) { const float e = __builtin_amdgcn_exp2f(p[t][hf][r] - mx); p[t][hf][r] = e; ps += e; }
        { auto rr = __builtin_amdgcn_permlane32_swap(__float_as_uint(ps), __float_as_uint(ps), false, false); ps = __uint_as_float(rr[0]) + __uint_as_float(rr[1]); }
        const float linv = __builtin_amdgcn_rcpf(ps + __builtin_amdgcn_exp2f(sinkp - mxr));
        __builtin_amdgcn_sched_barrier(0);
        CV_STORE(cvA, cv_i); CV_STORE(cvB, cv_i + cv_stride); cv_i += 2 * cv_stride;
        CV_LOAD(cvA, cv_i); CV_LOAD(cvB, cv_i + cv_stride);
        __builtin_amdgcn_sched_barrier(0);
        f32x16 o[2] = {};
#pragma unroll
        for (int t = 0; t < 3; ++t) { bf16x8 pa[4];
            SWA_PK4(p[t][0], 0, pa[0]); SWA_PK4(p[t][0], 8, pa[1]); SWA_PK4(p[t][1], 0, pa[2]); SWA_PK4(p[t][1], 8, pa[3]);
#pragma unroll
            for (int d0 = 0; d0 < 2; ++d0) { s16x4 lo[4], hh[4];
#pragma unroll
                for (int ks = 0; ks < 4; ++ks) {
                    asm volatile("ds_read_b64_tr_b16 %0, %1 offset:%2" : "=&v"(lo[ks]) : "v"(vb0), "i"(t * 8192 + d0 * 512 + ks * 2048) : "memory");
                    asm volatile("ds_read_b64_tr_b16 %0, %1 offset:%2" : "=&v"(hh[ks]) : "v"(vb0), "i"(t * 8192 + d0 * 512 + ks * 2048 + 1024) : "memory"); }
                asm volatile("s_waitcnt lgkmcnt(0)" ::: "memory"); __builtin_amdgcn_sched_barrier(0);
#pragma unroll
                for (int ks = 0; ks < 4; ++ks)
                    o[d0] = __builtin_amdgcn_mfma_f32_32x32x16_bf16(pa[ks], (bf16x8){lo[ks][0], lo[ks][1], lo[ks][2], lo[ks][3], hh[ks][0], hh[ks][1], hh[ks][2], hh[ks][3]}, o[d0], 0, 0, 0); } }
        __builtin_amdgcn_sched_barrier(0);
        u32x4 ea[4]; [[maybe_unused]] u32x4 eza[4], ezb[4]; [[maybe_unused]] unsigned long long gza[4], gzb[4];
#pragma unroll
        for (int i = 0; i < 4; ++i) { const int idx = lane + 64 * i, row = idx >> 3, c8 = idx & 7; const size_t off = (brow + q0 + row) * 4096 + hq * 64 + c8 * 8;
            ea[i] = *(const u32x4*)(OA + off);
            if (GATE_FP8) { gza[i] = *(const unsigned long long*)((const unsigned char*)ZA + off); gzb[i] = *(const unsigned long long*)((const unsigned char*)ZB + off); }
            else { eza[i] = *(const u32x4*)(ZA + off); ezb[i] = *(const u32x4*)(ZB + off); } }
        __builtin_amdgcn_sched_barrier(0);
        if (hi == 0) ost[r32] = linv;
        asm volatile("s_waitcnt lgkmcnt(0)" ::: "memory");
        float rl[16];
#pragma unroll
        for (int r = 0; r < 16; ++r) rl[r] = ost[crow(r, hi)];
        asm volatile("s_waitcnt lgkmcnt(0)" ::: "memory"); __builtin_amdgcn_sched_barrier(0);
#pragma unroll
        for (int r = 0; r < 16; ++r)
#pragma unroll
            for (int d0 = 0; d0 < 2; ++d0) ost[crow(r, hi) * 64 + d0 * 32 + r32] = o[d0][r] * rl[r];
        asm volatile("s_waitcnt lgkmcnt(0)" ::: "memory"); __builtin_amdgcn_sched_barrier(0);
#pragma unroll
        for (int i = 0; i < 4; ++i) { const int idx = lane + 64 * i, row = idx >> 3, c8 = idx & 7;
            const f32x4 oa_ = *(const f32x4*)(ost + row * 64 + c8 * 8), ob_ = *(const f32x4*)(ost + row * 64 + c8 * 8 + 4);
            const size_t off = (brow + q0 + row) * 4096 + hq * 64 + c8 * 8;
            const u32x4 a = ea[i];
            float m[8];
            if (GATE_FP8) { const unsigned a0 = (unsigned)gza[i], a1 = (unsigned)(gza[i] >> 32), b0 = (unsigned)gzb[i], b1 = (unsigned)(gzb[i] >> 32);
                const f32x2v ga0 = __builtin_amdgcn_cvt_pk_f32_fp8((int)a0, false), ga1 = __builtin_amdgcn_cvt_pk_f32_fp8((int)a0, true), ga2 = __builtin_amdgcn_cvt_pk_f32_fp8((int)a1, false), ga3 = __builtin_amdgcn_cvt_pk_f32_fp8((int)a1, true);
                const f32x2v gb0 = __builtin_amdgcn_cvt_pk_f32_fp8((int)b0, false), gb1 = __builtin_amdgcn_cvt_pk_f32_fp8((int)b0, true), gb2 = __builtin_amdgcn_cvt_pk_f32_fp8((int)b1, false), gb3 = __builtin_amdgcn_cvt_pk_f32_fp8((int)b1, true);
                m[0] = sigm8(ga0.x) * bflo(a.x) + sigm8(gb0.x) * oa_.x; m[1] = sigm8(ga0.y) * bfhi(a.x) + sigm8(gb0.y) * oa_.y;
                m[2] = sigm8(ga1.x) * bflo(a.y) + sigm8(gb1.x) * oa_.z; m[3] = sigm8(ga1.y) * bfhi(a.y) + sigm8(gb1.y) * oa_.w;
                m[4] = sigm8(ga2.x) * bflo(a.z) + sigm8(gb2.x) * ob_.x; m[5] = sigm8(ga2.y) * bfhi(a.z) + sigm8(gb2.y) * ob_.y;
                m[6] = sigm8(ga3.x) * bflo(a.w) + sigm8(gb3.x) * ob_.z; m[7] = sigm8(ga3.y) * bfhi(a.w) + sigm8(gb3.y) * ob_.w; }
            else { const u32x4 za = eza[i], zb = ezb[i];
            m[0] = sigm(bflo(za.x)) * bflo(a.x) + sigm(bflo(zb.x)) * oa_.x; m[1] = sigm(bfhi(za.x)) * bfhi(a.x) + sigm(bfhi(zb.x)) * oa_.y;
            m[2] = sigm(bflo(za.y)) * bflo(a.y) + sigm(bflo(zb.y)) * oa_.z; m[3] = sigm(bfhi(za.y)) * bfhi(a.y) + sigm(bfhi(zb.y)) * oa_.w;
            m[4] = sigm(bflo(za.z)) * bflo(a.z) + sigm(bflo(zb.z)) * ob_.x; m[5] = sigm(bfhi(za.z)) * bfhi(a.z) + sigm(bfhi(zb.z)) * ob_.y;
            m[6] = sigm(bflo(za.w)) * bflo(a.w) + sigm(bflo(zb.w)) * ob_.z; m[7] = sigm(bfhi(za.w)) * bfhi(a.w) + sigm(bfhi(zb.w)) * ob_.w; }
            if (MIX_FP8) { int t0_ = __builtin_amdgcn_cvt_pk_fp8_f32(m[0] * MIXS, m[1] * MIXS, 0, false); t0_ = __builtin_amdgcn_cvt_pk_fp8_f32(m[2] * MIXS, m[3] * MIXS, t0_, true);
                int t1_ = __builtin_amdgcn_cvt_pk_fp8_f32(m[4] * MIXS, m[5] * MIXS, 0, false); t1_ = __builtin_amdgcn_cvt_pk_fp8_f32(m[6] * MIXS, m[7] * MIXS, t1_, true);
                *(unsigned long long*)((unsigned char*)MIX + off) = (unsigned long long)(unsigned)t0_ | ((unsigned long long)(unsigned)t1_ << 32); }
            else { u32x4 w; w.x = cvtpk(m[0], m[1]); w.y = cvtpk(m[2], m[3]); w.z = cvtpk(m[4], m[5]); w.w = cvtpk(m[6], m[7]);
                *(u32x4*)(MIX + off) = w; } }
        CV_STORE(cvA, cv_i); CV_STORE(cvB, cv_i + cv_stride); cv_i += 2 * cv_stride;
        __syncthreads();
    }
    for (; cu != nullptr && cv_i < CV_N; cv_i += cv_stride) { CV_LOAD(cvA, cv_i); CV_STORE(cvA, cv_i); }
#undef CV_LOAD
#undef CV_STORE
#undef SWA_FETCH
}
}

namespace peer {
typedef short bf16x8 __attribute__((ext_vector_type(8)));
typedef float f32x16 __attribute__((ext_vector_type(16)));
typedef unsigned u32x4 __attribute__((ext_vector_type(4)));
typedef unsigned short bf16;
constexpr int OFF_E = 0, OFF_G = 16384, LDS_BYTES = 32768;
__device__ __forceinline__ int crow(int r, int hi) { return (r & 3) + 8 * (r >> 2) + 4 * hi; }
__device__ __forceinline__ unsigned mono(float f) { const unsigned u = __float_as_uint(f); return (u & 0x80000000u) ? ~u : (u | 0x80000000u); }
__device__ __forceinline__ float unmono(unsigned k) { return __uint_as_float((k & 0x80000000u) ? (k & 0x7fffffffu) : ~k); }
__device__ __forceinline__ unsigned umax(unsigned a, unsigned b) { return a > b ? a : b; }
__device__ __forceinline__ unsigned umin(unsigned a, unsigned b) { return a < b ? a : b; }
template <int N> __device__ __forceinline__ void bitonic_sort_desc(unsigned* v) {
#pragma unroll
    for (int k = 2; k <= N; k <<= 1)
#pragma unroll
        for (int j = k >> 1; j > 0; j >>= 1)
#pragma unroll
            for (int i = 0; i < N; ++i) { const int l = i ^ j;
                if (l > i) { const unsigned x = v[i], y = v[l]; const bool desc = ((i & k) == 0);
                    v[i] = desc ? umax(x, y) : umin(x, y); v[l] = desc ? umin(x, y) : umax(x, y); } }
}
template <int N> __device__ __forceinline__ void bitonic_merge_desc(unsigned* v) {
#pragma unroll
    for (int j = N >> 1; j > 0; j >>= 1)
#pragma unroll
        for (int i = 0; i < N; ++i) { const int l = i ^ j; if (l > i) { const unsigned x = v[i], y = v[l]; v[i] = umax(x, y); v[l] = umin(x, y); } }
}
__device__ __forceinline__ void merge_top16(unsigned* a, const unsigned* b) {
#pragma unroll
    for (int i = 0; i < 16; ++i) a[i] = umax(a[i], b[15 - i]);
    bitonic_merge_desc<16>(a);
}
__device__ __forceinline__ void top16_of_64(unsigned (&k)[64]) {
    bitonic_sort_desc<16>(k); bitonic_sort_desc<16>(k + 16); bitonic_sort_desc<16>(k + 32); bitonic_sort_desc<16>(k + 48);
    merge_top16(k, k + 16); merge_top16(k + 32, k + 48); merge_top16(k, k + 32);
}
__device__ __forceinline__ void top16_pair(unsigned (&k)[64], unsigned (&out)[16]) {
    top16_of_64(k);
    unsigned pb[16];
#pragma unroll
    for (int i = 0; i < 16; ++i) pb[i] = (unsigned)__shfl_xor((int)k[i], 32);
    merge_top16(k, pb);
#pragma unroll
    for (int i = 0; i < 16; ++i) out[i] = k[i];
}
__device__ __forceinline__ float gelu_erf(float v) { return 0.5f * v * (1.0f + erff(v * 0.70710678118654752f)); }


__device__ __forceinline__ void peer_topk(int vcu, int G, const bf16* PQ, const bf16* SUBK, int* EXP, float* GATE) {
    const int tid = threadIdx.x, wid = __builtin_amdgcn_readfirstlane(tid >> 6), lane0 = tid & 63;
    for (int tile = vcu; tile < 512; tile += G) {
        const int t0 = tile * 32;
        int lane = lane0; asm volatile("" : "+v"(lane));
        const int r32 = lane & 31, hi = lane >> 5;
        const int h = wid; unsigned la[16], lb[16];
        const int koff = r32 * 128 + hi * 8;
#pragma unroll
        for (int p = 0; p < 2; ++p) {
            bf16x8 q[8];
#pragma unroll
            for (int ks = 0; ks < 8; ++ks) q[ks] = *(const bf16x8*)(PQ + (size_t)(t0 + r32) * 2048 + (h * 2 + p) * 128 + ks * 16 + hi * 8);
            unsigned k[64];
#pragma unroll
            for (int blk = 0; blk < 4; ++blk) { f32x16 acc = {};
#pragma unroll
                for (int ks = 0; ks < 8; ++ks) { const bf16x8 a = *(const bf16x8*)(SUBK + ((h * 2 + p) * 128 + blk * 32) * 128 + ks * 16 + koff);
                    acc = __builtin_amdgcn_mfma_f32_32x32x16_bf16(a, q[ks], acc, 0, 0, 0); }
#pragma unroll
                for (int r = 0; r < 16; ++r) { const int n = blk * 32 + crow(r, hi); k[blk * 16 + r] = (mono(acc[r]) & ~0x7fu) | (unsigned)(127 - n); } }
            if (p == 0) top16_pair(k, la); else top16_pair(k, lb);
        }
        float va[16], vb[16];
#pragma unroll
        for (int i = 0; i < 16; ++i) { va[i] = unmono(la[i] & ~0x7fu); vb[i] = unmono(lb[i] & ~0x7fu); }
#define CKEY(i, j) ((mono(va[i] + vb[j]) & ~0xffu) | (unsigned)(255 - ((i) * 16 + (j))))
        unsigned c[16], cb[16], cc[16];
#pragma unroll
        for (int j = 0; j < 16; ++j) c[j] = CKEY(0, j);
#pragma unroll
        for (int j = 0; j < 8; ++j) { cb[j] = CKEY(1, j); cb[8 + j] = CKEY(15 - j, 0); }
        bitonic_merge_desc<16>(cb);
        merge_top16(c, cb);
        cc[0] = CKEY(2, 0); cc[1] = CKEY(2, 1); cc[2] = CKEY(2, 2); cc[3] = CKEY(2, 3); cc[4] = CKEY(2, 4); cc[5] = CKEY(3, 0); cc[6] = CKEY(3, 1); cc[7] = CKEY(3, 2); cc[8] = CKEY(3, 3);
        cc[9] = CKEY(4, 0); cc[10] = CKEY(4, 1); cc[11] = CKEY(4, 2); cc[12] = CKEY(5, 0); cc[13] = CKEY(5, 1); cc[14] = CKEY(6, 0); cc[15] = CKEY(6, 1);
        bitonic_sort_desc<16>(cc);
        merge_top16(c, cc);
        { const unsigned d0 = CKEY(7, 0), d1 = CKEY(7, 1), a = c[14], b = c[15]; c[14] = umax(a, d0); c[15] = umax(umin(a, d0), umax(b, d1)); }
#undef CKEY
        unsigned ia[4], ib[4];
#pragma unroll
        for (int w = 0; w < 4; ++w) { ia[w] = 0u; ib[w] = 0u;
#pragma unroll
            for (int e = 0; e < 4; ++e) { ia[w] |= (127u - (la[4 * w + e] & 0x7fu)) << (8 * e); ib[w] |= (127u - (lb[4 * w + e] & 0x7fu)) << (8 * e); } }
        float bs[16]; int be[16];
#pragma unroll
        for (int kk = 0; kk < 16; ++kk) {
            const unsigned m = c[kk];
            const unsigned code = 255u - (m & 0xffu), ci = code >> 4, cj = code & 15u;
            const unsigned wa = (ci < 8u) ? ((ci < 4u) ? ia[0] : ia[1]) : ((ci < 12u) ? ia[2] : ia[3]);
            const unsigned wb = (cj < 8u) ? ((cj < 4u) ? ib[0] : ib[1]) : ((cj < 12u) ? ib[2] : ib[3]);
            const unsigned i1 = (wa >> ((ci & 3u) * 8u)) & 0xffu, i2 = (wb >> ((cj & 3u) * 8u)) & 0xffu;
            bs[kk] = unmono(m & ~0xffu);
            be[kk] = (int)(i1 * 128u + i2);
        }
        float mx = bs[0];
#pragma unroll
        for (int kk = 1; kk < 16; ++kk) mx = fmaxf(mx, bs[kk]);
        float sum = 0.f;
#pragma unroll
        for (int kk = 0; kk < 16; ++kk) { bs[kk] = __expf(bs[kk] - mx); sum += bs[kk]; }
        const float inv = 1.0f / sum;
        if (hi == 0) { int* ep = EXP + (size_t)(t0 + r32) * 128 + h * 16; float* gp = GATE + (size_t)(t0 + r32) * 128 + h * 16;
#pragma unroll
            for (int q4 = 0; q4 < 4; ++q4) { *(u32x4*)(ep + 4 * q4) = (u32x4){(unsigned)be[4 * q4], (unsigned)be[4 * q4 + 1], (unsigned)be[4 * q4 + 2], (unsigned)be[4 * q4 + 3]};
                *(f32x4*)(gp + 4 * q4) = (f32x4){bs[4 * q4] * inv, bs[4 * q4 + 1] * inv, bs[4 * q4 + 2] * inv, bs[4 * q4 + 3] * inv}; } }
    }
}
struct Census { int xi, nx, rank, nloc; };
__device__ __forceinline__ unsigned cen_ld(unsigned* p) { return __hip_atomic_load(p, __ATOMIC_RELAXED, __HIP_MEMORY_SCOPE_AGENT); }
__device__ __forceinline__ void census_post(unsigned* cen, volatile __attribute__((address_space(3))) unsigned* misc) {
    if (threadIdx.x == 0) { const unsigned x = (unsigned)__builtin_amdgcn_s_getreg((3 << 11) | 20) & 0xFu;
        misc[0] = x; misc[1] = __hip_atomic_fetch_add(cen + 64 * x, 1u, __ATOMIC_RELAXED, __HIP_MEMORY_SCOPE_AGENT); }
}
__device__ __forceinline__ Census census_complete(unsigned* cen, volatile __attribute__((address_space(3))) unsigned* misc) {
    if (threadIdx.x == 0) { const unsigned G = gridDim.x, x = misc[0]; unsigned sum = 0, cnt = 0, mine = 1, before = 0;
        for (unsigned sp = 0; sp < (1u << 20); ++sp) { sum = 0; cnt = 0; before = 0;
#pragma unroll
            for (unsigned j = 0; j < 16; ++j) { const unsigned c = cen_ld(cen + 64 * j); sum += c; cnt += c > 0u ? 1u : 0u; before += (j < x && c > 0u) ? 1u : 0u; mine = (j == x) ? c : mine; }
            if (sum == G) break; __builtin_amdgcn_s_sleep(2); }
        misc[2] = before; misc[3] = cnt > 0u ? cnt : 1u; misc[4] = mine > 0u ? mine : 1u; }
    __syncthreads();
    Census z; z.xi = (int)misc[2]; z.nx = (int)misc[3]; z.rank = (int)misc[1]; z.nloc = (int)misc[4];
    z.xi = __builtin_amdgcn_readfirstlane(z.xi); z.nx = __builtin_amdgcn_readfirstlane(z.nx); z.rank = __builtin_amdgcn_readfirstlane(z.rank); z.nloc = __builtin_amdgcn_readfirstlane(z.nloc);
    return z;
}
__device__ __forceinline__ float dpp_sum8(float v) {
    v += __builtin_bit_cast(float, __builtin_amdgcn_update_dpp(0, __builtin_bit_cast(int, v), 0xB1, 0xf, 0xf, true));
    v += __builtin_bit_cast(float, __builtin_amdgcn_update_dpp(0, __builtin_bit_cast(int, v), 0x4E, 0xf, 0xf, true));
    v += __builtin_bit_cast(float, __builtin_amdgcn_update_dpp(0, __builtin_bit_cast(int, v), 0x141, 0xf, 0xf, true));
    return v;
}
__device__ __forceinline__ void swap32(float& x, float& y) { auto r = __builtin_amdgcn_permlane32_swap(__float_as_uint(x), __float_as_uint(y), false, false); x = __uint_as_float(r[0]); y = __uint_as_float(r[1]); }
__device__ __forceinline__ void swap16(float& x, float& y) { auto r = __builtin_amdgcn_permlane16_swap(__float_as_uint(x), __float_as_uint(y), false, false); x = __uint_as_float(r[0]); y = __uint_as_float(r[1]); }
__device__ __forceinline__ float ror8_add(float v) { return v + __builtin_bit_cast(float, __builtin_amdgcn_update_dpp(0, __builtin_bit_cast(int, v), 0x128, 0xf, 0xf, true)); }
__device__ __forceinline__ void reduce_hi3(float (&v)[16]) {
#pragma unroll
    for (int k = 0; k < 8; ++k) { swap32(v[k], v[k + 8]); v[k] += v[k + 8]; }
#pragma unroll
    for (int k = 0; k < 4; ++k) { swap16(v[k], v[k + 4]); v[k] += v[k + 4]; }
#pragma unroll
    for (int k = 0; k < 4; ++k) v[k] = ror8_add(v[k]);
}
__device__ __forceinline__ void peer_u(const Census cz, const bf16* H2, const bf16* US, const int* EXP, float* PX) {
    const int tid = threadIdx.x, wid = __builtin_amdgcn_readfirstlane(tid >> 6), lane0 = tid & 63;
    const int wi = cz.rank * 8 + wid, NWV = cz.nloc * 8;
    float* PXx = PX + (size_t)cz.xi * (16384 * 128);
    int pass = 0;
    for (int s = cz.xi; s < 64; s += cz.nx, ++pass) {
        const unsigned char* Us = (const unsigned char*)US + (size_t)s * (16384 * 128);
        for (int t = wi; t < 16384; t += NWV) {
            int lane = lane0; asm volatile("" : "+v"(lane));
            const int e8 = lane >> 3, c = lane & 7;
            const u32x4* ip = (const u32x4*)(EXP + (size_t)t * 128 + e8 * 16);
            const u32x4 i0 = ip[0], i1 = ip[1], i2 = ip[2], i3 = ip[3];
            const u32x4 xv = *(const u32x4*)(H2 + (size_t)t * 4096 + s * 64 + c * 8);
            float* pp = PXx + (size_t)t * 128 + e8 * 16;
            f32x4 o0 = {0.f, 0.f, 0.f, 0.f}, o1 = o0, o2 = o0, o3 = o0;
            if (pass != 0 && c == 0) { o0 = *(const f32x4*)pp; o1 = *(const f32x4*)(pp + 4); o2 = *(const f32x4*)(pp + 8); o3 = *(const f32x4*)(pp + 12); }
            const unsigned ids[16] = {i0.x, i0.y, i0.z, i0.w, i1.x, i1.y, i1.z, i1.w, i2.x, i2.y, i2.z, i2.w, i3.x, i3.y, i3.z, i3.w};
            u32x4 uv[16];
#pragma unroll
            for (int i = 0; i < 16; ++i) uv[i] = *(const u32x4*)(Us + (ids[i] * 128u + (unsigned)c * 16u));
            float d[16];
#pragma unroll
            for (int i = 0; i < 16; ++i) { float a = dot2bf(uv[i].x, xv.x, 0.f); a = dot2bf(uv[i].y, xv.y, a); a = dot2bf(uv[i].z, xv.z, a); a = dot2bf(uv[i].w, xv.w, a); d[i] = dpp_sum8(a); }
            if (c == 0) {
                *(f32x4*)pp = (f32x4){o0.x + d[0], o0.y + d[1], o0.z + d[2], o0.w + d[3]}; *(f32x4*)(pp + 4) = (f32x4){o1.x + d[4], o1.y + d[5], o1.z + d[6], o1.w + d[7]};
                *(f32x4*)(pp + 8) = (f32x4){o2.x + d[8], o2.y + d[9], o2.z + d[10], o2.w + d[11]}; *(f32x4*)(pp + 12) = (f32x4){o3.x + d[12], o3.y + d[13], o3.z + d[14], o3.w + d[15]}; }
        }
    }
}
__device__ __forceinline__ void peer_act(int nx, const float* PX, const float* GATE, float* AV, float dscale, float ascale) {
    const size_t n4 = (size_t)16384 * 128 / 4, nthr = (size_t)gridDim.x * 512;
    for (size_t i = (size_t)blockIdx.x * 512 + threadIdx.x; i < n4; i += nthr) { f32x4 s = *(const f32x4*)(PX + 4 * i);
        for (int x = 1; x < nx; ++x) s += *(const f32x4*)(PX + (size_t)x * (16384 * 128) + 4 * i);
        const f32x4 g = *(const f32x4*)(GATE + 4 * i);
        s = s * dscale;
        *(f32x4*)(AV + 4 * i) = (f32x4){gelu_erf(s.x) * g.x * ascale, gelu_erf(s.y) * g.y * ascale, gelu_erf(s.z) * g.z * ascale, gelu_erf(s.w) * g.w * ascale}; }
}
__device__ __forceinline__ void peer_v(const Census cz, const bf16* VS, const int* EXP, const float* AV, bf16* Y, float* RS) {
    const int tid = threadIdx.x, wid = __builtin_amdgcn_readfirstlane(tid >> 6), lane0 = tid & 63;
    const int wi = cz.rank * 8 + wid, NWV = cz.nloc * 8;
    for (int s = cz.xi; s < 64; s += cz.nx) {
        const unsigned char* Vs = (const unsigned char*)VS + (size_t)s * (16384 * 128);
        for (int t = wi; t < 16384; t += NWV) {
            int lane = lane0; asm volatile("" : "+v"(lane));
            const int e8 = lane >> 3, c = lane & 7;
            const u32x4* ip = (const u32x4*)(EXP + (size_t)t * 128 + e8 * 16);
            const u32x4 i0 = ip[0], i1 = ip[1], i2 = ip[2], i3 = ip[3];
            const f32x4* ap = (const f32x4*)(AV + (size_t)t * 128 + e8 * 16);
            const f32x4 a0 = ap[0], a1 = ap[1], a2 = ap[2], a3 = ap[3];
            const unsigned ids[16] = {i0.x, i0.y, i0.z, i0.w, i1.x, i1.y, i1.z, i1.w, i2.x, i2.y, i2.z, i2.w, i3.x, i3.y, i3.z, i3.w};
            const float av[16] = {a0.x, a0.y, a0.z, a0.w, a1.x, a1.y, a1.z, a1.w, a2.x, a2.y, a2.z, a2.w, a3.x, a3.y, a3.z, a3.w};
            u32x4 vv[16];
#pragma unroll
            for (int i = 0; i < 16; ++i) vv[i] = *(const u32x4*)(Vs + (ids[i] * 128u + (unsigned)c * 16u));
            float acc[8] = {0.f, 0.f, 0.f, 0.f, 0.f, 0.f, 0.f, 0.f};
#pragma unroll
            for (int i = 0; i < 16; ++i) { const float a = av[i];
                acc[0] += a * bflo(vv[i].x); acc[1] += a * bfhi(vv[i].x); acc[2] += a * bflo(vv[i].y); acc[3] += a * bfhi(vv[i].y);
                acc[4] += a * bflo(vv[i].z); acc[5] += a * bfhi(vv[i].z); acc[6] += a * bflo(vv[i].w); acc[7] += a * bfhi(vv[i].w); }
#pragma unroll
            for (int e = 0; e < 8; ++e) { acc[e] += __shfl_xor(acc[e], 8); acc[e] += __shfl_xor(acc[e], 16); acc[e] += __shfl_xor(acc[e], 32); }
            float ss = 0.f;
#pragma unroll
            for (int e = 0; e < 8; ++e) ss += acc[e] * acc[e];
            ss = dpp_sum8(ss);
            if (e8 == 0) { u32x4 w; w.x = cvtpk(acc[0], acc[1]); w.y = cvtpk(acc[2], acc[3]); w.z = cvtpk(acc[4], acc[5]); w.w = cvtpk(acc[6], acc[7]);
                *(u32x4*)(Y + (size_t)t * 4096 + s * 64 + c * 8) = w;
                if (c == 0) RS[(size_t)t * 64 + s] = ss; }
        }
    }
}
__device__ __forceinline__ void peer_final(LAS unsigned char* lds, int vcu, int G, const float* x, const bf16* T, const float* RSQ, const bf16* Y, const float* RS, int nslices, const float* ada, const float* g_apost, const float* g_post, float* out, const bf16* X1) {
    const int tid = threadIdx.x, wid = __builtin_amdgcn_readfirstlane(tid >> 6), lane0 = tid & 63;
    LAS f32x4* L = (LAS f32x4*)lds;
    for (int k = tid; k < 2048; k += 512) { const int b = k >> 10, q = k & 1023, slot = ((q >> 7) * 2 + (q & 1)) * 64 + ((q >> 1) & 63);
        const f32x4 a = *(const f32x4*)(ada + b * 24576 + 2 * 4096 + 4 * q), h = *(const f32x4*)(g_apost + 4 * q), f = *(const f32x4*)(ada + b * 24576 + 5 * 4096 + 4 * q), g = *(const f32x4*)(g_post + 4 * q);
        L[b * 2048 + slot] = a * h; L[b * 2048 + 1024 + slot] = f * g; }
    __syncthreads();
    for (int tok = vcu * 8 + wid; tok < 16384; tok += G * 8) { const int b = tok >> 13;
        int lane = lane0; asm volatile("" : "+v"(lane));
        const float rs = lane < nslices ? RS[(size_t)tok * 64 + lane] : 0.f;
        const u32x4* Yr = (const u32x4*)(Y + (size_t)tok * 4096) + lane;
        const LAS f32x4* Lb = L + b * 2048 + lane; f32x4* orow = (f32x4*)(out + (size_t)tok * 4096) + 2 * lane;
        if (X1_BF16) {
            const u32x4* Xr = (const u32x4*)(X1 + (size_t)tok * 4096) + lane;
            u32x4 y[8], r[8];
#pragma unroll
            for (int i = 0; i < 8; ++i) { y[i] = Yr[64 * i]; r[i] = Xr[64 * i]; }
            __builtin_amdgcn_sched_barrier(0);
            const float rstd = 1.0f / sqrtf(wave_sum(rs) * (1.f / 4096.f) + 1e-6f);
#pragma unroll
            for (int i = 0; i < 8; ++i) {
                f32x4 r0, r1, y0, y1; r0.x = bflo(r[i].x); r0.y = bfhi(r[i].x); r0.z = bflo(r[i].y); r0.w = bfhi(r[i].y); r1.x = bflo(r[i].z); r1.y = bfhi(r[i].z); r1.z = bflo(r[i].w); r1.w = bfhi(r[i].w);
                y0.x = bflo(y[i].x); y0.y = bfhi(y[i].x); y0.z = bflo(y[i].y); y0.w = bfhi(y[i].y); y1.x = bflo(y[i].z); y1.y = bfhi(y[i].z); y1.z = bflo(y[i].w); y1.w = bfhi(y[i].w);
                orow[128 * i] = r0 + Lb[1024 + 128 * i] * (y0 * rstd); orow[128 * i + 1] = r1 + Lb[1024 + 128 * i + 64] * (y1 * rstd); }
            continue; }
        const float rq = RSQ[(size_t)tok * 64 + lane];
        const u32x4* Tr = (const u32x4*)(T + (size_t)tok * 4096) + lane; const f32x4* xr = (const f32x4*)(x + (size_t)tok * 4096) + 2 * lane;
        u32x4 y[8], t[8]; f32x4 xx[16];
#pragma unroll
        for (int i = 0; i < 8; ++i) { y[i] = Yr[64 * i]; t[i] = Tr[64 * i]; }
#pragma unroll
        for (int i = 0; i < 8; ++i) { xx[2 * i] = xr[128 * i]; xx[2 * i + 1] = xr[128 * i + 1]; }
        __builtin_amdgcn_sched_barrier(0);
        const float rstd = 1.0f / sqrtf(wave_sum(rs) * (1.f / 4096.f) + 1e-6f);
        const float rstdT = 1.0f / sqrtf(wave_sum(rq) * (1.f / 4096.f) + 1e-6f);
#pragma unroll
        for (int i = 0; i < 8; ++i) {
            f32x4 t0, t1, y0, y1; t0.x = bflo(t[i].x); t0.y = bfhi(t[i].x); t0.z = bflo(t[i].y); t0.w = bfhi(t[i].y); t1.x = bflo(t[i].z); t1.y = bfhi(t[i].z); t1.z = bflo(t[i].w); t1.w = bfhi(t[i].w);
            y0.x = bflo(y[i].x); y0.y = bfhi(y[i].x); y0.z = bflo(y[i].y); y0.w = bfhi(y[i].y); y1.x = bflo(y[i].z); y1.y = bfhi(y[i].z); y1.z = bflo(y[i].w); y1.w = bfhi(y[i].w);
            const f32x4 o0 = (xx[2 * i] + Lb[128 * i] * (t0 * rstdT)) + Lb[1024 + 128 * i] * (y0 * rstd);
            const f32x4 o1 = (xx[2 * i + 1] + Lb[128 * i + 64] * (t1 * rstdT)) + Lb[1024 + 128 * i + 64] * (y1 * rstd);
            orow[128 * i] = o0; orow[128 * i + 1] = o1; }
    }
}
typedef float f32x2v __attribute__((ext_vector_type(2)));
constexpr float U_SCALE = 1024.f, V_SCALE = 128.f;
__device__ __forceinline__ float dpp_x1(float v) { return __builtin_bit_cast(float, __builtin_amdgcn_update_dpp(0, __builtin_bit_cast(int, v), 0xB1, 0xf, 0xf, true)); }
__device__ __forceinline__ float dpp_x2(float v) { return __builtin_bit_cast(float, __builtin_amdgcn_update_dpp(0, __builtin_bit_cast(int, v), 0x4E, 0xf, 0xf, true)); }
__device__ __forceinline__ float dpp_x4(float v) { int t = __builtin_amdgcn_update_dpp(0, __builtin_bit_cast(int, v), 0x104, 0xf, 0x5, false);
    t = __builtin_amdgcn_update_dpp(t, __builtin_bit_cast(int, v), 0x114, 0xf, 0xa, false); return __builtin_bit_cast(float, t); }
__device__ __forceinline__ void reduce8_t(const float (&d)[16], int c, float& r0, float& r1) {
    const bool b0 = (c & 1) != 0, b1 = (c & 2) != 0, b2 = (c & 4) != 0;
    float a[8], b[4];
#pragma unroll
    for (int j = 0; j < 8; ++j) a[j] = (b0 ? d[2 * j + 1] : d[2 * j]) + dpp_x1(b0 ? d[2 * j] : d[2 * j + 1]);
#pragma unroll
    for (int k = 0; k < 4; ++k) b[k] = (b1 ? a[2 * k + 1] : a[2 * k]) + dpp_x2(b1 ? a[2 * k] : a[2 * k + 1]);
    r0 = (b2 ? b[1] : b[0]) + dpp_x4(b2 ? b[0] : b[1]);
    r1 = (b2 ? b[3] : b[2]) + dpp_x4(b2 ? b[2] : b[3]);
}
__device__ __forceinline__ void peer_u8(const Census cz, const bf16* H2, const unsigned char* US, const int* EXP, float* PX) {
    const int tid = threadIdx.x, wid = __builtin_amdgcn_readfirstlane(tid >> 6), lane0 = tid & 63;
    const int wi = cz.rank * 8 + wid, NWV = cz.nloc * 8;
    float* PXx = PX + (size_t)cz.xi * (16384 * 128);
    int pass = 0;
    for (int s = cz.xi; s < 32; s += cz.nx, ++pass) {
        const unsigned char* Us = US + (size_t)s * (16384 * 128);
        int lane = lane0; asm volatile("" : "+v"(lane));
        const int e8 = lane >> 3, c = lane & 7;
        u32x4 i0, i1, i2, i3, xa, xb; float q0 = 0.f, q1 = 0.f;
#define U8_FETCH(tt) do { const u32x4* ip_ = (const u32x4*)(EXP + (size_t)(tt) * 128 + e8 * 16); i0 = ip_[0]; i1 = ip_[1]; i2 = ip_[2]; i3 = ip_[3]; \
            const bf16* xp_ = H2 + (size_t)(tt) * 4096 + s * 128 + c * 16; xa = *(const u32x4*)xp_; xb = *(const u32x4*)(xp_ + 8); \
            if (pass != 0) { const float* pp_ = PXx + (size_t)(tt) * 128 + e8 * 16 + c; q0 = pp_[0]; q1 = pp_[8]; } } while (0)
        if (wi < 16384) U8_FETCH(wi);
        for (int t = wi; t < 16384; t += NWV) {
            const unsigned ids[16] = {i0.x, i0.y, i0.z, i0.w, i1.x, i1.y, i1.z, i1.w, i2.x, i2.y, i2.z, i2.w, i3.x, i3.y, i3.z, i3.w};
            u32x4 uv[16];
#pragma unroll
            for (int i = 0; i < 16; ++i) uv[i] = *(const u32x4*)(Us + (ids[i] * 128u + (unsigned)c * 16u));
            const f32x2v xp[8] = {{bflo(xa.x), bfhi(xa.x)}, {bflo(xa.y), bfhi(xa.y)}, {bflo(xa.z), bfhi(xa.z)}, {bflo(xa.w), bfhi(xa.w)},
                                  {bflo(xb.x), bfhi(xb.x)}, {bflo(xb.y), bfhi(xb.y)}, {bflo(xb.z), bfhi(xb.z)}, {bflo(xb.w), bfhi(xb.w)}};
            const float p0 = q0, p1 = q1;
            __builtin_amdgcn_sched_barrier(0);
            if (t + NWV < 16384) U8_FETCH(t + NWV);
            __builtin_amdgcn_sched_barrier(0);
            float d[16];
#pragma unroll
            for (int g = 0; g < 4; ++g) { f32x2v a2[4];
#pragma unroll
                for (int q = 0; q < 4; ++q) {
#pragma unroll
                    for (int k = 0; k < 4; ++k) { const int i = 4 * g + k; const unsigned w = q == 0 ? uv[i].x : q == 1 ? uv[i].y : q == 2 ? uv[i].z : uv[i].w;
                        const f32x2v lo = __builtin_amdgcn_cvt_pk_f32_fp8((int)w, false); a2[k] = q == 0 ? lo * xp[0] : __builtin_elementwise_fma(lo, xp[2 * q], a2[k]); }
                    __builtin_amdgcn_sched_barrier(0);
#pragma unroll
                    for (int k = 0; k < 4; ++k) { const int i = 4 * g + k; const unsigned w = q == 0 ? uv[i].x : q == 1 ? uv[i].y : q == 2 ? uv[i].z : uv[i].w;
                        const f32x2v hi = __builtin_amdgcn_cvt_pk_f32_fp8((int)w, true); a2[k] = __builtin_elementwise_fma(hi, xp[2 * q + 1], a2[k]); }
                    __builtin_amdgcn_sched_barrier(0); }
#pragma unroll
                for (int k = 0; k < 4; ++k) d[4 * g + k] = a2[k].x + a2[k].y; }
            float r0, r1; reduce8_t(d, c, r0, r1);
            { float* pp = PXx + (size_t)t * 128 + e8 * 16 + c; pp[0] = p0 + r0; pp[8] = p1 + r1; }
        }
#undef U8_FETCH
    }
}
__device__ __forceinline__ void peer_v8(const Census cz, const unsigned char* VS, const int* EXP, const float* AV, bf16* Y, float* RS) {
    const int tid = threadIdx.x, wid = __builtin_amdgcn_readfirstlane(tid >> 6), lane0 = tid & 63;
    const int wi = cz.rank * 8 + wid, NWV = cz.nloc * 8;
    for (int s = cz.xi; s < 32; s += cz.nx) {
        const unsigned char* Vs = VS + (size_t)s * (16384 * 128);
        int lane = lane0; asm volatile("" : "+v"(lane));
        const int e8 = lane >> 3, c = lane & 7;
        u32x4 i0, i1, i2, i3; f32x4 a0, a1, a2, a3;
#define V8_FETCH(tt) do { const u32x4* ip_ = (const u32x4*)(EXP + (size_t)(tt) * 128 + e8 * 16); i0 = ip_[0]; i1 = ip_[1]; i2 = ip_[2]; i3 = ip_[3]; \
            const f32x4* ap_ = (const f32x4*)(AV + (size_t)(tt) * 128 + e8 * 16); a0 = ap_[0]; a1 = ap_[1]; a2 = ap_[2]; a3 = ap_[3]; } while (0)
        if (wi < 16384) V8_FETCH(wi);
        for (int t = wi; t < 16384; t += NWV) {
            const unsigned ids[16] = {i0.x, i0.y, i0.z, i0.w, i1.x, i1.y, i1.z, i1.w, i2.x, i2.y, i2.z, i2.w, i3.x, i3.y, i3.z, i3.w};
            const float av[16] = {a0.x, a0.y, a0.z, a0.w, a1.x, a1.y, a1.z, a1.w, a2.x, a2.y, a2.z, a2.w, a3.x, a3.y, a3.z, a3.w};
            u32x4 vv[16];
#pragma unroll
            for (int i = 0; i < 16; ++i) vv[i] = *(const u32x4*)(Vs + (ids[i] * 128u + (unsigned)c * 16u));
            __builtin_amdgcn_sched_barrier(0);
            if (t + NWV < 16384) V8_FETCH(t + NWV);
            __builtin_amdgcn_sched_barrier(0);
            f32x2v ac2[8];
#pragma unroll
            for (int i = 0; i < 16; ++i) { const f32x2v a2 = {av[i], av[i]}; const unsigned w[4] = {vv[i].x, vv[i].y, vv[i].z, vv[i].w};
#pragma unroll
                for (int q = 0; q < 4; ++q) { const f32x2v lo = __builtin_amdgcn_cvt_pk_f32_fp8((int)w[q], false), hi = __builtin_amdgcn_cvt_pk_f32_fp8((int)w[q], true);
                    ac2[2 * q] = i == 0 ? a2 * lo : __builtin_elementwise_fma(a2, lo, ac2[2 * q]); ac2[2 * q + 1] = i == 0 ? a2 * hi : __builtin_elementwise_fma(a2, hi, ac2[2 * q + 1]); } }
            float acc[16];
#pragma unroll
            for (int e = 0; e < 8; ++e) { acc[2 * e] = ac2[e].x; acc[2 * e + 1] = ac2[e].y; }
            reduce_hi3(acc);
            float ss = (acc[0] * acc[0] + acc[1] * acc[1]) + (acc[2] * acc[2] + acc[3] * acc[3]);
            ss = dpp_sum8(ss);
            { float s2 = ss; swap16(ss, s2); ss += s2; s2 = ss; swap32(ss, s2); ss += s2; }
            if ((e8 & 1) == 0) { const int q4 = 4 * ((e8 >> 1) & 1) + 8 * (e8 >> 2);
                *(unsigned long long*)(Y + (size_t)t * 4096 + s * 128 + c * 16 + q4) = (unsigned long long)cvtpk(acc[0], acc[1]) | ((unsigned long long)cvtpk(acc[2], acc[3]) << 32);
                if (lane == 0) RS[(size_t)t * 64 + s] = ss; }
        }
#undef V8_FETCH
    }
}
}

#ifndef PEER_FP8
#define PEER_FP8 1
#endif
#ifndef MK_N_LAUNCHES
#define MK_N_LAUNCHES 1
#endif
constexpr int N_PHASES = 16;
constexpr int N_LAUNCHES = MK_N_LAUNCHES;
struct Args { const float* in[19]; float* out; unsigned char* ws; int ph_lo, ph_hi; };
#ifndef FP8_SAT
#define FP8_SAT 1
#endif
__global__ void __launch_bounds__(NWAVES * 64, 2) hybrid_fwd(Args args) {
    extern __shared__ __attribute__((aligned(16))) unsigned char lds[];
#if FP8_SAT
    asm volatile("s_setreg_imm32_b32 hwreg(HW_REG_MODE, 23, 1), 1");
#endif
    Frame F;
    F.lds = (LAS unsigned char*)lds;
    F.MISC = (volatile LAS unsigned*)(F.lds + MISC_OFF);
    F.tid = threadIdx.x; F.lane = F.tid & 63; F.wave = __builtin_amdgcn_readfirstlane(F.tid >> 6);
    F.G = gridDim.x; { const int bx = blockIdx.x; F.vcu = (F.G % 8 == 0) ? (bx % 8) * (F.G / 8) + bx / 8 : bx; }
    F.ctl = (gu32*)(args.ws + WS_CTL);
    for (int u = F.tid; u < (LDS_BYTES - LDSCTL_OFF) / 4; u += NWAVES * 64) ((LAS unsigned*)(F.lds + LDSCTL_OFF))[u] = 0u;
    __syncthreads();
    XcdBarrier bar; bar.bar = (unsigned*)(F.ctl + CW_BAR); bar.x = 0; bar.st = nullptr;
    if (N_LAUNCHES == 1) bar = xcd_barrier_post((unsigned*)(F.ctl + CW_BAR), F.MISC + 8);
    unsigned* const cen = (unsigned*)(F.ctl + CW_CEN) + (N_LAUNCHES == 1 ? 0 : args.ph_lo * 1024);
    peer::census_post(cen, F.MISC + 16);
#define GRID_BAR() do { if (N_LAUNCHES == 1) xcd_barrier(bar); } while (0)
#ifdef PROBE_A
    unsigned long long* stamps = (unsigned long long*)(args.ws + WS_ADA + 512 * 1024);
#define STAMP(k) do { if (blockIdx.x == 0 && F.tid == 0) stamps[k] = rt(); } while (0)
#else
#define STAMP(k) do { } while (0)
#endif
    STAMP(0);
    const int lo = args.ph_lo, hi = args.ph_hi;
#ifdef ONLY_PHASE
#define PH_ON(k) ((k) == ONLY_PHASE)
#else
#define PH_ON(k) true
#endif
#define IN(k) (PH_ON(k) && lo <= (k) && (k) < hi)
#ifndef REPEAT_PHASE
#define REPEAT_PHASE -1
#endif
#define REPS(k) for (int rep_ = 0; rep_ < ((k) == REPEAT_PHASE ? 2 : 1); ++rep_)
#define BOTH(k) (IN(k) && IN((k) + 1))
    typedef const __attribute__((address_space(4))) Args* kargs_t;
    const kargs_t kap0 = (kargs_t)__builtin_amdgcn_kernarg_segment_ptr();
#define INP(i) ({ kargs_t p_ = kap0; asm volatile("" : "+s"(p_)); p_->in[i]; })
#define OUTP() ({ kargs_t p_ = kap0; asm volatile("" : "+s"(p_)); p_->out; })
#define WSP() ({ kargs_t p_ = kap0; asm volatile("" : "+s"(p_)); p_->ws; })

    if (IN(0)) { unsigned char* ws = WSP(); REPS(0) p0_prologue(F, INP(1), INP(2), INP(6), INP(8), INP(10), INP(12), INP(15), INP(16), ws); if (BOTH(0)) GRID_BAR(); STAMP(1); }
    if (IN(1)) { unsigned char* ws = WSP(); REPS(1) p1_ada_reduce(F, INP(3), ws); if (BOTH(1)) GRID_BAR(); STAMP(2); }
    if (IN(2)) { unsigned char* ws = WSP(); REPS(2) p2_modnorm(F, INP(0), INP(4), ws); if (BOTH(2)) GRID_BAR(); STAMP(3); }
    if (IN(3)) {
        unsigned char* ws = WSP();
        pg8::Gemm8 g{ws + WS_H, ws + WS_WIN, M, NZ, DM}; pg8::StaticOrder S; S.init(M, NZ, F.G, (int)blockIdx.x);
        pg8::EpiZ E{(bf16*)(ws + WS_ZQ), (bf16*)(ws + WS_ZSQ), (bf16*)(ws + WS_ZA), (bf16*)(ws + WS_ZB), (bf16*)(ws + WS_ZSK), (bf16*)(ws + WS_ZSV), (bf16*)(ws + WS_ZKV), 0.125f * LOG2E, 1.f / (H_SCALE * WIN_SCALE)};
        REPS(3) { pg8::gemm_phase8<pg8::EpiZ, pg8::StaticOrder, true, true>(F.lds + RING_OFF, g, S, E); __syncthreads(); }
        if (BOTH(3)) GRID_BAR(); STAMP(4);
    }
    if (IN(4)) { unsigned char* ws = WSP(); REPS(4) p4_latent(F, INP(7), INP(9), ws); if (BOTH(4)) GRID_BAR(); STAMP(5); }
    if (IN(5)) {
        unsigned char* ws = WSP();
        if (P5_FP8) {
#ifndef P5_SKIP_Q
          { pg8::Gemm8 g{ws + WS_ZQN, ws + WS_WQB, M, 6144, 1024}; pg8::StaticOrder S; S.init(M, 6144, F.G, (int)blockIdx.x);
            pg8::EpiQ E{(bf16*)(ws + WS_QN), (bf16*)(ws + WS_QP), (const float*)(ws + WS_ROPE), (const float*)(ws + WS_ROPE) + SEQ * 32, 1.f / (LAT_SCALE * WQB_SCALE), MLA_FP8QK ? QK8_SCALE : 0.f};
            pg8::gemm_phase8<pg8::EpiQ, pg8::StaticOrder, true, true>(F.lds + RING_OFF, g, S, E); }
#endif
          __syncthreads();
#ifndef P5_SKIP_KV
          if (MLA_FP8PV) {
            { pg8::Gemm8 g{ws + WS_CKV, ws + WS_WKVB, M, 4096, 512}; pg8::StaticOrder S; S.init(M, 4096, F.G, (int)blockIdx.x);
              pg8::EpiKV E{(bf16*)(ws + WS_KN), (bf16*)(ws + WS_VM), 1.f / (LAT_SCALE * WKVB_SCALE), QK8_SCALE};
              pg8::gemm_phase8<pg8::EpiKV, pg8::StaticOrder, true, true>(F.lds + RING_OFF, g, S, E); }
            __syncthreads();
            { pg8::Gemm8 g{ws + WS_WKVB + (size_t)4096 * 512, ws + WS_CKV, 4096, M, 512}; pg8::StaticOrder S; S.init(4096, M, F.G, (int)blockIdx.x);
              pg8::EpiVT E{ws + WS_VM, V8_SCALE / (LAT_SCALE * WKVB_SCALE)};
              pg8::gemm_phase8<pg8::EpiVT, pg8::StaticOrder, true, true>(F.lds + RING_OFF, g, S, E); }
          } else
          { pg8::Gemm8 g{ws + WS_CKV, ws + WS_WKVB, M, 8192, 512}; pg8::StaticOrder S; S.init(M, 8192, F.G, (int)blockIdx.x);
            pg8::EpiKV E{(bf16*)(ws + WS_KN), (bf16*)(ws + WS_VM), 1.f / (LAT_SCALE * WKVB_SCALE), MLA_FP8QK ? QK8_SCALE : 0.f};
            pg8::gemm_phase8<pg8::EpiKV, pg8::StaticOrder, true, true>(F.lds + RING_OFF, g, S, E); }
#endif
        } else {
          { pg8::Gemm g{(const bf16*)(ws + WS_ZQN), (const bf16*)(ws + WS_WQB), M, 6144, 1024}; pg8::StaticOrder S; S.init(M, 6144, F.G, (int)blockIdx.x);
            pg8::EpiQ E{(bf16*)(ws + WS_QN), (bf16*)(ws + WS_QP), (const float*)(ws + WS_ROPE), (const float*)(ws + WS_ROPE) + SEQ * 32, 1.f, MLA_FP8QK ? QK8_SCALE : 0.f};
            pg8::gemm_phase<pg8::EpiQ, pg8::StaticOrder, true, true>(F.lds + RING_OFF, g, S, E); }
          __syncthreads();
          { pg8::Gemm g{(const bf16*)(ws + WS_CKV), (const bf16*)(ws + WS_WKVB), M, 8192, 512}; pg8::StaticOrder S; S.init(M, 8192, F.G, (int)blockIdx.x);
            pg8::EpiKV E{(bf16*)(ws + WS_KN), (bf16*)(ws + WS_VM), 1.f, MLA_FP8QK ? QK8_SCALE : 0.f};
            pg8::gemm_phase<pg8::EpiKV, pg8::StaticOrder, true, true>(F.lds + RING_OFF, g, S, E); }
        }
        if (BOTH(5)) GRID_BAR(); STAMP(6);
    }
    if (IN(6)) {
        unsigned char* ws = WSP();
        REPS(6) { mla::mla_phase((char*)lds + RING_OFF, F.vcu, F.G, ws); __syncthreads(); }
        if (BOTH(6)) GRID_BAR(); STAMP(7);
    }
    if (IN(7)) {
        unsigned char* ws = WSP(); const float* sinks = INP(11); const float* peer_u = INP(17); const float* peer_v = INP(18);
        REPS(7) swa::swa_phase<WOUT_FP8 != 0>(MIX_SCALE, (char*)lds + RING_OFF, F.vcu, F.G, (const bf16*)(ws + WS_ZSQ), (const bf16*)(ws + WS_ZSK), (const bf16*)(ws + WS_ZSV), sinks,
                       (const bf16*)(ws + WS_OA), (const bf16*)(ws + WS_ZA), (const bf16*)(ws + WS_ZB), (bf16*)(ws + WS_H),
                       PEER_FP8 ? peer_u : nullptr, peer_v, ws + WS_UB, ws + WS_VB, peer::U_SCALE, peer::V_SCALE);
        if (!PEER_FP8) { REPS(16) convert_slices(F, peer_u, (bf16*)(ws + WS_UB)); REPS(16) convert_slices(F, peer_v, (bf16*)(ws + WS_VB)); }
        if (BOTH(7)) GRID_BAR(); STAMP(8);
    }
    if (IN(8)) {
        unsigned char* ws = WSP();
        if (WOUT_FP8) { pg8::Gemm8 g{ws + WS_H, ws + WS_WOUT, M, DM, DM}; pg8::StaticOrder S; S.init(M, DM, F.G, (int)blockIdx.x);
            pg8::EpiT E{(bf16*)(ws + WS_T), (float*)(ws + WS_RSQ), 1.f / (MIX_SCALE * WOUT_SCALE)};
            REPS(8) { pg8::gemm_phase8<pg8::EpiT, pg8::StaticOrder, true, true>(F.lds + RING_OFF, g, S, E); __syncthreads(); } }
        else { pg8::Gemm g{(const bf16*)(ws + WS_H), (const bf16*)(ws + WS_WOUT), M, DM, DM}; pg8::StaticOrder S; S.init(M, DM, F.G, (int)blockIdx.x);
            pg8::EpiT E{(bf16*)(ws + WS_T), (float*)(ws + WS_RSQ), 1.f};
            REPS(8) { pg8::gemm_phase<pg8::EpiT, pg8::StaticOrder, true, true>(F.lds + RING_OFF, g, S, E); __syncthreads(); } }
        if (BOTH(8)) GRID_BAR(); STAMP(9);
    }
    if (IN(9)) { unsigned char* ws = WSP(); REPS(9) p9_post_attn(F, INP(0), INP(5), INP(13), OUTP(), ws); if (BOTH(9)) GRID_BAR(); STAMP(10); }
    if (IN(10)) {
        unsigned char* ws = WSP();
        pg8::Gemm g{(const bf16*)(ws + WS_H), (const bf16*)(ws + WS_WPQ), M, 2048, DM}; pg8::StaticOrder S; S.init(M, 2048, F.G, (int)blockIdx.x);
        pg8::EpiBf16<0> E{(bf16*)(ws + WS_PQ), 2048, nullptr, 0, 0, 1.f};
        REPS(10) { pg8::gemm_phase<pg8::EpiBf16<0>, pg8::StaticOrder, true, true>(F.lds + RING_OFF, g, S, E); __syncthreads(); }
        if (BOTH(10)) GRID_BAR(); STAMP(11);
    }
    if (IN(11)) {
        unsigned char* ws = WSP();
        REPS(11) peer::peer_topk(F.vcu, F.G, (const bf16*)(ws + WS_PQ), (const bf16*)(ws + WS_SUBK), (int*)(ws + WS_EXP), (float*)(ws + WS_GATE));
        if (BOTH(11)) GRID_BAR(); STAMP(12);
    }
    if (IN(12)) {
        unsigned char* ws = WSP(); const peer::Census cz = peer::census_complete(cen, F.MISC + 16);
        if (PEER_FP8) { REPS(12) peer::peer_u8(cz, (const bf16*)(ws + WS_H), ws + WS_UB, (const int*)(ws + WS_EXP), (float*)(ws + WS_PX)); }
        else { REPS(12) peer::peer_u(cz, (const bf16*)(ws + WS_H), (const bf16*)(ws + WS_UB), (const int*)(ws + WS_EXP), (float*)(ws + WS_PX)); }
        if (BOTH(12)) GRID_BAR(); STAMP(13);
    }
    if (IN(13)) {
        unsigned char* ws = WSP(); const peer::Census cz = peer::census_complete(cen, F.MISC + 16);
        peer::peer_act(cz.nx, (const float*)(ws + WS_PX), (const float*)(ws + WS_GATE), (float*)(ws + WS_AV), PEER_FP8 ? 1.f / peer::U_SCALE : 1.f, PEER_FP8 ? 1.f / peer::V_SCALE : 1.f);
        if (BOTH(13)) GRID_BAR(); STAMP(14);
    }
    if (IN(14)) {
        unsigned char* ws = WSP(); const peer::Census cz = peer::census_complete(cen, F.MISC + 16);
        if (PEER_FP8) { REPS(14) peer::peer_v8(cz, ws + WS_VB, (const int*)(ws + WS_EXP), (const float*)(ws + WS_AV), (bf16*)(ws + WS_Y), (float*)(ws + WS_RS)); }
        else { REPS(14) peer::peer_v(cz, (const bf16*)(ws + WS_VB), (const int*)(ws + WS_EXP), (const float*)(ws + WS_AV), (bf16*)(ws + WS_Y), (float*)(ws + WS_RS)); }
        if (BOTH(14)) GRID_BAR(); STAMP(15);
    }
    if (IN(15)) {
        unsigned char* ws = WSP();
        peer::peer_final(F.lds + RING_OFF, F.vcu, F.G, INP(0), (const bf16*)(ws + WS_T), (const float*)(ws + WS_RSQ), (const bf16*)(ws + WS_Y), (const float*)(ws + WS_RS), PEER_FP8 ? 32 : 64, (const float*)(ws + WS_ADA), INP(5), INP(14), OUTP(), (const bf16*)(ws + WS_X1));
    }
#undef IN
#undef BOTH
#undef GRID_BAR
}

extern "C" void kernel_launch(void* const* d_in, const int* in_sizes, int n_in, void* d_out, int out_size, void* d_ws, size_t ws_size, hipStream_t stream) {
    static int grid = 0;
    if (grid == 0) {
        if (n_in != 19 || out_size != M * DM || ws_size < WS_END) { fprintf(stderr, "kernel_launch: unexpected shapes (n_in %d out %d ws %zu)\n", n_in, out_size, ws_size); grid = -1; return; }
        int dev = 0, cus = 0, per_cu = 0;
        if (hipGetDevice(&dev) != hipSuccess || hipDeviceGetAttribute(&cus, hipDeviceAttributeMultiprocessorCount, dev) != hipSuccess) { grid = -1; return; }
        if (hipFuncSetAttribute((const void*)hybrid_fwd, hipFuncAttributeMaxDynamicSharedMemorySize, LDS_BYTES) != hipSuccess) { fprintf(stderr, "kernel_launch: hipFuncSetAttribute failed\n"); grid = -1; return; }
        if (hipOccupancyMaxActiveBlocksPerMultiprocessor(&per_cu, (const void*)hybrid_fwd, NWAVES * 64, LDS_BYTES) != hipSuccess || per_cu < 1)
            fprintf(stderr, "kernel_launch: note: occupancy query reports %d workgroups per CU\n", per_cu);
        (void)hipGetLastError();
        grid = cus;
    }
    if (grid < 0) return;
    if (hipMemsetAsync((char*)d_ws + WS_CTL, 0, CTL_ZERO_BYTES, stream) != hipSuccess) return;
    Args a{};
    for (int i = 0; i < 19; ++i) a.in[i] = (const float*)d_in[i];
    a.out = (float*)d_out; a.ws = (unsigned char*)d_ws;
    if (N_LAUNCHES == 1) { a.ph_lo = 0; a.ph_hi = N_PHASES; hipLaunchKernelGGL(hybrid_fwd, dim3(grid), dim3(NWAVES * 64), LDS_BYTES, stream, a); }
    else { for (int p = 0; p < N_PHASES; ++p) { a.ph_lo = p; a.ph_hi = p + 1; hipLaunchKernelGGL(hybrid_fwd, dim3(grid), dim3(NWAVES * 64), LDS_BYTES, stream, a); } }
}
```
